# Optimizing an MI355X kernel written in HIP

```python
import math
import jax, jax.numpy as jnp
from jax import lax
import numpy as np

D_MODEL = 1024
BATCH = 16
SEQ = 4096
DEPTH = 4


DA_HEADS = 4
DA_QK_DIM = 64
DA_V_DIM = 2 * DA_QK_DIM
DA_WIDTH = DA_HEADS * DA_V_DIM
Q_BLOCK = 128
HG_HEADS = 4
HG_K = 128
HG_V = 128
HG_KW = HG_HEADS * HG_K
HG_WIDTH = HG_HEADS * HG_V
HG_CHUNK = 64
SG_GROUPS = 8
SG_CHUNK = 128
SG_WIDTH = D_MODEL
SG_GROUP_DIM = SG_WIDTH // SG_GROUPS
REL_BUCKETS = 32
REL_MAX_DIST = 128
D_FF = -(-8 * D_MODEL // (3 * 256)) * 256
N_EVEN = (DEPTH + 1) // 2
N_ODD = DEPTH // 2
EVEN_SPLITS = (DA_WIDTH, DA_WIDTH, DA_WIDTH, HG_KW, HG_KW, HG_KW, HG_WIDTH, HG_WIDTH)
EVEN_IN = sum(EVEN_SPLITS)
ODD_IN = 2 * SG_WIDTH
EPS = 1e-6

kernel_name = 'hybrid_diffattn_hgrn2_sgu_encoder'


def rms_norm(x, gain):
    xf = x.astype(jnp.float32)
    y = xf * lax.rsqrt(jnp.mean(xf * xf, axis=-1, keepdims=True) + EPS)
    return (y * gain.astype(jnp.float32)).astype(x.dtype)


def rel_bucket(rel):
    half = REL_BUCKETS // 2
    max_exact = half // 2
    ret = jnp.where(rel > 0, half, 0)
    n = jnp.abs(rel)
    nf = jnp.maximum(n, 1).astype(jnp.float32)
    large = max_exact + (jnp.log(nf / max_exact) / math.log(REL_MAX_DIST / max_exact)
                         * (half - max_exact)).astype(jnp.int32)
    large = jnp.minimum(large, half - 1)
    return ret + jnp.where(n < max_exact, n, large)


def diff_attention(q, k, v, lam, rel_bias):
    b, s, h, _ = q.shape
    n_blk = s // Q_BLOCK
    q = q * (DA_QK_DIM ** -0.5)
    q_blocks = q.reshape(b, n_blk, Q_BLOCK, h, 2 * DA_QK_DIM).transpose(1, 0, 3, 2, 4)
    k = k.transpose(0, 2, 1, 3)
    k1, k2 = k[..., :DA_QK_DIM], k[..., DA_QK_DIM:]
    v = v.transpose(0, 2, 1, 3)
    k_pos = jnp.arange(s, dtype=jnp.int32)

    def one_block(args):
        qb, blk = args
        q_pos = blk * Q_BLOCK + jnp.arange(Q_BLOCK, dtype=jnp.int32)
        bias = rel_bias[rel_bucket(k_pos[None, :] - q_pos[:, None])]
        bias = bias.astype(jnp.float32).transpose(2, 0, 1)[None]
        s1 = jnp.einsum('bhqd,bhkd->bhqk', qb[..., :DA_QK_DIM], k1).astype(jnp.float32) + bias
        s2 = jnp.einsum('bhqd,bhkd->bhqk', qb[..., DA_QK_DIM:], k2).astype(jnp.float32) + bias
        p = jax.nn.softmax(s1, axis=-1) - lam * jax.nn.softmax(s2, axis=-1)
        return jnp.einsum('bhqk,bhkd->bhqd', p.astype(v.dtype), v)

    o = lax.map(one_block, (q_blocks, jnp.arange(n_blk, dtype=jnp.int32)))
    return o.transpose(1, 0, 3, 2, 4).reshape(b, s, h, DA_V_DIM)


def forget_gate(z, lb):
    z = z.astype(jnp.float32)
    lb = lb.reshape(HG_HEADS, HG_K)
    log_f = jnp.logaddexp(jnp.log(lb), jnp.log1p(-lb) + jax.nn.log_sigmoid(z))
    k = (1.0 - lb) * jax.nn.sigmoid(-z)
    return log_f, k


def chunk_gla(q, k, v, log_f):
    b, s, h, dk = q.shape
    dv = v.shape[-1]
    n = s // HG_CHUNK

    def to_chunks(t):
        return t.reshape(b, n, HG_CHUNK, h, t.shape[-1]).transpose(1, 0, 3, 2, 4)

    qc, kc, vc, lc = to_chunks(q), to_chunks(k), to_chunks(v), to_chunks(log_f)
    mask = jnp.tril(jnp.ones((HG_CHUNK, HG_CHUNK), dtype=bool))[:, :, None]

    def step(state, inp):
        q_, k_, v_, l_ = inp
        cum = jnp.cumsum(l_, axis=-2)
        o_inter = jnp.einsum('bhck,bhkv->bhcv', q_ * jnp.exp(cum), state)
        diff = cum[..., :, None, :] - cum[..., None, :, :]
        decay = jnp.exp(jnp.where(mask, diff, -jnp.inf))
        att = jnp.einsum('bhik,bhjk,bhijk->bhij', q_, k_, decay)
        o = o_inter + jnp.einsum('bhij,bhjv->bhiv', att, v_)
        last = cum[..., -1:, :]
        state = (jnp.exp(last[..., 0, :])[..., None] * state
                 + jnp.einsum('bhck,bhcv->bhkv', k_ * jnp.exp(last - cum), v_))
        return state, o

    s0 = jnp.zeros((b, h, dk, dv), jnp.float32)
    _, o = lax.scan(step, s0, (qc, kc, vc, lc))
    return o.transpose(1, 0, 3, 2, 4).reshape(b, s, h, dv)


def hgrn2_bidir(q, z_fwd, z_bwd, i, lb_fwd, lb_bwd):
    lf_f, k_f = forget_gate(z_fwd, lb_fwd)
    lf_b, k_b = forget_gate(z_bwd, lb_bwd)
    flip = lambda t: jnp.flip(t, axis=1)
    qf = q.astype(jnp.float32)
    vf = i.astype(jnp.float32)
    q2 = jnp.concatenate([qf, flip(qf)], axis=2)
    k2 = jnp.concatenate([k_f, flip(k_b)], axis=2)
    l2 = jnp.concatenate([lf_f, flip(lf_b)], axis=2)
    v2 = jnp.concatenate([vf, flip(vf)], axis=2)
    o2 = chunk_gla(q2, k2, v2, l2)
    return o2[:, :, :HG_HEADS] + flip(o2[:, :, HG_HEADS:])


def even_mixer(h, w_in, w_out, lam, lambda_init, subln, rel_bias, lb_fwd, lb_bwd, hg_norm):
    b, s, _ = h.shape
    da_q, da_k, da_v, hg_q, hg_zf, hg_zb, hg_i, hg_g = jnp.split(
        h @ w_in, np.cumsum(EVEN_SPLITS)[:-1].tolist(), axis=-1)
    o_a = diff_attention(da_q.reshape(b, s, DA_HEADS, 2 * DA_QK_DIM),
                         da_k.reshape(b, s, DA_HEADS, 2 * DA_QK_DIM),
                         da_v.reshape(b, s, DA_HEADS, DA_V_DIM), lam, rel_bias)
    o_a = (rms_norm(o_a, subln) * (1.0 - lambda_init)).reshape(b, s, DA_WIDTH)
    heads = lambda t, d: t.reshape(b, s, HG_HEADS, d)
    o_b = hgrn2_bidir(jax.nn.silu(heads(hg_q, HG_K)), heads(hg_zf, HG_K), heads(hg_zb, HG_K),
                      heads(hg_i, HG_V), lb_fwd, lb_bwd).astype(h.dtype)
    o_b = (rms_norm(o_b, hg_norm) * jax.nn.silu(heads(hg_g, HG_V))).reshape(b, s, HG_WIDTH)
    return jnp.concatenate([o_a, o_b], axis=-1) @ w_out


def odd_mixer(h, w_in, sg_norm, sg_w, sg_b, w_out):
    b, s, _ = h.shape
    u, v = jnp.split(jax.nn.gelu(h @ w_in, approximate=False), 2, axis=-1)
    v = rms_norm(v, sg_norm)
    n = s // SG_CHUNK
    v = v.reshape(b, n, SG_CHUNK, SG_GROUPS, SG_GROUP_DIM)
    v = jnp.einsum('gpq,bnqgc->bnpgc', sg_w, v) + sg_b.T[None, None, :, :, None]
    return (u * v.reshape(b, s, SG_WIDTH)) @ w_out


def swiglu(h, w_in, w_out):
    gate, up = jnp.split(h @ w_in, 2, axis=-1)
    return (jax.nn.silu(gate) * up) @ w_out


def setup_inputs(seed: int = 0) -> dict:
    key = jax.random.key(seed)
    ks = jax.random.split(key, 22)

    def nrm(k, shape, scale):
        return jax.random.normal(k, shape, jnp.float32) * scale

    return {
        'x': nrm(ks[0], (BATCH, SEQ, D_MODEL), 1.0),
        'rel_bias': nrm(ks[1], (REL_BUCKETS, DA_HEADS), 0.5),
        'norm_mix': 1.0 + nrm(ks[2], (DEPTH, D_MODEL), 0.02),
        'norm_ffn': 1.0 + nrm(ks[3], (DEPTH, D_MODEL), 0.02),
        'norm_final': 1.0 + nrm(ks[4], (D_MODEL,), 0.02),
        'w_in_even': nrm(ks[5], (N_EVEN, D_MODEL, EVEN_IN), D_MODEL ** -0.5),
        'w_out_even': nrm(ks[6], (N_EVEN, DA_WIDTH + HG_WIDTH, D_MODEL), (DA_WIDTH + HG_WIDTH) ** -0.5),
        'lambda_q1': nrm(ks[7], (N_EVEN, DA_QK_DIM), 0.1),
        'lambda_k1': nrm(ks[8], (N_EVEN, DA_QK_DIM), 0.1),
        'lambda_q2': nrm(ks[9], (N_EVEN, DA_QK_DIM), 0.1),
        'lambda_k2': nrm(ks[10], (N_EVEN, DA_QK_DIM), 0.1),
        'da_subln': 1.0 + nrm(ks[11], (N_EVEN, DA_V_DIM), 0.02),
        'hg_lb_fwd': nrm(ks[12], (N_EVEN, HG_KW), 0.1),
        'hg_lb_bwd': nrm(ks[13], (N_EVEN, HG_KW), 0.1),
        'hg_norm': 1.0 + nrm(ks[14], (N_EVEN, HG_V), 0.02),
        'w_in_odd': nrm(ks[15], (N_ODD, D_MODEL, ODD_IN), D_MODEL ** -0.5),
        'sg_norm': 1.0 + nrm(ks[16], (N_ODD, SG_WIDTH), 0.02),
        'sg_w': nrm(ks[17], (N_ODD, SG_GROUPS, SG_CHUNK, SG_CHUNK), SG_CHUNK ** -0.5),
        'sg_b': 1.0 + nrm(ks[18], (N_ODD, SG_GROUPS, SG_CHUNK), 0.1),
        'w_out_odd': nrm(ks[19], (N_ODD, SG_WIDTH, D_MODEL), SG_WIDTH ** -0.5),
        'w_ffn_in': nrm(ks[20], (DEPTH, D_MODEL, 2 * D_FF), D_MODEL ** -0.5),
        'w_ffn_out': nrm(ks[21], (DEPTH, D_FF, D_MODEL), D_FF ** -0.5),
    }


def reference(x, rel_bias, norm_mix, norm_ffn, norm_final, w_in_even, w_out_even,
              lambda_q1, lambda_k1, lambda_q2, lambda_k2, da_subln, hg_lb_fwd, hg_lb_bwd, hg_norm,
              w_in_odd, sg_norm, sg_w, sg_b, w_out_odd, w_ffn_in, w_ffn_out):
    f32 = jnp.float32
    lb_f = jnp.cumsum(jax.nn.softmax(hg_lb_fwd.astype(f32), axis=0), axis=0)
    lb_f = lb_f - lb_f[:1]
    lb_b = jnp.cumsum(jax.nn.softmax(hg_lb_bwd.astype(f32), axis=0), axis=0)
    lb_b = lb_b - lb_b[:1]
    h = x
    for l in range(DEPTH):
        hn = rms_norm(h, norm_mix[l])
        if l % 2 == 0:
            e = l // 2
            lambda_init = 0.8 - 0.6 * math.exp(-0.3 * l)
            lam = (jnp.exp(jnp.sum(lambda_q1[e].astype(f32) * lambda_k1[e].astype(f32)))
                   - jnp.exp(jnp.sum(lambda_q2[e].astype(f32) * lambda_k2[e].astype(f32))) + lambda_init)
            h = h + even_mixer(hn, w_in_even[e], w_out_even[e], lam, lambda_init, da_subln[e], rel_bias,
                               lb_f[e], lb_b[e], hg_norm[e])
        else:
            o = l // 2
            h = h + odd_mixer(hn, w_in_odd[o], sg_norm[o], sg_w[o], sg_b[o], w_out_odd[o])
        h = h + swiglu(rms_norm(h, norm_ffn[l]), w_ffn_in[l], w_ffn_out[l])
    return rms_norm(h, norm_final)
```

```cpp
#include <hip/hip_runtime.h>
#include <hip/hip_cooperative_groups.h>
#include <cstdio>
#include <cstdint>
namespace cg = cooperative_groups;
namespace pg8 {
#define PG8_LAS __attribute__((address_space(3)))
typedef unsigned short bf16_t;
typedef short bf16x8 __attribute__((ext_vector_type(8)));
typedef float f32x4 __attribute__((ext_vector_type(4)));
typedef unsigned u32x4 __attribute__((ext_vector_type(4)));
constexpr int BM = 256, BK = 64, HALF = 128, HTB = HALF * BK * 2  , STAGE_BYTES = 8 * HTB, NXCD = 8, WGM = 8;

__host__ __device__ __forceinline__ int lds_byte(int r, int c) { const int st = (r >> 4) * 2 + (c >> 5), rr = r & 15, cc = c & 31, ob = rr * 64 + cc * 2; return st * 1024 + (ob ^ (((ob >> 9) & 1) << 5)); }
__host__ __device__ __forceinline__ void stage_rc(int b, int& R, int& C) { const int st = b / 1024, sb = b % 1024, swz = sb ^ (((sb >> 9) & 1) << 5); R = (st >> 1) * 16 + swz / 64; C = (st & 1) * 32 + (swz % 64) / 2; }
__host__ __device__ __forceinline__ int perm32(int rho) { const int n = rho >> 4, i = rho & 15; return 8 * (i >> 2) + 4 * n + (i & 3); }

struct Unit { int pm, pn; };
struct Gemm { const bf16_t* A; const bf16_t* Bt; int M, N, K; };

struct StaticOrder {
    int nM, nN, nwg, G, c;
    __host__ __device__ void init(int M, int N, int G_, int c_) { nM = M / BM; nN = N / BM; nwg = nM * nN; G = G_; c = c_; }
    __host__ __device__ bool next(int i, Unit& u) const {
        const long L = (long)i * G + c; if (L >= nwg) return false;
        int wgid = (int)L; { const int q = nwg / NXCD, r = nwg % NXCD, xcd = wgid % NXCD, off = wgid / NXCD; wgid = (xcd < r ? xcd * (q + 1) : r * (q + 1) + (xcd - r) * q) + off; }
        const int nig = WGM * nN, gid = wgid / nig, fm = gid * WGM, gsz = (nM - fm) < WGM ? (nM - fm) : WGM;
        u.pm = fm + ((wgid % nig) % gsz); u.pn = (wgid % nig) / gsz; return true;
    }
    __device__ __forceinline__ void a_ready(const Unit&) const {}
    __device__ __forceinline__ void done(const Unit&) const {}
};

__device__ __forceinline__ unsigned cvt_pk_bf16(float lo, float hi) { unsigned r; asm volatile("v_cvt_pk_bf16_f32 %0, %1, %2" : "=v"(r) : "v"(lo), "v"(hi)); return r; }
typedef float f32x2 __attribute__((ext_vector_type(2)));
__device__ __forceinline__ f32x2 gelu_pk(f32x2 v) {
    const f32x2 av = __builtin_elementwise_abs(v), d = av * 0.2316418882f + 1.0f;
    f32x2 t; t.x = __builtin_amdgcn_rcpf(d.x); t.y = __builtin_amdgcn_rcpf(d.y);
    f32x2 q = t * 0.5307027145f + (-0.7265760135f); q = q * t + 0.7107068705f; q = q * t + (-0.142248368f); q = q * t + 0.127414796f; q = q * t;
    const f32x2 s = (v * v) * (-0.72134752044f);
    f32x2 e; e.x = __builtin_amdgcn_exp2f(s.x); e.y = __builtin_amdgcn_exp2f(s.y);
    const f32x2 m = v * (q * e), r = v - m;
    f32x2 o; o.x = v.x < 0.f ? m.x : r.x; o.y = v.y < 0.f ? m.y : r.y; return o;
}

constexpr float RMS_EPS = 1e-6f;
__device__ __forceinline__ float ss2f(unsigned long long v) { return (float)v * (1.0f / 16777216.0f); }
__device__ __forceinline__ unsigned long long f2ss(float v) { return (unsigned long long)(v * 16777216.0f); }
__device__ __forceinline__ float silu1(float v) { return v * __builtin_amdgcn_rcpf(1.0f + __builtin_amdgcn_exp2f(-1.4426950408889634f * v)); }
__device__ __forceinline__ f32x4 silu4(f32x4 v) { return (f32x4){silu1(v[0]), silu1(v[1]), silu1(v[2]), silu1(v[3])}; }
__device__ __forceinline__ u32x4 pack8(f32x4 v0, f32x4 v1) { u32x4 w; w.x = cvt_pk_bf16(v0[0], v0[1]); w.y = cvt_pk_bf16(v0[2], v0[3]); w.z = cvt_pk_bf16(v1[0], v1[1]); w.w = cvt_pk_bf16(v1[2], v1[3]); return w; }

struct EpiEvenIn {
    static constexpr bool PERM = true, AFTER_DRAIN = false;
    bf16_t* O; const unsigned long long* ss;
    __device__ __forceinline__ void operator()(const f32x4 (&acc)[2][2][4][2], const Unit& u, int wr, int wc, int fr, int fq) const {
        const int row0 = u.pm * BM + wr * 64 + fr, col0 = u.pn * BM + wc * 32 + 8 * fq;
        const bool act = (u.pn == 6) || (u.pn == 7) || (u.pn == 14) || (u.pn == 15);
        const float sc = (u.pn < 2) ? 0.125f : 1.0f;
#pragma unroll
        for (int ai = 0; ai < 2; ++ai)
#pragma unroll
            for (int m = 0; m < 4; ++m) { const int row = row0 + ai * HALF + m * 16; const float r = __builtin_amdgcn_rsqf(ss2f(ss[row]) * (1.0f / 1024.0f) + RMS_EPS) * sc;
                bf16_t* rowp = O + (size_t)row * 4096 + col0;
#pragma unroll
                for (int bj = 0; bj < 2; ++bj) { f32x4 v0 = acc[ai][bj][m][0] * r, v1 = acc[ai][bj][m][1] * r;
                    if (act) { v0 = silu4(v0); v1 = silu4(v1); }
                    *(u32x4*)(rowp + bj * HALF) = pack8(v0, v1); } }
    }
};
struct EpiOddIn {
    static constexpr bool PERM = true, AFTER_DRAIN = false;
    bf16_t* O; const unsigned long long* ss; unsigned long long* vss;
    __device__ __forceinline__ void operator()(const f32x4 (&acc)[2][2][4][2], const Unit& u, int wr, int wc, int fr, int fq) const {
        const int row0 = u.pm * BM + wr * 64 + fr, col0 = u.pn * BM + wc * 32 + 8 * fq;
        const bool isv = u.pn >= 4;
#pragma unroll
        for (int ai = 0; ai < 2; ++ai)
#pragma unroll
            for (int m = 0; m < 4; ++m) { const int row = row0 + ai * HALF + m * 16; const float r = __builtin_amdgcn_rsqf(ss2f(ss[row]) * (1.0f / 1024.0f) + RMS_EPS);
                bf16_t* rowp = O + (size_t)row * 2048 + col0; float sq = 0.f;
#pragma unroll
                for (int bj = 0; bj < 2; ++bj) { f32x4 v0 = acc[ai][bj][m][0] * r, v1 = acc[ai][bj][m][1] * r;
                    f32x2 a = gelu_pk((f32x2){v0[0], v0[1]}), b = gelu_pk((f32x2){v0[2], v0[3]}), c = gelu_pk((f32x2){v1[0], v1[1]}), d = gelu_pk((f32x2){v1[2], v1[3]});
                    v0 = (f32x4){a.x, a.y, b.x, b.y}; v1 = (f32x4){c.x, c.y, d.x, d.y};
                    sq += (v0[0] * v0[0] + v0[1] * v0[1]) + (v0[2] * v0[2] + v0[3] * v0[3]) + (v1[0] * v1[0] + v1[1] * v1[1]) + (v1[2] * v1[2] + v1[3] * v1[3]);
                    *(u32x4*)(rowp + bj * HALF) = pack8(v0, v1); }
                if (isv) { sq += __shfl_xor(sq, 16); sq += __shfl_xor(sq, 32); if (fq == 0) atomicAdd(vss + row, f2ss(sq)); } }
    }
};
struct EpiFfnIn {
    static constexpr bool PERM = true, AFTER_DRAIN = false;
    bf16_t* O; const unsigned long long* ss;
    __device__ __forceinline__ void operator()(const f32x4 (&acc)[2][2][4][2], const Unit& u, int wr, int wc, int fr, int fq) const {
        const int row0 = u.pm * BM + wr * 64 + fr, col0 = u.pn * HALF + wc * 32 + 8 * fq;
#pragma unroll
        for (int ai = 0; ai < 2; ++ai)
#pragma unroll
            for (int m = 0; m < 4; ++m) { const int row = row0 + ai * HALF + m * 16; const float r = __builtin_amdgcn_rsqf(ss2f(ss[row]) * (1.0f / 1024.0f) + RMS_EPS);
                const f32x4 g0 = silu4(acc[ai][0][m][0] * r), g1 = silu4(acc[ai][0][m][1] * r);
                const f32x4 v0 = g0 * (acc[ai][1][m][0] * r), v1 = g1 * (acc[ai][1][m][1] * r);
                *(u32x4*)(O + (size_t)row * 2816 + col0) = pack8(v0, v1); }
    }
};
struct EpiRes {
    static constexpr bool PERM = true, AFTER_DRAIN = false;
    bf16_t* hb; unsigned long long* ssn;
    __device__ __forceinline__ void operator()(const f32x4 (&acc)[2][2][4][2], const Unit& u, int wr, int wc, int fr, int fq) const {
        const int row0 = u.pm * BM + wr * 64 + fr, col0 = u.pn * BM + wc * 32 + 8 * fq;
#pragma unroll
        for (int ai = 0; ai < 2; ++ai)
#pragma unroll
            for (int m = 0; m < 4; ++m) { const int row = row0 + ai * HALF + m * 16; const size_t off = (size_t)row * 1024 + col0; float sq = 0.f;
#pragma unroll
                for (int bj = 0; bj < 2; ++bj) { const u32x4 bw = *(const u32x4*)(hb + off + bj * HALF);
                    const f32x4 b0 = (f32x4){__uint_as_float(bw.x << 16), __uint_as_float(bw.x & 0xffff0000u), __uint_as_float(bw.y << 16), __uint_as_float(bw.y & 0xffff0000u)};
                    const f32x4 b1 = (f32x4){__uint_as_float(bw.z << 16), __uint_as_float(bw.z & 0xffff0000u), __uint_as_float(bw.w << 16), __uint_as_float(bw.w & 0xffff0000u)};
                    const f32x4 v0 = acc[ai][bj][m][0] + b0, v1 = acc[ai][bj][m][1] + b1;
                    *(u32x4*)(hb + off + bj * HALF) = pack8(v0, v1);
                    sq += (v0[0] * v0[0] + v0[1] * v0[1]) + (v0[2] * v0[2] + v0[3] * v0[3]) + (v1[0] * v1[0] + v1[1] * v1[1]) + (v1[2] * v1[2] + v1[3] * v1[3]); }
                sq += __shfl_xor(sq, 16); sq += __shfl_xor(sq, 32); if (fq == 0) atomicAdd(ssn + row, f2ss(sq)); }
    }
};
template <class Epi, class Sched, bool ALIGN_EPI = false, bool SP2 = false>
__device__ __forceinline__ void gemm_phase(PG8_LAS unsigned char* lds, const Gemm g, const Sched& S, const Epi& E) {
    int tid_ = threadIdx.x; asm volatile("" : "+v"(tid_));
    const int tid = tid_, wid = __builtin_amdgcn_readfirstlane(tid >> 6), lane = tid & 63, wr = wid >> 2, wc = wid & 3, fr = lane & 15, fq = lane >> 4;
    const int K = g.K, nt = K / BK;
    unsigned voffA[2], voffB[2];
#pragma unroll
    for (int i = 0; i < 2; ++i) { int R, C; stage_rc(tid * 16 + i * 8192, R, C); const int Rb = Epi::PERM ? ((R & ~31) + perm32(R & 31)) : R;
        voffA[i] = (unsigned)(R * K + C) * 2u; voffB[i] = (unsigned)(Rb * K + C) * 2u; }
    const size_t kstep = (size_t)(BK * 2);
    const size_t hstep = (size_t)HALF * K * 2;
    const size_t tstep = 2 * hstep;
    const unsigned ldsw = (unsigned)wid * 1024u;
    const int aoff = lds_byte(wr * 64 + fr, fq * 8), boff = lds_byte(wc * 32 + fr, fq * 8);
#define PG8_SA(b, h) (((b) * 2 + (h)) * HTB)
#define PG8_SB(b, h) ((4 + (b) * 2 + (h)) * HTB)
#define PG8_STAGE(bufoff, gbase, voff) do { _Pragma("unroll") for (int _i = 0; _i < 2; ++_i) \
        __builtin_amdgcn_global_load_lds((const unsigned*)((const char*)(gbase) + (voff)[_i]), (PG8_LAS unsigned*)(lds + (bufoff) + ldsw + _i * 8192), 16, 0, 0); } while (0)
#define PG8_LDA(dst, b, h) do { _Pragma("unroll") for (int m = 0; m < 4; ++m) _Pragma("unroll") for (int k = 0; k < 2; ++k) dst[m][k] = *(const PG8_LAS bf16x8*)(lds + PG8_SA(b, h) + aoff + m * 2048 + k * 1024); } while (0)
#define PG8_LDB(dst, b, h) do { _Pragma("unroll") for (int n = 0; n < 2; ++n) _Pragma("unroll") for (int k = 0; k < 2; ++k) dst[n][k] = *(const PG8_LAS bf16x8*)(lds + PG8_SB(b, h) + boff + n * 2048 + k * 1024); } while (0)
#define PG8_MMA(ai, bj, At, Bt) do { __builtin_amdgcn_s_setprio(1); _Pragma("unroll") for (int m = 0; m < 4; ++m) _Pragma("unroll") for (int n = 0; n < 2; ++n) _Pragma("unroll") for (int k = 0; k < 2; ++k) \
        acc[ai][bj][m][n] = __builtin_amdgcn_mfma_f32_16x16x32_bf16(Bt[n][k], At[m][k], acc[ai][bj][m][n], 0, 0, 0); __builtin_amdgcn_s_setprio(0); } while (0)
#define PG8_WAIT_V(n) asm volatile("s_waitcnt vmcnt(" #n ")" ::: "memory")
#define PG8_WAIT_L(n) asm volatile("s_waitcnt lgkmcnt(" #n ")" ::: "memory")
#define PG8_BAR __builtin_amdgcn_s_barrier()
#define PG8_SCHED __builtin_amdgcn_sched_barrier(0)
    Unit cur, nxt; int ui = 0;
    if (!S.next(0, cur)) return;
    f32x4 acc[2][2][4][2];
#pragma unroll
    for (int a = 0; a < 2; ++a)
#pragma unroll
        for (int b = 0; b < 2; ++b)
#pragma unroll
            for (int m = 0; m < 4; ++m)
#pragma unroll
                for (int n = 0; n < 2; ++n) acc[a][b][m][n] = (f32x4){0.f, 0.f, 0.f, 0.f};
    bf16x8 At[4][2], B0[2][2], B1[2][2];
    const char* cA = (const char*)g.A + (size_t)cur.pm * tstep; const char* cB = (const char*)g.Bt + (size_t)cur.pn * tstep;
    S.a_ready(cur);
    if constexpr (SP2) {
        PG8_STAGE(PG8_SB(0, 0), cB, voffB); PG8_STAGE(PG8_SB(0, 1), cB + hstep, voffB); PG8_STAGE(PG8_SA(0, 0), cA, voffA); PG8_STAGE(PG8_SA(0, 1), cA + hstep, voffA);
        if (wr == 1) PG8_BAR;
        PG8_WAIT_V(2); PG8_BAR;
        PG8_STAGE(PG8_SB(1, 0), cB + kstep, voffB); PG8_STAGE(PG8_SA(1, 0), cA + kstep, voffA); PG8_STAGE(PG8_SB(1, 1), cB + hstep + kstep, voffB);
        PG8_WAIT_V(6); PG8_BAR;
    } else {
        PG8_STAGE(PG8_SB(0, 0), cB, voffB); PG8_STAGE(PG8_SA(0, 0), cA, voffA); PG8_STAGE(PG8_SB(0, 1), cB + hstep, voffB); PG8_STAGE(PG8_SA(0, 1), cA + hstep, voffA);
        if (wr == 1) PG8_BAR;
        PG8_WAIT_V(4); PG8_BAR;
        PG8_STAGE(PG8_SB(1, 0), cB + kstep, voffB); PG8_STAGE(PG8_SA(1, 0), cA + kstep, voffA); PG8_STAGE(PG8_SB(1, 1), cB + hstep + kstep, voffB);
        PG8_WAIT_V(6); PG8_BAR;
    }
    for (;;) {
        const bool has_next = S.next(ui + 1, nxt);
        const char* nA = has_next ? (const char*)g.A + (size_t)nxt.pm * tstep : cA; const char* nB = has_next ? (const char*)g.Bt + (size_t)nxt.pn * tstep : cB;
        for (int t = 0; t < nt; t += 2) {
            const bool last = (t == nt - 2);
            const char* a1 = cA + (size_t)(t + 1) * kstep;
            const char* a2 = last ? nA : cA + (size_t)(t + 2) * kstep; const char* b2 = last ? nB : cB + (size_t)(t + 2) * kstep;
            const char* a3 = a2 + kstep; const char* b3 = b2 + kstep;
            if (last && has_next) S.a_ready(nxt);
            if constexpr (SP2) {
            PG8_LDB(B0, 0, 0); PG8_LDB(B1, 0, 1); PG8_SCHED; PG8_LDA(At, 0, 0); PG8_STAGE(PG8_SA(1, 1), a1 + hstep, voffA);
            PG8_WAIT_V(8); PG8_WAIT_L(0); PG8_BAR; PG8_MMA(0, 0, At, B0); PG8_MMA(0, 1, At, B1); PG8_BAR; PG8_SCHED;
            PG8_LDA(At, 0, 1); PG8_STAGE(PG8_SB(0, 0), b2, voffB); PG8_STAGE(PG8_SB(0, 1), b2 + hstep, voffB); PG8_STAGE(PG8_SA(0, 0), a2, voffA);
            PG8_WAIT_V(8); PG8_WAIT_L(0); PG8_BAR; PG8_MMA(1, 0, At, B0); PG8_MMA(1, 1, At, B1); PG8_BAR; PG8_SCHED;
            PG8_LDB(B0, 1, 0); PG8_LDB(B1, 1, 1); PG8_SCHED; PG8_LDA(At, 1, 0); PG8_STAGE(PG8_SA(0, 1), a2 + hstep, voffA);
            PG8_WAIT_V(8); PG8_WAIT_L(0); PG8_BAR; PG8_MMA(0, 0, At, B0); PG8_MMA(0, 1, At, B1); PG8_BAR; PG8_SCHED;
            PG8_LDA(At, 1, 1); PG8_STAGE(PG8_SB(1, 0), b3, voffB); PG8_STAGE(PG8_SB(1, 1), b3 + hstep, voffB); PG8_STAGE(PG8_SA(1, 0), a3, voffA);
            PG8_WAIT_V(8); PG8_WAIT_L(0); PG8_BAR; PG8_MMA(1, 0, At, B0); PG8_MMA(1, 1, At, B1); PG8_BAR; PG8_SCHED;
            } else {
            PG8_LDB(B0, 0, 0); PG8_SCHED; PG8_LDA(At, 0, 0); PG8_STAGE(PG8_SA(1, 1), a1 + hstep, voffA);
            PG8_WAIT_L(8); PG8_BAR; PG8_WAIT_L(0); PG8_MMA(0, 0, At, B0); PG8_BAR; PG8_SCHED;
            PG8_LDB(B1, 0, 1); PG8_STAGE(PG8_SB(0, 0), b2, voffB);
            PG8_BAR; PG8_WAIT_L(0); PG8_MMA(0, 1, At, B1); PG8_BAR;
            PG8_LDA(At, 0, 1); PG8_STAGE(PG8_SA(0, 0), a2, voffA);
            PG8_BAR; PG8_WAIT_L(0); PG8_MMA(1, 0, At, B0); PG8_BAR; PG8_SCHED;
            PG8_STAGE(PG8_SB(0, 1), b2 + hstep, voffB);
            PG8_WAIT_V(6); PG8_BAR; PG8_MMA(1, 1, At, B1); PG8_BAR;
            PG8_LDB(B0, 1, 0); PG8_SCHED; PG8_LDA(At, 1, 0); PG8_STAGE(PG8_SA(0, 1), a2 + hstep, voffA);
            PG8_WAIT_L(8); PG8_BAR; PG8_WAIT_L(0); PG8_MMA(0, 0, At, B0); PG8_BAR; PG8_SCHED;
            PG8_LDB(B1, 1, 1); PG8_STAGE(PG8_SB(1, 0), b3, voffB);
            PG8_BAR; PG8_WAIT_L(0); PG8_MMA(0, 1, At, B1); PG8_BAR;
            PG8_LDA(At, 1, 1); PG8_STAGE(PG8_SA(1, 0), a3, voffA);
            PG8_BAR; PG8_WAIT_L(0); PG8_MMA(1, 0, At, B0); PG8_BAR; PG8_SCHED;
            PG8_STAGE(PG8_SB(1, 1), b3 + hstep, voffB);
            PG8_WAIT_V(6); PG8_BAR; PG8_MMA(1, 1, At, B1); PG8_BAR;
            }
        }
        if constexpr (ALIGN_EPI) { if (wr == 0) PG8_BAR; }
        if constexpr (!Epi::AFTER_DRAIN) { E(acc, cur, wr, wc, fr, fq); S.done(cur); }
        if (!has_next) break;
#pragma unroll
        for (int a = 0; a < 2; ++a)
#pragma unroll
            for (int b = 0; b < 2; ++b)
#pragma unroll
                for (int m = 0; m < 4; ++m)
#pragma unroll
                    for (int n = 0; n < 2; ++n) acc[a][b][m][n] = (f32x4){0.f, 0.f, 0.f, 0.f};
        cur = nxt; cA = nA; cB = nB; ++ui;
        if constexpr (ALIGN_EPI) { if (wr == 1) PG8_BAR; }
    }
    PG8_WAIT_V(0);
    if constexpr (!ALIGN_EPI) { if (wr == 0) PG8_BAR; }
    PG8_BAR;
    if constexpr (Epi::AFTER_DRAIN) { E.fused(acc, cur, wr, wc, fr, fq, lds, wid, lane); S.done(cur); }
#undef PG8_SA
#undef PG8_SB
#undef PG8_STAGE
#undef PG8_LDA
#undef PG8_LDB
#undef PG8_MMA
#undef PG8_WAIT_V
#undef PG8_WAIT_L
#undef PG8_BAR
#undef PG8_SCHED
}
}

constexpr int D_MODEL = 1024, BATCH = 16, SEQ = 4096, T = BATCH * SEQ, DFF = 2816, DEPTH = 4;
constexpr int EVEN_IN = 4096, ODD_IN = 2048;
constexpr float EPS = 1e-6f;
typedef unsigned short bf16;
typedef unsigned u32x4 __attribute__((ext_vector_type(4)));
typedef unsigned u32x2 __attribute__((ext_vector_type(2)));
typedef float f32x4 __attribute__((ext_vector_type(4)));
typedef float f32x2 __attribute__((ext_vector_type(2)));
typedef float f32x8 __attribute__((ext_vector_type(8)));
typedef float f32x16 __attribute__((ext_vector_type(16)));
typedef short bf16x8 __attribute__((ext_vector_type(8)));
typedef short s16x4 __attribute__((ext_vector_type(4)));
#define LAS __attribute__((address_space(3)))
#define GAS __attribute__((address_space(1)))

constexpr size_t MiB = 1u << 20;
constexpr size_t WS_SS = 0;
constexpr size_t WS_BAR = 6 * MiB;
constexpr size_t WS_W = 8 * MiB;
constexpr size_t W_INE = 0, W_OUTE = W_INE + 2ull * 4096 * 1024, W_INO = W_OUTE + 2ull * 1024 * 1024, W_OUTO = W_INO + 2ull * 2048 * 1024,
                 W_FIN = W_OUTO + 2ull * 1024 * 1024, W_FOUT = W_FIN + 4ull * 5632 * 1024, W_SGW = W_FOUT + 4ull * 1024 * 2816, W_END = W_SGW + 2ull * 8 * 128 * 128;
static_assert(WS_W + W_END * 2 <= 108 * MiB, "weights");
constexpr size_t WS_ASCR = 108 * MiB;
constexpr size_t WS_HB = 140 * MiB;
constexpr size_t WS_MIX = 268 * MiB;
constexpr size_t WS_BIG = 396 * MiB;
constexpr size_t WS_END = 908 * MiB;
constexpr int LDS_BYTES = 147456;

struct Params {
    const float* x; const float* rel_bias; const float* norm_mix; const float* norm_ffn; const float* norm_final; const float* w_in_even; const float* w_out_even;
    const float* lq1; const float* lk1; const float* lq2; const float* lk2; const float* da_subln; const float* lb_fwd; const float* lb_bwd; const float* hg_norm;
    const float* w_in_odd; const float* sg_norm; const float* sg_w; const float* sg_b; const float* w_out_odd; const float* w_ffn_in; const float* w_ffn_out;
    float* out; unsigned char* ws; int ph_lo, ph_hi;
};

__device__ __forceinline__ unsigned cvtpk(float lo, float hi) { unsigned r; asm volatile("v_cvt_pk_bf16_f32 %0, %1, %2" : "=v"(r) : "v"(lo), "v"(hi)); return r; }
typedef __bf16 bf16v2 __attribute__((ext_vector_type(2)));
__device__ __forceinline__ unsigned cvtpk_c(float lo, float hi) { bf16v2 v; v.x = (__bf16)lo; v.y = (__bf16)hi; return __builtin_bit_cast(unsigned, v); }
__device__ __forceinline__ float bf2f(unsigned short b) { return __uint_as_float(((unsigned)b) << 16); }
__device__ __forceinline__ float bflo(unsigned w) { return __uint_as_float(w << 16); }
__device__ __forceinline__ float bfhi(unsigned w) { return __uint_as_float(w & 0xffff0000u); }
__device__ __forceinline__ float wave_sum(float v) {
#pragma unroll
    for (int o = 1; o < 64; o <<= 1) v += __shfl_xor(v, o);
    return v;
}

__device__ __forceinline__ void transpose_item(const float* W, int K, int N, bf16* WT, const float* gain, int ffn_perm, LAS float* scr, int item, int lane) {
    const int nblk = N / 32, kb = item / nblk, nb = item % nblk, k0 = 64 * kb, n0 = 32 * nb;
    float wv[32];
#pragma unroll
    for (int i = 0; i < 32; ++i) { const int kk = 2 * i + (lane >> 5); wv[i] = W[(size_t)(k0 + kk) * N + n0 + (lane & 31)]; }
#pragma unroll
    for (int i = 0; i < 32; ++i) { const int kk = 2 * i + (lane >> 5); const float g = gain ? gain[k0 + kk] : 1.0f; scr[kk * 33 + (lane & 31)] = wv[i] * g; }
    asm volatile("s_waitcnt lgkmcnt(0)" ::: "memory");
    int r0 = n0;
    if (ffn_perm) { r0 = (n0 < DFF) ? ((n0 >> 7) * 256 + (n0 & 127)) : (((n0 - DFF) >> 7) * 256 + 128 + ((n0 - DFF) & 127)); }
    const int c = lane & 7;
#pragma unroll
    for (int j = 0; j < 4; ++j) { const int n = (lane >> 3) + 8 * j; const LAS float* s = scr + (8 * c) * 33 + n;
        u32x4 o; o.x = cvtpk(s[0 * 33], s[1 * 33]); o.y = cvtpk(s[2 * 33], s[3 * 33]); o.z = cvtpk(s[4 * 33], s[5 * 33]); o.w = cvtpk(s[6 * 33], s[7 * 33]);
        *(u32x4*)(WT + (size_t)(r0 + n) * K + k0 + 8 * c) = o; }
    asm volatile("s_waitcnt lgkmcnt(0)" ::: "memory");
}

__device__ __forceinline__ void prologue_phase(const Params& p, LAS unsigned char* lds) {
    int tid_ = threadIdx.x; asm volatile("" : "+v"(tid_));
    const int tid = tid_, lane = tid & 63, wave = tid >> 6;
    const int gw = blockIdx.x * 8 + wave, NGW = gridDim.x * 8;
    const int gt = blockIdx.x * 512 + tid, NGT = gridDim.x * 512;
    { f32x4* z = (f32x4*)(p.ws + WS_SS); for (int i = T / 2 + gt; i < 11 * T / 2; i += NGT) z[i] = (f32x4){0.f, 0.f, 0.f, 0.f}; }
    bf16* WB = (bf16*)(p.ws + WS_W);
    LAS float* scr = (LAS float*)(lds + wave * 16384);
    constexpr int I_INE = 16 * 128, I_OUT = 16 * 32, I_INO = 16 * 64, I_FIN = 16 * 176, I_FOUT = 44 * 32;
    constexpr int NITEMS = 2 * I_INE + 2 * I_OUT + 2 * I_INO + 2 * I_OUT + 4 * I_FIN + 4 * I_FOUT;
    for (int it = gw; it < NITEMS; it += NGW) {
        int r = it;
        if (r < 2 * I_INE) { const int e = r / I_INE; transpose_item(p.w_in_even + (size_t)e * 1024 * 4096, 1024, 4096, WB + W_INE + (size_t)e * 4096 * 1024, p.norm_mix + (2 * e) * 1024, 0, scr, r % I_INE, lane); continue; } r -= 2 * I_INE;
        if (r < 2 * I_OUT) { const int e = r / I_OUT; transpose_item(p.w_out_even + (size_t)e * 1024 * 1024, 1024, 1024, WB + W_OUTE + (size_t)e * 1024 * 1024, nullptr, 0, scr, r % I_OUT, lane); continue; } r -= 2 * I_OUT;
        if (r < 2 * I_INO) { const int e = r / I_INO; transpose_item(p.w_in_odd + (size_t)e * 1024 * 2048, 1024, 2048, WB + W_INO + (size_t)e * 2048 * 1024, p.norm_mix + (2 * e + 1) * 1024, 0, scr, r % I_INO, lane); continue; } r -= 2 * I_INO;
        if (r < 2 * I_OUT) { const int e = r / I_OUT; transpose_item(p.w_out_odd + (size_t)e * 1024 * 1024, 1024, 1024, WB + W_OUTO + (size_t)e * 1024 * 1024, nullptr, 0, scr, r % I_OUT, lane); continue; } r -= 2 * I_OUT;
        if (r < 4 * I_FIN) { const int l = r / I_FIN; transpose_item(p.w_ffn_in + (size_t)l * 1024 * 5632, 1024, 5632, WB + W_FIN + (size_t)l * 5632 * 1024, p.norm_ffn + l * 1024, 1, scr, r % I_FIN, lane); continue; } r -= 4 * I_FIN;
        { const int l = r / I_FOUT; transpose_item(p.w_ffn_out + (size_t)l * 2816 * 1024, 2816, 1024, WB + W_FOUT + (size_t)l * 1024 * 2816, nullptr, 0, scr, r % I_FOUT, lane); }
    }
    { const f32x4* s = (const f32x4*)p.sg_w; u32x2* d = (u32x2*)(WB + W_SGW);
      for (int i = gt; i < 2 * 8 * 128 * 128 / 4; i += NGT) { const f32x4 v = s[i]; u32x2 o; o.x = cvtpk(v[0], v[1]); o.y = cvtpk(v[2], v[3]); d[i] = o; } }
    { unsigned long long* ss0 = (unsigned long long*)(p.ws + WS_SS); bf16* hb = (bf16*)(p.ws + WS_HB);
      for (int m = gw; m < T; m += 2 * NGW) {
        const int m1 = m + NGW; const bool has1 = m1 < T;
        const f32x4* xr0 = (const f32x4*)(p.x + (size_t)m * 1024) + lane; const f32x4* xr1 = (const f32x4*)(p.x + (size_t)(has1 ? m1 : m) * 1024) + lane;
        f32x4 a[4], b[4];
#pragma unroll
        for (int j = 0; j < 4; ++j) { a[j] = xr0[64 * j]; b[j] = xr1[64 * j]; }
        float s0 = 0.f, s1 = 0.f;
        u32x2* o0 = (u32x2*)(hb + (size_t)m * 1024) + lane; u32x2* o1 = (u32x2*)(hb + (size_t)m1 * 1024) + lane;
#pragma unroll
        for (int j = 0; j < 4; ++j) { const f32x4 v = a[j]; s0 += (v[0] * v[0] + v[1] * v[1]) + (v[2] * v[2] + v[3] * v[3]); u32x2 w; w.x = cvtpk(v[0], v[1]); w.y = cvtpk(v[2], v[3]); o0[64 * j] = w; }
        if (has1) {
#pragma unroll
          for (int j = 0; j < 4; ++j) { const f32x4 v = b[j]; s1 += (v[0] * v[0] + v[1] * v[1]) + (v[2] * v[2] + v[3] * v[3]); u32x2 w; w.x = cvtpk(v[0], v[1]); w.y = cvtpk(v[2], v[3]); o1[64 * j] = w; } }
        s0 = wave_sum(s0); s1 = wave_sum(s1);
        if (lane == 0) { ss0[m] = pg8::f2ss(s0); if (has1) ss0[m1] = pg8::f2ss(s1); } } }
}

__device__ __forceinline__ void final_phase(const Params& p) {
    int tid_ = threadIdx.x; asm volatile("" : "+v"(tid_));
    const int tid = tid_, lane = tid & 63, wave = tid >> 6;
    const int gw = blockIdx.x * 8 + wave, NGW = gridDim.x * 8;
    const unsigned long long* ss = (const unsigned long long*)(p.ws + WS_SS) + (size_t)8 * T;
    const bf16* hb = (const bf16*)(p.ws + WS_HB);
    f32x4 g0[2], g1[2];
#pragma unroll
    for (int j = 0; j < 2; ++j) { const int c = j * 512 + lane * 8; g0[j] = *(const f32x4*)(p.norm_final + c); g1[j] = *(const f32x4*)(p.norm_final + c + 4); }
    for (int m0 = gw; m0 < T; m0 += 4 * NGW) {
        u32x4 w[4][2]; unsigned long long sv[4];
#pragma unroll
        for (int q = 0; q < 4; ++q) { const int m = m0 + q * NGW; const int mc = m < T ? m : m0; sv[q] = ss[mc];
#pragma unroll
            for (int j = 0; j < 2; ++j) w[q][j] = *(const u32x4*)(hb + (size_t)mc * 1024 + j * 512 + lane * 8); }
#pragma unroll
        for (int q = 0; q < 4; ++q) { const int m = m0 + q * NGW; if (m < T) { const float r = __builtin_amdgcn_rsqf(pg8::ss2f(sv[q]) * (1.0f / 1024.0f) + EPS);
#pragma unroll
            for (int j = 0; j < 2; ++j) { const int c = j * 512 + lane * 8; const u32x4 x = w[q][j];
                const f32x4 v0 = (f32x4){bflo(x.x), bfhi(x.x), bflo(x.y), bfhi(x.y)}, v1 = (f32x4){bflo(x.z), bfhi(x.z), bflo(x.w), bfhi(x.w)};
                *(f32x4*)(p.out + (size_t)m * 1024 + c) = v0 * r * g0[j]; *(f32x4*)(p.out + (size_t)m * 1024 + c + 4) = v1 * r * g1[j]; } } } }
}

namespace att {
constexpr int KVBLK = 64, LDK = 4096;
constexpr int SHM_V = 64 * 128 * 2, SHM_K = 64 * 64 * 2;
constexpr int OFF_V = 0, OFF_K = 3 * SHM_V, OFF_WS = OFF_K + 3 * SHM_K, OFF_TB = OFF_WS + 8 * 64 * 4, OFF_OST = OFF_TB + 1552, OST_PITCH = 272, OFF_END = OFF_OST + 8 * 32 * OST_PITCH;
constexpr float LOG2E = 1.4426950408889634f;
constexpr float C1 = LOG2E;
constexpr float THR2 = 8.0f * LOG2E;
#define KSWZ64(row, colB) ((row) * 128 + ((colB) ^ ((((row) >> 1) & 7) << 4)))
#define SBAR() __builtin_amdgcn_sched_barrier(0)
__device__ __forceinline__ int crow(int r, int hi) { return (r & 3) + 8 * (r >> 2) + 4 * hi; }

__device__ __forceinline__ void partialSM(f32x16& p0, f32x16& p1, float& m_reg, float& mn, float& alpha, int kt0, int qpos, int qw, int hi, const float* tb2, float cL, float cR) {
  const int rel_hi = kt0 + 63 - qw, rel_lo = kt0 - (qw + 31);
  if (rel_hi <= -91 || rel_lo >= 91) {
    const float c = (rel_hi <= -91) ? cL : cR;
    float pmax = p0[0];
#pragma unroll
    for (int r = 1; r < 16; ++r) pmax = fmaxf(pmax, p0[r]);
#pragma unroll
    for (int r = 0; r < 16; ++r) pmax = fmaxf(pmax, p1[r]);
    pmax = fmaf(pmax, C1, c);
    { auto rr = __builtin_amdgcn_permlane32_swap(__float_as_uint(pmax), __float_as_uint(pmax), false, false);
      pmax = fmaxf(__uint_as_float(rr[0]), __uint_as_float(rr[1])); }
    if (__builtin_expect(__all(pmax - m_reg <= THR2), 1)) { mn = m_reg; alpha = 1.f; }
    else { mn = fmaxf(m_reg, pmax); alpha = __builtin_amdgcn_exp2f(m_reg - mn); m_reg = mn; }
    const float cm = c - mn;
#pragma unroll
    for (int r = 0; r < 16; ++r) { p0[r] = fmaf(p0[r], C1, cm); p1[r] = fmaf(p1[r], C1, cm); }
#pragma unroll
    for (int r = 0; r < 16; ++r) p0[r] = __builtin_amdgcn_exp2f(p0[r]);
    return;
  }
  {
    const float* tp = tb2 + (kt0 - qpos + 192 + 4 * hi);
#pragma unroll
    for (int r4 = 0; r4 < 4; ++r4) {
      float ta[4], tb[4];
#pragma unroll
      for (int i = 0; i < 4; ++i) { ta[i] = tp[8 * r4 + i]; tb[i] = tp[32 + 8 * r4 + i]; }
#pragma unroll
      for (int i = 0; i < 4; ++i) { p0[4 * r4 + i] = fmaf(p0[4 * r4 + i], C1, ta[i]); p1[4 * r4 + i] = fmaf(p1[4 * r4 + i], C1, tb[i]); }
      asm volatile("" ::: "memory");
    }
  }
  float pmax = p0[0];
#pragma unroll
  for (int r = 1; r < 16; ++r) pmax = fmaxf(pmax, p0[r]);
#pragma unroll
  for (int r = 0; r < 16; ++r) pmax = fmaxf(pmax, p1[r]);
  { auto rr = __builtin_amdgcn_permlane32_swap(__float_as_uint(pmax), __float_as_uint(pmax), false, false);
    pmax = fmaxf(__uint_as_float(rr[0]), __uint_as_float(rr[1])); }
  if (__builtin_expect(__all(pmax - m_reg <= THR2), 1)) { mn = m_reg; alpha = 1.f; }
  else { mn = fmaxf(m_reg, pmax); alpha = __builtin_amdgcn_exp2f(m_reg - mn); m_reg = mn; }
#pragma unroll
  for (int r = 0; r < 16; ++r) { p0[r] = p0[r] - mn; p1[r] = p1[r] - mn; }
#pragma unroll
  for (int r = 0; r < 16; ++r) p0[r] = __builtin_amdgcn_exp2f(p0[r]);
}
__device__ __forceinline__ void finishSM(f32x16& p0, f32x16& p1, float alpha, float& l_reg, bf16x8& pa0, bf16x8& pa1, bf16x8& pa2, bf16x8& pa3) {
#pragma unroll
  for (int r = 0; r < 16; ++r) p1[r] = __builtin_amdgcn_exp2f(p1[r]);
  float ps = 0;
#pragma unroll
  for (int r = 0; r < 16; ++r) ps += p0[r];
#pragma unroll
  for (int r = 0; r < 16; ++r) ps += p1[r];
  { auto rr = __builtin_amdgcn_permlane32_swap(__float_as_uint(ps), __float_as_uint(ps), false, false);
    ps = __uint_as_float(rr[0]) + __uint_as_float(rr[1]); }
  l_reg = l_reg * alpha + ps;
#define PK4(P, BASE, OUT) do { unsigned a0 = cvtpk(P[BASE + 0], P[BASE + 1]), a1 = cvtpk(P[BASE + 2], P[BASE + 3]);   \
    unsigned b0 = cvtpk(P[BASE + 4], P[BASE + 5]), b1 = cvtpk(P[BASE + 6], P[BASE + 7]);                              \
    auto r0 = __builtin_amdgcn_permlane32_swap(a0, b0, false, false); auto r1 = __builtin_amdgcn_permlane32_swap(a1, b1, false, false); \
    u32x4 w = {r0[0], r1[0], r0[1], r1[1]}; OUT = *reinterpret_cast<bf16x8*>(&w); } while (0)
  PK4(p0, 0, pa0); PK4(p0, 8, pa1); PK4(p1, 0, pa2); PK4(p1, 8, pa3);
#undef PK4
}
__device__ __forceinline__ void qkt(f32x16& p0, f32x16& p1, const char* Ks, const bf16x8* qr, int r32, int hi) {
  bf16x8 ka[4], kb[4];
#pragma unroll
  for (int d0 = 0; d0 < 4; ++d0) { const int cb = (d0 * 16 + hi * 8) * 2;
    ka[d0] = *reinterpret_cast<const bf16x8*>(Ks + KSWZ64(r32, cb)); kb[d0] = *reinterpret_cast<const bf16x8*>(Ks + KSWZ64(32 + r32, cb)); }
  asm volatile("s_waitcnt lgkmcnt(0)" ::: "memory"); SBAR();
  p0 = f32x16{}; p1 = f32x16{};
#pragma unroll
  for (int d0 = 0; d0 < 4; ++d0) {
    p0 = __builtin_amdgcn_mfma_f32_32x32x16_bf16(ka[d0], qr[d0], p0, 0, 0, 0);
    p1 = __builtin_amdgcn_mfma_f32_32x32x16_bf16(kb[d0], qr[d0], p1, 0, 0, 0); }
}
__device__ __forceinline__ int v_st(int k, int c) { const int kk = (k & ~0xC) | ((k & 4) << 1) | ((k & 8) >> 1); return ((kk >> 3) * 4 + (c >> 5)) * 512 + ((kk & 7) * 32 + (c & 31)) * 2; }
__device__ __forceinline__ int v_rd_base(int lane) { return ((lane & 3) << 3) | (((lane >> 2) & 3) << 6) | (((lane >> 4) & 1) << 5) | (((lane >> 5) & 1) << 8); }
constexpr int v_rd_off(int d0, int ks, int half) { return d0 * 512 + ks * 4096 + half * 2048; }
template <int OFF> __device__ __forceinline__ s16x4 tr_read(int vb) {
  s16x4 r; asm volatile("ds_read_b64_tr_b16 %0, %1 offset:%2" : "=&v"(r) : "v"(vb), "i"(OFF) : "memory"); return r;
}
template <int D0> __device__ __forceinline__ void pv_one(f32x16& od, int vb, bf16x8 pa0, bf16x8 pa1, bf16x8 pa2, bf16x8 pa3) {
  const s16x4 l0 = tr_read<v_rd_off(D0, 0, 0)>(vb), h0 = tr_read<v_rd_off(D0, 0, 1)>(vb), l1 = tr_read<v_rd_off(D0, 1, 0)>(vb), h1 = tr_read<v_rd_off(D0, 1, 1)>(vb);
  const s16x4 l2 = tr_read<v_rd_off(D0, 2, 0)>(vb), h2 = tr_read<v_rd_off(D0, 2, 1)>(vb), l3 = tr_read<v_rd_off(D0, 3, 0)>(vb), h3 = tr_read<v_rd_off(D0, 3, 1)>(vb);
  asm volatile("s_waitcnt lgkmcnt(0)" ::: "memory"); SBAR();
#define PK(L, H) (bf16x8){L[0], L[1], L[2], L[3], H[0], H[1], H[2], H[3]}
  od = __builtin_amdgcn_mfma_f32_32x32x16_bf16(pa0, PK(l0, h0), od, 0, 0, 0);
  od = __builtin_amdgcn_mfma_f32_32x32x16_bf16(pa1, PK(l1, h1), od, 0, 0, 0);
  od = __builtin_amdgcn_mfma_f32_32x32x16_bf16(pa2, PK(l2, h2), od, 0, 0, 0);
  od = __builtin_amdgcn_mfma_f32_32x32x16_bf16(pa3, PK(l3, h3), od, 0, 0, 0);
#undef PK
}
__device__ __forceinline__ void pv_d0(f32x16* o, int vb, bf16x8 pa0, bf16x8 pa1, bf16x8 pa2, bf16x8 pa3) {
  pv_one<0>(o[0], vb, pa0, pa1, pa2, pa3); pv_one<1>(o[1], vb, pa0, pa1, pa2, pa3); pv_one<2>(o[2], vb, pa0, pa1, pa2, pa3); pv_one<3>(o[3], vb, pa0, pa1, pa2, pa3);
}

template <bool GRPB> __device__ __forceinline__ void attn_pass(const int pass, float* __restrict__ scr, bf16* __restrict__ mixrow, const float lam, const float* __restrict__ gsub, const float one_m_li,
                                          const bf16* __restrict__ Qb, const bf16* __restrict__ Kh, const bf16* __restrict__ Vh, int q0seq, char* lds, const float* tb2) {
  int tid_ = threadIdx.x; asm volatile("" : "+v"(tid_));
  const int tid = tid_, wid = tid >> 6, lane = tid & 63, r32 = lane & 31, hi = lane >> 5;
  char* V_lds = lds + OFF_V; char* K_lds = lds + OFF_K;
  float* ws = (float*)(lds + OFF_WS) + wid * 64; float* li_l = ws; float* al_l = ws + 32; char* ost = lds + OFF_OST + wid * (32 * OST_PITCH);
  const float cL = __uint_as_float(__builtin_amdgcn_readfirstlane(__float_as_uint(tb2[0]))), cR = __uint_as_float(__builtin_amdgcn_readfirstlane(__float_as_uint(tb2[384])));
  const int qw = __builtin_amdgcn_readfirstlane(q0seq + wid * 32), qpos = qw + r32;
  float m_reg = -1e30f, l_reg = 0; bf16x8 qr[4]; f32x16 o[4];
#pragma unroll
  for (int d = 0; d < 4; ++d) o[d] = f32x16{};
  const bf16* Qw = Qb + (long)(wid * 32 + r32) * LDK + hi * 8;
#pragma unroll
  for (int d0 = 0; d0 < 4; ++d0) qr[d0] = *(const GAS bf16x8*)(Qw + d0 * 16);
  const int sr = tid >> 4, sc = (tid & 15) * 8, vst0 = v_st(sr, sc), vst1 = v_st(32 + sr, sc);
  const int kr = tid >> 3, kc = (tid & 7) * 8, kst = KSWZ64(kr, kc * 2);
  const int vb0 = (int)(uintptr_t)V_lds + v_rd_base(lane);
  struct { bf16x8 vs0, vs1, ks0; } sr_[2];
#define SLOAD(i, k0) do { sr_[i].vs0 = *(const GAS bf16x8*)(&Vh[(long)((k0) + sr) * LDK + sc]); sr_[i].vs1 = *(const GAS bf16x8*)(&Vh[(long)((k0) + 32 + sr) * LDK + sc]); \
    sr_[i].ks0 = *(const GAS bf16x8*)(&Kh[(long)((k0) + kr) * LDK + kc]); } while (0)
#define SWRITE(b, i) do { *(bf16x8*)(V_lds + (b) * SHM_V + vst0) = sr_[i].vs0; *(bf16x8*)(V_lds + (b) * SHM_V + vst1) = sr_[i].vs1; \
    *(bf16x8*)(K_lds + (b) * SHM_K + kst) = sr_[i].ks0; } while (0)
#define SWAIT() asm volatile("s_waitcnt vmcnt(3)" ::: "memory")
#define RESC(a) do { if (__any((a) < 1.f)) { if (hi == 0) al_l[r32] = (a); asm volatile("s_waitcnt lgkmcnt(0)" ::: "memory"); \
    _Pragma("unroll") for (int d = 0; d < 4; ++d) _Pragma("unroll") for (int r = 0; r < 16; ++r) o[d][r] *= al_l[crow(r, hi)]; } } while (0)
  f32x16 pA0, pA1, pB0, pB1; float mnA, mnB, alA, alB; bf16x8 pa0, pa1, pa2, pa3; constexpr int NT = SEQ / KVBLK;
  __syncthreads();
  SLOAD(0, 0); SLOAD(1, KVBLK); asm volatile("s_waitcnt vmcnt(0)" ::: "memory"); SWRITE(0, 0); SWRITE(1, 1);
  SLOAD(0, 2 * KVBLK); asm volatile("s_waitcnt vmcnt(0)" ::: "memory"); SWRITE(2, 0); __syncthreads();
  qkt(pA0, pA1, K_lds, qr, r32, hi); partialSM(pA0, pA1, m_reg, mnA, alA, 0, qpos, qw, hi, tb2, cL, cR);
  int bm1 = 0, b0 = 1, bp1 = 2;
#define HSTEP(N0, N1, MN, AL, C0, C1, ALC, TPOS, LOADSTMT) do { \
    if constexpr (GRPB) { SBAR(); finishSM(C0, C1, ALC, l_reg, pa0, pa1, pa2, pa3); SBAR(); qkt(N0, N1, K_lds + b0 * SHM_K, qr, r32, hi); SBAR(); LOADSTMT; SBAR(); \
                partialSM(N0, N1, m_reg, MN, AL, (TPOS), qpos, qw, hi, tb2, cL, cR); SBAR(); pv_d0(o, vb0 + bm1 * SHM_V, pa0, pa1, pa2, pa3); } \
    else      { SBAR(); qkt(N0, N1, K_lds + b0 * SHM_K, qr, r32, hi); finishSM(C0, C1, ALC, l_reg, pa0, pa1, pa2, pa3); SBAR(); LOADSTMT; SBAR(); \
                pv_d0(o, vb0 + bm1 * SHM_V, pa0, pa1, pa2, pa3); partialSM(N0, N1, m_reg, MN, AL, (TPOS), qpos, qw, hi, tb2, cL, cR); } } while (0)
  for (int t = 1; t + 1 < NT; t += 2) {
    HSTEP(pB0, pB1, mnB, alB, pA0, pA1, alA, t * KVBLK, SLOAD(0, (t + 2) * KVBLK));
    __syncthreads(); SWRITE(bm1, 0);
    RESC(alB);
    { const int tmp = bm1; bm1 = b0; b0 = bp1; bp1 = tmp; }
    HSTEP(pA0, pA1, mnA, alA, pB0, pB1, alB, (t + 1) * KVBLK, if (t + 3 < NT) SLOAD(0, (t + 3) * KVBLK));
    __syncthreads(); if (t + 3 < NT) SWRITE(bm1, 0);
    RESC(alA);
    { const int tmp = bm1; bm1 = b0; b0 = bp1; bp1 = tmp; }
  }
#undef HSTEP
  SBAR(); qkt(pB0, pB1, K_lds + b0 * SHM_K, qr, r32, hi);
  finishSM(pA0, pA1, alA, l_reg, pa0, pa1, pa2, pa3); SBAR();
  pv_d0(o, vb0 + bm1 * SHM_V, pa0, pa1, pa2, pa3); partialSM(pB0, pB1, m_reg, mnB, alB, (NT - 1) * KVBLK, qpos, qw, hi, tb2, cL, cR);
  RESC(alB);
  finishSM(pB0, pB1, alB, l_reg, pa0, pa1, pa2, pa3); SBAR();
  pv_d0(o, vb0 + b0 * SHM_V, pa0, pa1, pa2, pa3);
  if (hi == 0) li_l[r32] = l_reg; asm volatile("s_waitcnt lgkmcnt(0)" ::: "memory");
  GAS f32x4* scr4 = (GAS f32x4*)(scr + (size_t)tid * 64);
  if (pass == 0) {
#pragma unroll
    for (int r4 = 0; r4 < 4; ++r4) { const f32x4 lv = *(const f32x4*)(li_l + 8 * r4 + 4 * hi);
      const f32x4 rl = (f32x4){__builtin_amdgcn_rcpf(lv[0]), __builtin_amdgcn_rcpf(lv[1]), __builtin_amdgcn_rcpf(lv[2]), __builtin_amdgcn_rcpf(lv[3])};
#pragma unroll
      for (int d0 = 0; d0 < 4; ++d0) scr4[d0 * 4 + r4] = (f32x4){o[d0][4 * r4 + 0] * rl[0], o[d0][4 * r4 + 1] * rl[1], o[d0][4 * r4 + 2] * rl[2], o[d0][4 * r4 + 3] * rl[3]}; }
  } else {
    float g[4];
#pragma unroll
    for (int d0 = 0; d0 < 4; ++d0) g[d0] = gsub[d0 * 32 + r32] * one_m_li;
#pragma unroll
    for (int r4 = 0; r4 < 4; ++r4) { const f32x4 lv = *(const f32x4*)(li_l + 8 * r4 + 4 * hi);
      f32x4 av[4];
#pragma unroll
      for (int d0 = 0; d0 < 4; ++d0) av[d0] = scr4[d0 * 4 + r4];
#pragma unroll
      for (int i = 0; i < 4; ++i) { const float rl = __builtin_amdgcn_rcpf(lv[i]) * lam; float dv[4]; float sq = 0.f;
#pragma unroll
        for (int d0 = 0; d0 < 4; ++d0) { dv[d0] = av[d0][i] - rl * o[d0][4 * r4 + i]; sq += dv[d0] * dv[d0]; }
        sq += __shfl_xor(sq, 1); sq += __shfl_xor(sq, 2); sq += __shfl_xor(sq, 4); sq += __shfl_xor(sq, 8); sq += __shfl_xor(sq, 16);
        const float rs = __builtin_amdgcn_rsqf(sq * (1.0f / 128.0f) + EPS);
        unsigned short* orow = (unsigned short*)(ost + (8 * r4 + 4 * hi + i) * OST_PITCH) + r32;
#pragma unroll
        for (int d0 = 0; d0 < 4; ++d0) orow[d0 * 32] = (unsigned short)(cvtpk(dv[d0] * rs * g[d0], 0.f) & 0xffffu); } }
    asm volatile("s_waitcnt lgkmcnt(0)" ::: "memory");
    { const int rr = lane >> 4, c16 = lane & 15; char* gdst = (char*)(mixrow + (size_t)(wid * 32 + rr) * 1024) + c16 * 16;
#pragma unroll
      for (int j = 0; j < 8; ++j) { const u32x4 w = *(const u32x4*)(ost + (4 * j + rr) * OST_PITCH + c16 * 16); *(GAS u32x4*)(gdst + (size_t)j * 8192) = w; } }
  }
#undef SLOAD
#undef SWRITE
#undef SWAIT
#undef RESC
}

__device__ __forceinline__ int rel_bucket(int rel) {
  const int ret = rel > 0 ? 16 : 0; const int n = rel < 0 ? -rel : rel;
  if (n < 8) return ret + n;
  int large = 2 + (31 - __clz(n * n)); if (large > 15) large = 15;
  return ret + large;
}

__device__ __forceinline__ void attn_phase(const Params& p, int e, char* lds) {
  int tid_ = threadIdx.x; asm volatile("" : "+v"(tid_));
  const int tid = tid_, wid = tid >> 6, lane = tid & 63, r32 = lane & 31, hi = lane >> 5;
  const bf16* big = (const bf16*)(p.ws + WS_BIG); bf16* mix = (bf16*)(p.ws + WS_MIX);
  float* scr = (float*)(p.ws + WS_ASCR) + (size_t)blockIdx.x * 32768;
  float* tb2 = (float*)(lds + OFF_TB);
  float lam, one_m_li;
  { const float a = p.lq1[e * 64 + lane] * p.lk1[e * 64 + lane], b = p.lq2[e * 64 + lane] * p.lk2[e * 64 + lane];
    const float s1 = wave_sum(a), s2 = wave_sum(b); const float li = 0.8f - 0.6f * __expf(-0.3f * (float)(2 * e));
    lam = __uint_as_float(__builtin_amdgcn_readfirstlane(__float_as_uint(__expf(s1) - __expf(s2) + li))); one_m_li = 1.0f - li; }
  int cur_h = -1;
  const bool xmap = (gridDim.x == 256);
  const int nrounds = xmap ? 4 : (BATCH * 4 * 16 + (int)gridDim.x - 1) / (int)gridDim.x;
  for (int k = 0; k < nrounds; ++k) {
    const int u = xmap ? ((((k * 16) + ((int)(blockIdx.x & 7) * 2) + (int)(blockIdx.x >> 7)) << 4) | (int)((blockIdx.x >> 3) & 15)) : ((int)blockIdx.x + k * (int)gridDim.x);
    if (u >= BATCH * 4 * 16) break;
    const int qb = u & 15, h = (u >> 4) & 3, b = u >> 6;
    if (h != cur_h) { __syncthreads(); for (int d = tid; d < 385; d += 512) tb2[d] = p.rel_bias[rel_bucket(d - 192) * 4 + h] * LOG2E; cur_h = h; __syncthreads(); }
    const long row0 = (long)b * SEQ + qb * 256;
    if (__builtin_amdgcn_readfirstlane(wid) & 1) {
      attn_pass<true>(0, scr, mix + (size_t)row0 * 1024 + h * 128, lam, p.da_subln + e * 128, one_m_li,
                big + row0 * LDK + h * 128, big + (long)b * SEQ * LDK + 512 + h * 128, big + (long)b * SEQ * LDK + 1024 + h * 128, qb * 256, lds, tb2);
      attn_pass<true>(1, scr, mix + (size_t)row0 * 1024 + h * 128, lam, p.da_subln + e * 128, one_m_li,
                big + row0 * LDK + h * 128 + 64, big + (long)b * SEQ * LDK + 512 + h * 128 + 64, big + (long)b * SEQ * LDK + 1024 + h * 128, qb * 256, lds, tb2);
    } else {
      attn_pass<false>(0, scr, mix + (size_t)row0 * 1024 + h * 128, lam, p.da_subln + e * 128, one_m_li,
                big + row0 * LDK + h * 128, big + (long)b * SEQ * LDK + 512 + h * 128, big + (long)b * SEQ * LDK + 1024 + h * 128, qb * 256, lds, tb2);
      attn_pass<false>(1, scr, mix + (size_t)row0 * 1024 + h * 128, lam, p.da_subln + e * 128, one_m_li,
                big + row0 * LDK + h * 128 + 64, big + (long)b * SEQ * LDK + 512 + h * 128 + 64, big + (long)b * SEQ * LDK + 1024 + h * 128, qb * 256, lds, tb2);
    }
  }
}
}

namespace hg {
constexpr int TB = 32;
constexpr int OFF_F = 0, OFF_Q = 16384, OFF_V = 32768, OFF_OP = 40960, OFF_END = 40960 + 65536;
__device__ __forceinline__ void hgrn_phase(const Params& p, int e, char* lds) {
  int tid_ = threadIdx.x; asm volatile("" : "+v"(tid_));
  const int tid = tid_, wave = tid >> 6, lane = tid & 63;
  const bf16* big = (const bf16*)(p.ws + WS_BIG);
  bf16* ohg = (bf16*)(p.ws + WS_HB);
  float* F = (float*)(lds + OFF_F); float* Q = (float*)(lds + OFF_Q); float* Vv = (float*)(lds + OFF_V); float* OP = (float*)(lds + OFF_OP);
  const int lt = tid >> 4, lk8 = (tid & 15) * 8;
  const int vt = (tid & 255) >> 3, vv8 = (tid & 7) * 8;
  const int vg = lane & 15, kg = wave * 4 + (lane >> 4), k0 = kg * 4, v0 = vg * 4;
  const int st = tid >> 4, sv4 = (tid & 15) * 4;
  for (int u = blockIdx.x; u < 256; u += gridDim.x) {
    const int vh = u & 1, dir = (u >> 1) & 1, h = (u >> 2) & 3, b = u >> 4;
    const float* lbsrc = dir ? p.lb_bwd : p.lb_fwd;
    float lb[8];
#pragma unroll
    for (int i = 0; i < 8; ++i) { if (e == 0) lb[i] = 0.f; else { const float a0 = lbsrc[h * 128 + lk8 + i], a1 = lbsrc[512 + h * 128 + lk8 + i]; lb[i] = 1.0f / (1.0f + __expf(a0 - a1)); } }
    const bf16* qbase = big + (size_t)b * SEQ * 4096 + 1536 + h * 128 + lk8;
    const bf16* zbase = big + (size_t)b * SEQ * 4096 + (dir ? 2560 : 2048) + h * 128 + lk8;
    const bf16* vbase = big + (size_t)b * SEQ * 4096 + 3072 + h * 128 + vh * 64 + vv8;
    bf16* obase = ohg + (size_t)dir * T * 512 + (size_t)b * SEQ * 512 + h * 128 + vh * 64 + sv4;
    f32x2 S[4][2];
#pragma unroll
    for (int i = 0; i < 4; ++i) { S[i][0] = (f32x2){0.f, 0.f}; S[i][1] = (f32x2){0.f, 0.f}; }
    u32x4 rq, rz, rv;
    { const int pos = dir ? (SEQ - 1 - lt) : lt; rq = *(const u32x4*)(qbase + (size_t)pos * 4096); rz = *(const u32x4*)(zbase + (size_t)pos * 4096);
      const int pv = dir ? (SEQ - 1 - vt) : vt; rv = (tid < 256) ? *(const u32x4*)(vbase + (size_t)pv * 4096) : (u32x4){0, 0, 0, 0}; }
    for (int blk = 0; blk < SEQ / TB; ++blk) {
      { float zf[8], qf[8];
        zf[0] = bflo(rz.x); zf[1] = bfhi(rz.x); zf[2] = bflo(rz.y); zf[3] = bfhi(rz.y); zf[4] = bflo(rz.z); zf[5] = bfhi(rz.z); zf[6] = bflo(rz.w); zf[7] = bfhi(rz.w);
        qf[0] = bflo(rq.x); qf[1] = bfhi(rq.x); qf[2] = bflo(rq.y); qf[3] = bfhi(rq.y); qf[4] = bflo(rq.z); qf[5] = bfhi(rq.z); qf[6] = bflo(rq.w); qf[7] = bfhi(rq.w);
        float ff[8];
#pragma unroll
        for (int i = 0; i < 8; ++i) { const float sg = __builtin_amdgcn_rcpf(1.0f + __builtin_amdgcn_exp2f(-1.4426950408889634f * zf[i])); ff[i] = lb[i] + (1.0f - lb[i]) * sg; }
        *(f32x4*)(F + lt * 128 + lk8) = (f32x4){ff[0], ff[1], ff[2], ff[3]}; *(f32x4*)(F + lt * 128 + lk8 + 4) = (f32x4){ff[4], ff[5], ff[6], ff[7]};
        *(f32x4*)(Q + lt * 128 + lk8) = (f32x4){qf[0], qf[1], qf[2], qf[3]}; *(f32x4*)(Q + lt * 128 + lk8 + 4) = (f32x4){qf[4], qf[5], qf[6], qf[7]};
        if (tid < 256) { *(f32x4*)(Vv + vt * 64 + vv8) = (f32x4){bflo(rv.x), bfhi(rv.x), bflo(rv.y), bfhi(rv.y)}; *(f32x4*)(Vv + vt * 64 + vv8 + 4) = (f32x4){bflo(rv.z), bfhi(rv.z), bflo(rv.w), bfhi(rv.w)}; } }
      __syncthreads();
      if (blk + 1 < SEQ / TB) { const int t1 = (blk + 1) * TB;
        const int pos = dir ? (SEQ - 1 - (t1 + lt)) : (t1 + lt); rq = *(const u32x4*)(qbase + (size_t)pos * 4096); rz = *(const u32x4*)(zbase + (size_t)pos * 4096);
        const int pv = dir ? (SEQ - 1 - (t1 + vt)) : (t1 + vt); if (tid < 256) rv = *(const u32x4*)(vbase + (size_t)pv * 4096); }
#pragma unroll 4
      for (int t = 0; t < TB; ++t) {
        const f32x4 f4 = *(const f32x4*)(F + t * 128 + k0), q4 = *(const f32x4*)(Q + t * 128 + k0), v4 = *(const f32x4*)(Vv + t * 64 + v0);
        const f32x2 va = (f32x2){v4[0], v4[1]}, vb = (f32x2){v4[2], v4[3]};
        f32x2 oa = (f32x2){0.f, 0.f}, ob = (f32x2){0.f, 0.f};
#pragma unroll
        for (int i = 0; i < 4; ++i) { const f32x2 fi = (f32x2){f4[i], f4[i]}, qi = (f32x2){q4[i], q4[i]};
          S[i][0] = fi * (S[i][0] - va) + va; S[i][1] = fi * (S[i][1] - vb) + vb;
          oa += S[i][0] * qi; ob += S[i][1] * qi; }
        float o0 = oa.x, o1 = oa.y, o2 = ob.x, o3 = ob.y;
        o0 += __shfl_xor(o0, 16); o1 += __shfl_xor(o1, 16); o2 += __shfl_xor(o2, 16); o3 += __shfl_xor(o3, 16);
        o0 += __shfl_xor(o0, 32); o1 += __shfl_xor(o1, 32); o2 += __shfl_xor(o2, 32); o3 += __shfl_xor(o3, 32);
        if (lane < 16) *(f32x4*)(OP + (wave * TB + t) * 64 + v0) = (f32x4){o0, o1, o2, o3};
      }
      __syncthreads();
      { f32x4 s = *(const f32x4*)(OP + (0 * TB + st) * 64 + sv4);
#pragma unroll
        for (int w = 1; w < 8; ++w) s += *(const f32x4*)(OP + (w * TB + st) * 64 + sv4);
        const int tt = blk * TB + st; const int pos = dir ? (SEQ - 1 - tt) : tt;
        u32x2 o; o.x = cvtpk(s[0], s[1]); o.y = cvtpk(s[2], s[3]); *(u32x2*)(obase + (size_t)pos * 512) = o; }
    }
    __syncthreads();
  }
}
__device__ __forceinline__ void hgpost_phase(const Params& p, int e) {
  int tid_ = threadIdx.x; asm volatile("" : "+v"(tid_));
  const int tid = tid_, lane = tid & 63, wave = tid >> 6;
  const int gw = blockIdx.x * 8 + wave, NGW = gridDim.x * 8;
  const bf16* big = (const bf16*)(p.ws + WS_BIG); const bf16* ohg = (const bf16*)p.out; bf16* mix = (bf16*)(p.ws + WS_MIX);
  float gn[8];
#pragma unroll
  for (int i = 0; i < 8; ++i) gn[i] = p.hg_norm[e * 128 + (lane & 15) * 8 + i];
  for (int m0 = gw; m0 < T; m0 += 4 * NGW) {
    u32x4 av[4], bv[4], gv[4];
#pragma unroll
    for (int q = 0; q < 4; ++q) { const int m = m0 + q * NGW; const int mc = m < T ? m : m0;
      av[q] = *(const u32x4*)(ohg + (size_t)mc * 512 + lane * 8); bv[q] = *(const u32x4*)(ohg + (size_t)T * 512 + (size_t)mc * 512 + lane * 8); gv[q] = *(const u32x4*)(big + (size_t)mc * 4096 + 3584 + lane * 8); }
#pragma unroll
    for (int q = 0; q < 4; ++q) { const int m = m0 + q * NGW; const u32x4 a = av[q], b = bv[q], g = gv[q];
      float s[8];
      s[0] = bflo(a.x) + bflo(b.x); s[1] = bfhi(a.x) + bfhi(b.x); s[2] = bflo(a.y) + bflo(b.y); s[3] = bfhi(a.y) + bfhi(b.y);
      s[4] = bflo(a.z) + bflo(b.z); s[5] = bfhi(a.z) + bfhi(b.z); s[6] = bflo(a.w) + bflo(b.w); s[7] = bfhi(a.w) + bfhi(b.w);
      float sq = 0.f;
#pragma unroll
      for (int i = 0; i < 8; ++i) sq += s[i] * s[i];
      sq += __shfl_xor(sq, 1); sq += __shfl_xor(sq, 2); sq += __shfl_xor(sq, 4); sq += __shfl_xor(sq, 8);
      const float rs = __builtin_amdgcn_rsqf(sq * (1.0f / 128.0f) + EPS);
      float gg[8]; gg[0] = bflo(g.x); gg[1] = bfhi(g.x); gg[2] = bflo(g.y); gg[3] = bfhi(g.y); gg[4] = bflo(g.z); gg[5] = bfhi(g.z); gg[6] = bflo(g.w); gg[7] = bfhi(g.w);
      float o[8];
#pragma unroll
      for (int i = 0; i < 8; ++i) o[i] = s[i] * rs * gn[i] * gg[i];
      u32x4 w; w.x = cvtpk(o[0], o[1]); w.y = cvtpk(o[2], o[3]); w.z = cvtpk(o[4], o[5]); w.w = cvtpk(o[6], o[7]);
      if (m < T) *(u32x4*)(mix + (size_t)m * 1024 + 512 + lane * 8) = w; }
  }
}
}


namespace hg2 {
constexpr int PQ = 272, PJ = 144;
constexpr int OFF_QD = 0, OFF_QA = 17408, OFF_KB = 34816, OFF_KS = 52224, OFF_VT = 70656, OFF_P = 79872, OFF_ST = 89088, OFF_TOT = 123904, OFF_D = 125952, OFF_END = 126464;
constexpr float L2E = 1.4426950408889634f;
__device__ __forceinline__ bf16x8 ldfrag(const char* base, int row, int pitch, int koff) { return *(const bf16x8*)(base + row * pitch + koff * 2); }
__device__ __forceinline__ void hgrn_phase(const Params& p, int e, char* lds) {
  int tid_ = threadIdx.x; asm volatile("" : "+v"(tid_));
  const int tid = tid_, wave = tid >> 6, lane = tid & 63, fr = lane & 15, fq_ = lane >> 4;
  const char* bigc = (const char*)(p.ws + WS_BIG);
  char* ohgc = (char*)p.out;
  char* QD = lds + OFF_QD; char* QA = lds + OFF_QA; char* KB = lds + OFF_KB; char* KS = lds + OFF_KS; char* VT = lds + OFF_VT; char* PP = lds + OFF_P; char* ST = lds + OFF_ST;
  char* RQ = QD; char* RZ = QA; char* RV = KB;
  float* TOT = (float*)(lds + OFF_TOT); float* DD = (float*)(lds + OFF_D);
  const int k = tid & 127, rq = tid >> 7;
  const int vv = tid & 63, jg = tid >> 6;
  const int lr0 = tid >> 4, lc8 = (tid & 15) * 8;
  const int vr = tid >> 3, vc8 = (tid & 7) * 8;
  for (int u = blockIdx.x; u < 256; u += gridDim.x) {
    const int vh = u & 1, dir = (u >> 1) & 1, h = (u >> 2) & 3, b = u >> 4;
    float lbk = 0.f;
    if (e != 0) { const float* lbsrc = dir ? p.lb_bwd : p.lb_fwd; const float a0 = lbsrc[h * 128 + k], a1 = lbsrc[512 + h * 128 + k]; lbk = 1.0f / (1.0f + __expf(a0 - a1)); }
    const int rsb = dir ? -8192 : 8192;
    const int base0 = (b * SEQ + (dir ? (SEQ - 1) : 0)) * 8192;
    const int qcol = (1536 + h * 128 + lc8) * 2, zcol = ((dir ? 2560 : 2048) + h * 128 + lc8) * 2, vcol = (3072 + h * 128 + vh * 64 + vc8) * 2;
    const int osb = dir ? -1024 : 1024;
    const int obase = dir * (T * 1024) + (b * SEQ + (dir ? (SEQ - 1) : 0)) * 1024 + (h * 128 + vh * 64) * 2;
    f32x4 Sacc[4];
#pragma unroll
    for (int i = 0; i < 4; ++i) Sacc[i] = (f32x4){0.f, 0.f, 0.f, 0.f};
    for (int i = tid; i < 64 * PQ / 16; i += 512) *(u32x4*)(ST + i * 16) = (u32x4){0, 0, 0, 0};
    u32x4 gq0, gq1, gz0, gz1, gv;
    { const int o0 = base0 + rsb * lr0, o1 = base0 + rsb * (lr0 + 32);
      gq0 = *(const GAS u32x4*)(bigc + (size_t)(unsigned)(o0 + qcol)); gq1 = *(const GAS u32x4*)(bigc + (size_t)(unsigned)(o1 + qcol));
      gz0 = *(const GAS u32x4*)(bigc + (size_t)(unsigned)(o0 + zcol)); gz1 = *(const GAS u32x4*)(bigc + (size_t)(unsigned)(o1 + zcol));
      gv = *(const GAS u32x4*)(bigc + (size_t)(unsigned)(base0 + rsb * vr + vcol)); }
    for (int c = 0; c < SEQ / 64; ++c) {
      const int pb = c & 1;
      *(u32x4*)(RQ + lr0 * PQ + lc8 * 2) = gq0; *(u32x4*)(RQ + (lr0 + 32) * PQ + lc8 * 2) = gq1;
      *(u32x4*)(RZ + lr0 * PQ + lc8 * 2) = gz0; *(u32x4*)(RZ + (lr0 + 32) * PQ + lc8 * 2) = gz1;
      *(u32x4*)(RV + vr * PJ + vc8 * 2) = gv;
      __syncthreads();
      float qf[16], kk[16], cl[16]; float run = 0.f;
#pragma unroll
      for (int i = 0; i < 16; ++i) { const int t = 16 * rq + i; const float z = bf2f(*(const unsigned short*)(RZ + t * PQ + k * 2)); qf[i] = bf2f(*(const unsigned short*)(RQ + t * PQ + k * 2));
        const float sg = __builtin_amdgcn_rcpf(1.0f + __builtin_amdgcn_exp2f(-L2E * z)); const float f = lbk + (1.0f - lbk) * sg;
        run += __builtin_amdgcn_logf(f); cl[i] = run; kk[i] = 1.0f - f; }
      TOT[rq * 128 + k] = run;
      unsigned short rvv[8];
#pragma unroll
      for (int i = 0; i < 8; ++i) rvv[i] = *(const unsigned short*)(RV + (8 * jg + i) * PJ + vv * 2);
      u32x4 vpk; vpk.x = rvv[0] | ((unsigned)rvv[1] << 16); vpk.y = rvv[2] | ((unsigned)rvv[3] << 16); vpk.z = rvv[4] | ((unsigned)rvv[5] << 16); vpk.w = rvv[6] | ((unsigned)rvv[7] << 16);
      __syncthreads();
      { const float t0 = TOT[k], t1 = TOT[128 + k], t2 = TOT[256 + k], t3 = TOT[384 + k];
        const float mid = t0 + t1, last = (t0 + t1) + (t2 + t3);
        const float off = (rq == 0) ? 0.f : (rq == 1) ? t0 : (rq == 2) ? (t0 + t1) : (t0 + t1 + t2);
        const float el = __builtin_amdgcn_exp2f(last), em = __builtin_amdgcn_exp2f(fminf(-mid, 120.f)), emi = __builtin_amdgcn_exp2f(mid);
        if (rq == 0) DD[k] = el;
        unsigned ksw[8];
#pragma unroll
        for (int i = 0; i < 16; ++i) { const float cc = off + cl[i];
          const float e1 = __builtin_amdgcn_exp2f(cc), inv1 = __builtin_amdgcn_exp2f(fminf(-cc, 120.f));
          const float ea = fminf(e1 * em, 3.6e16f);
          const float eb = fminf(inv1 * emi, 3.6e16f);
          const float es = fminf(inv1 * el, 1.0f);
          const int t = 16 * rq + i;
          const unsigned w0 = cvtpk(qf[i] * e1, qf[i] * ea), w1 = cvtpk(kk[i] * eb, kk[i] * es);
          *(unsigned short*)(QD + t * PQ + k * 2) = (unsigned short)(w0 & 0xffffu);
          *(unsigned short*)(QA + t * PQ + k * 2) = (unsigned short)(w0 >> 16);
          *(unsigned short*)(KB + t * PQ + k * 2) = (unsigned short)(w1 & 0xffffu);
          if (i & 1) ksw[i >> 1] |= (w1 & 0xffff0000u); else ksw[i >> 1] = (w1 >> 16); }
        *(u32x4*)(KS + k * PJ + rq * 32) = (u32x4){ksw[0], ksw[1], ksw[2], ksw[3]};
        *(u32x4*)(KS + k * PJ + rq * 32 + 16) = (u32x4){ksw[4], ksw[5], ksw[6], ksw[7]};
        *(u32x4*)(VT + vv * PJ + jg * 16) = vpk; }
      __syncthreads();
      if (c + 1 < SEQ / 64) { const int bc = base0 + rsb * 64 * (c + 1); const int o0 = bc + rsb * lr0, o1 = bc + rsb * (lr0 + 32);
        gq0 = *(const GAS u32x4*)(bigc + (size_t)(unsigned)(o0 + qcol)); gq1 = *(const GAS u32x4*)(bigc + (size_t)(unsigned)(o1 + qcol));
        gz0 = *(const GAS u32x4*)(bigc + (size_t)(unsigned)(o0 + zcol)); gz1 = *(const GAS u32x4*)(bigc + (size_t)(unsigned)(o1 + zcol));
        gv = *(const GAS u32x4*)(bigc + (size_t)(unsigned)(bc + rsb * vr + vcol)); }
#define HWAIT() do { asm volatile("s_waitcnt lgkmcnt(0)" ::: "memory"); __builtin_amdgcn_sched_barrier(0); } while (0)
      f32x4 oacc[2];
      { const int jt = wave >> 1, ttA = 2 * (wave & 1), ttO = wave >> 1, vtO = 2 * (wave & 1); const char* STp = ST + pb * (64 * PQ);
        bf16x8 fa[4], fb0[4], fb1[4], fq[4], fs0[4], fs1[4];
#pragma unroll
        for (int ks = 0; ks < 4; ++ks) { fa[ks] = ldfrag(KB, 16 * jt + fr, PQ, ks * 32 + fq_ * 8); fb0[ks] = ldfrag(QA, 16 * ttA + fr, PQ, ks * 32 + fq_ * 8); fb1[ks] = ldfrag(QA, 16 * (ttA + 1) + fr, PQ, ks * 32 + fq_ * 8);
          fq[ks] = ldfrag(QD, 16 * ttO + fr, PQ, ks * 32 + fq_ * 8); fs0[ks] = ldfrag(STp, 16 * vtO + fr, PQ, ks * 32 + fq_ * 8); fs1[ks] = ldfrag(STp, 16 * (vtO + 1) + fr, PQ, ks * 32 + fq_ * 8); }
        HWAIT();
        f32x4 acc0 = (f32x4){0.f, 0.f, 0.f, 0.f}, acc1 = acc0; oacc[0] = acc0; oacc[1] = acc0;
#pragma unroll
        for (int ks = 0; ks < 4; ++ks) {
          if (jt <= ttA) acc0 = __builtin_amdgcn_mfma_f32_16x16x32_bf16(fa[ks], fb0[ks], acc0, 0, 0, 0);
          if (jt <= ttA + 1) acc1 = __builtin_amdgcn_mfma_f32_16x16x32_bf16(fa[ks], fb1[ks], acc1, 0, 0, 0);
          oacc[0] = __builtin_amdgcn_mfma_f32_16x16x32_bf16(fq[ks], fs0[ks], oacc[0], 0, 0, 0);
          oacc[1] = __builtin_amdgcn_mfma_f32_16x16x32_bf16(fq[ks], fs1[ks], oacc[1], 0, 0, 0); }
        { const int j0 = 16 * jt + 4 * fq_;
          { const int tcol = 16 * ttA + fr; u32x2 w; w.x = cvtpk_c(j0 + 0 <= tcol ? acc0[0] : 0.f, j0 + 1 <= tcol ? acc0[1] : 0.f); w.y = cvtpk_c(j0 + 2 <= tcol ? acc0[2] : 0.f, j0 + 3 <= tcol ? acc0[3] : 0.f);
            *(u32x2*)(PP + tcol * PJ + j0 * 2) = w; }
          { const int tcol = 16 * (ttA + 1) + fr; u32x2 w; w.x = cvtpk_c(j0 + 0 <= tcol ? acc1[0] : 0.f, j0 + 1 <= tcol ? acc1[1] : 0.f); w.y = cvtpk_c(j0 + 2 <= tcol ? acc1[2] : 0.f, j0 + 3 <= tcol ? acc1[3] : 0.f);
            *(u32x2*)(PP + tcol * PJ + j0 * 2) = w; } } }
      { const f32x4 d4 = *(const f32x4*)(DD + 16 * wave + 4 * fq_); char* STn = ST + (pb ^ 1) * (64 * PQ);
        const bf16x8 a0 = ldfrag(KS, 16 * wave + fr, PJ, fq_ * 8), a1 = ldfrag(KS, 16 * wave + fr, PJ, 32 + fq_ * 8);
        bf16x8 v0[4], v1[4];
#pragma unroll
        for (int vt = 0; vt < 4; ++vt) { v0[vt] = ldfrag(VT, 16 * vt + fr, PJ, fq_ * 8); v1[vt] = ldfrag(VT, 16 * vt + fr, PJ, 32 + fq_ * 8); }
        HWAIT();
#pragma unroll
        for (int vt = 0; vt < 4; ++vt) { Sacc[vt] = Sacc[vt] * d4;
          Sacc[vt] = __builtin_amdgcn_mfma_f32_16x16x32_bf16(a0, v0[vt], Sacc[vt], 0, 0, 0);
          Sacc[vt] = __builtin_amdgcn_mfma_f32_16x16x32_bf16(a1, v1[vt], Sacc[vt], 0, 0, 0); }
#pragma unroll
        for (int vt = 0; vt < 4; ++vt) { u32x2 w; w.x = cvtpk_c(Sacc[vt][0], Sacc[vt][1]); w.y = cvtpk_c(Sacc[vt][2], Sacc[vt][3]);
          *(u32x2*)(STn + (16 * vt + fr) * PQ + (16 * wave + 4 * fq_) * 2) = w; } }
      __syncthreads();
      { const int tt = wave >> 1, vt0 = 2 * (wave & 1);
        bf16x8 pf[2], vf0[2], vf1[2];
#pragma unroll
        for (int ks = 0; ks < 2; ++ks) { pf[ks] = ldfrag(PP, 16 * tt + fr, PJ, ks * 32 + fq_ * 8); vf0[ks] = ldfrag(VT, 16 * vt0 + fr, PJ, ks * 32 + fq_ * 8); vf1[ks] = ldfrag(VT, 16 * (vt0 + 1) + fr, PJ, ks * 32 + fq_ * 8); }
        HWAIT();
#pragma unroll
        for (int ks = 0; ks < 2; ++ks) { oacc[0] = __builtin_amdgcn_mfma_f32_16x16x32_bf16(pf[ks], vf0[ks], oacc[0], 0, 0, 0); oacc[1] = __builtin_amdgcn_mfma_f32_16x16x32_bf16(pf[ks], vf1[ks], oacc[1], 0, 0, 0); }
#pragma unroll
        for (int n = 0; n < 2; ++n) { const int oo = obase + osb * (64 * c + 16 * tt + 4 * fq_) + (16 * (vt0 + n) + fr) * 2;
#pragma unroll
          for (int i = 0; i < 4; ++i) *(GAS unsigned short*)(ohgc + (size_t)(unsigned)(oo + osb * i)) = (unsigned short)(cvtpk_c(oacc[n][i], 0.f) & 0xffffu); } }
#undef HWAIT
    }
    __syncthreads();
  }
}
}

namespace sgu {
constexpr int VT_PITCH = 272;
constexpr int OFF_VT = 0, OFF_RS = 128 * VT_PITCH, OFF_END = OFF_RS + 512;
__device__ __forceinline__ void sgu_phase(const Params& p, int o, char* lds) {
  int tid_ = threadIdx.x; asm volatile("" : "+v"(tid_));
  const int tid = tid_, wave = tid >> 6, lane = tid & 63, fr = lane & 15, quad = lane >> 4;
  const int wr = wave >> 1, wc = wave & 1;
  const bf16* big = (const bf16*)(p.ws + WS_BIG); bf16* mix = (bf16*)(p.ws + WS_MIX);
  const bf16* Wb = (const bf16*)(p.ws + WS_W) + W_SGW + (size_t)o * 8 * 128 * 128;
  const unsigned long long* vss = (const unsigned long long*)(p.ws + WS_SS) + (size_t)(9 + o) * T;
  float* rs = (float*)(lds + OFF_RS);
  const int NU = 512 * 8, G = gridDim.x;
  const bool gfix = (G & 7) == 0;
  u32x4 wraw[4][2]; f32x4 gainv[4]; float biasv[2]; int gcur = -1;
  const int sq0 = tid >> 4, sc8 = (tid & 15) * 8;
  u32x4 vst[4];
  int u = blockIdx.x;
  if (u < NU) { const int g = u & 7; const size_t T0 = (size_t)(u >> 3) * 128;
#pragma unroll
    for (int i = 0; i < 4; ++i) vst[i] = *(const GAS u32x4*)(big + (T0 + sq0 + 32 * i) * 2048 + 1024 + g * 128 + sc8); }
  for (; u < NU; u += G) {
    const int g = u & 7, n = u >> 3; const size_t T0 = (size_t)n * 128;
    if (g != gcur) { gcur = g;
#pragma unroll
      for (int kq = 0; kq < 4; ++kq)
#pragma unroll
        for (int nt = 0; nt < 2; ++nt) wraw[kq][nt] = *(const GAS u32x4*)(Wb + ((size_t)g * 128 + wr * 32 + nt * 16 + fr) * 128 + kq * 32 + quad * 8);
#pragma unroll
      for (int mt = 0; mt < 4; ++mt) gainv[mt] = *(const f32x4*)(p.sg_norm + o * 1024 + g * 128 + wc * 64 + mt * 16 + 4 * quad);
#pragma unroll
      for (int nt = 0; nt < 2; ++nt) biasv[nt] = p.sg_b[(o * 8 + g) * 128 + wr * 32 + nt * 16 + fr]; }
    u32x2 uw[2][4];
#pragma unroll
    for (int nt = 0; nt < 2; ++nt)
#pragma unroll
      for (int mt = 0; mt < 4; ++mt) uw[nt][mt] = *(const GAS u32x2*)(big + (T0 + wr * 32 + nt * 16 + fr) * 2048 + g * 128 + wc * 64 + mt * 16 + 4 * quad);
    __syncthreads();
#pragma unroll
    for (int i = 0; i < 4; ++i) { const int q = sq0 + 32 * i; const u32x4 w = vst[i];
      unsigned short* d = (unsigned short*)(lds + OFF_VT + (sc8) * VT_PITCH + q * 2);
      d[0 * (VT_PITCH / 2)] = (unsigned short)(w.x & 0xffffu); d[1 * (VT_PITCH / 2)] = (unsigned short)(w.x >> 16);
      d[2 * (VT_PITCH / 2)] = (unsigned short)(w.y & 0xffffu); d[3 * (VT_PITCH / 2)] = (unsigned short)(w.y >> 16);
      d[4 * (VT_PITCH / 2)] = (unsigned short)(w.z & 0xffffu); d[5 * (VT_PITCH / 2)] = (unsigned short)(w.z >> 16);
      d[6 * (VT_PITCH / 2)] = (unsigned short)(w.w & 0xffffu); d[7 * (VT_PITCH / 2)] = (unsigned short)(w.w >> 16); }
    if (tid < 128) rs[tid] = __builtin_amdgcn_rsqf(pg8::ss2f(vss[T0 + tid]) * (1.0f / 1024.0f) + EPS);
    __syncthreads();
    if (u + G < NU) { const int g2 = (u + G) & 7; const size_t T2 = (size_t)((u + G) >> 3) * 128;
#pragma unroll
      for (int i = 0; i < 4; ++i) vst[i] = *(const GAS u32x4*)(big + (T2 + sq0 + 32 * i) * 2048 + 1024 + g2 * 128 + sc8); }
    f32x4 acc[4][2];
#pragma unroll
    for (int mt = 0; mt < 4; ++mt)
#pragma unroll
      for (int nt = 0; nt < 2; ++nt) acc[mt][nt] = (f32x4){0.f, 0.f, 0.f, 0.f};
#pragma unroll
    for (int kq = 0; kq < 4; ++kq) {
      const f32x4 r0 = *(const f32x4*)(rs + kq * 32 + quad * 8), r1 = *(const f32x4*)(rs + kq * 32 + quad * 8 + 4);
      bf16x8 wf[2];
#pragma unroll
      for (int nt = 0; nt < 2; ++nt) { const u32x4 w = wraw[kq][nt];
        u32x4 s; s.x = cvtpk(bflo(w.x) * r0[0], bfhi(w.x) * r0[1]); s.y = cvtpk(bflo(w.y) * r0[2], bfhi(w.y) * r0[3]); s.z = cvtpk(bflo(w.z) * r1[0], bfhi(w.z) * r1[1]); s.w = cvtpk(bflo(w.w) * r1[2], bfhi(w.w) * r1[3]);
        wf[nt] = __builtin_bit_cast(bf16x8, s); }
#pragma unroll
      for (int mt = 0; mt < 4; ++mt) { const bf16x8 vf = *(const bf16x8*)(lds + OFF_VT + (wc * 64 + mt * 16 + fr) * VT_PITCH + (kq * 32 + quad * 8) * 2);
#pragma unroll
        for (int nt = 0; nt < 2; ++nt) acc[mt][nt] = __builtin_amdgcn_mfma_f32_16x16x32_bf16(vf, wf[nt], acc[mt][nt], 0, 0, 0); }
    }
#pragma unroll
    for (int nt = 0; nt < 2; ++nt) { const int pp = wr * 32 + nt * 16 + fr;
#pragma unroll
      for (int mt = 0; mt < 4; ++mt) { const int c = g * 128 + wc * 64 + mt * 16 + 4 * quad; const u32x2 uu = uw[nt][mt];
        const f32x4 v = (f32x4){bflo(uu.x), bfhi(uu.x), bflo(uu.y), bfhi(uu.y)} * (gainv[mt] * acc[mt][nt] + biasv[nt]);
        u32x2 ow; ow.x = cvtpk(v[0], v[1]); ow.y = cvtpk(v[2], v[3]);
        *(GAS u32x2*)(mix + (T0 + pp) * 1024 + c) = ow; } }
  }
  (void)gfix;
}
}

#define XB_TMO      128
#define XB_XCNT(j)  (256  + 64 * (j))
#define XB_XSUB(j)  (1280 + 64 * (j))
#define XB_XGEN(j)  (2304 + 64 * (j))
#define XB_TOP      3328
#define XB_TOPGEN   3392
#define XCD_BAR_WORDS 3456
#define XB_SPIN_CAP (1u << 18)

__device__ __forceinline__ unsigned xb_ld(unsigned* p)              { return __hip_atomic_load(p, __ATOMIC_RELAXED, __HIP_MEMORY_SCOPE_AGENT); }
__device__ __forceinline__ unsigned xb_add(unsigned* p, unsigned v) { return __hip_atomic_fetch_add(p, v, __ATOMIC_RELAXED, __HIP_MEMORY_SCOPE_AGENT); }
__device__ __forceinline__ unsigned xb_xcc_id() { return (unsigned)__builtin_amdgcn_s_getreg((3 << 11) | 20) & 0xFu; }
#define XB_SPIN(cond, bar) do { unsigned _sp = 0; while (cond) { __builtin_amdgcn_s_sleep(1); \
    if ((++_sp & 255u) == 0u) { if (xb_ld(&(bar)[XB_TMO])) break; if (_sp > XB_SPIN_CAP) { atomicAdd(&(bar)[XB_TMO], 1u); break; } } } } while (0)

struct XcdBarrier {
    unsigned* bar; unsigned x;
    volatile LAS unsigned* st;
};

__device__ __forceinline__ XcdBarrier xcd_barrier_post(unsigned* bar, volatile LAS unsigned* st) {
    XcdBarrier b; b.bar = bar; b.x = xb_xcc_id(); b.st = st;
    if (threadIdx.x == 0) (void)xb_add(&bar[XB_XCNT(b.x)], 1u);
    return b;
}
__device__ __forceinline__ void xcd_barrier_complete(unsigned* bar, unsigned x, unsigned& nloc, unsigned& nx) {
    const unsigned G = gridDim.x * gridDim.y * gridDim.z;
    unsigned sum, cnt, mine, sp = 0u;
    for (;;) {
        sum = 0u; cnt = 0u; mine = 0u;
#pragma unroll
        for (unsigned j = 0; j < 16; ++j) { const unsigned c = xb_ld(&bar[XB_XCNT(j)]); sum += c; cnt += (c > 0u) ? 1u : 0u; mine = (j == x) ? c : mine; }
        if (sum == G) break;
        __builtin_amdgcn_s_sleep(1);
        if ((++sp & 255u) == 0u) { if (xb_ld(&bar[XB_TMO])) break; if (sp > XB_SPIN_CAP) { atomicAdd(&bar[XB_TMO], 1u); break; } }
    }
    nloc = mine > 0u ? mine : 1u; nx = cnt > 0u ? cnt : 1u;
}

__device__ __forceinline__ void xcd_barrier(const XcdBarrier& b) {
    asm volatile("s_waitcnt vmcnt(0)" ::: "memory");
    __syncthreads();
    if (threadIdx.x == 0) {
        unsigned* bar = b.bar;
        __builtin_amdgcn_s_waitcnt(0);
        unsigned nloc = b.st[0], nx = b.st[1];
        if (nloc == 0u) { xcd_barrier_complete(bar, b.x, nloc, nx); b.st[0] = nloc; b.st[1] = nx; }
        const unsigned old = xb_add(&bar[XB_XSUB(b.x)], 1u);
        const unsigned gen = old / nloc;
        if (old + 1u == (gen + 1u) * nloc) {
            __builtin_amdgcn_fence(__ATOMIC_RELEASE, "agent");
            asm volatile("s_waitcnt vmcnt(0)" ::: "memory");
            const unsigned og = xb_add(&bar[XB_TOP], 1u);
            const unsigned tg = og / nx;
            if (og + 1u == (tg + 1u) * nx) xb_add(&bar[XB_TOPGEN], 1u);
            else XB_SPIN(xb_ld(&bar[XB_TOPGEN]) == tg, bar);
            __builtin_amdgcn_fence(__ATOMIC_ACQUIRE, "agent");
            xb_add(&bar[XB_XGEN(b.x)], 1u);
            asm volatile("s_waitcnt vmcnt(0)" ::: "memory");
        } else {
            XB_SPIN(xb_ld(&bar[XB_XGEN(b.x)]) == gen, bar);
            __builtin_amdgcn_fence(__ATOMIC_ACQUIRE, "agent");
            asm volatile("s_waitcnt vmcnt(0)" ::: "memory");
        }
    }
    __syncthreads();
}

constexpr int NPHASE = 24;
__global__ void __launch_bounds__(512, 2) mega_fwd(Params pin) {
    extern __shared__ __attribute__((aligned(16))) unsigned char lds_raw[];
    PG8_LAS unsigned char* lds = (PG8_LAS unsigned char*)lds_raw;
    const int G = gridDim.x, c = blockIdx.x;
    volatile LAS unsigned* bst = (volatile LAS unsigned*)(lds + (LDS_BYTES - 64));
    if (threadIdx.x < 2) bst[threadIdx.x] = 0u;
    __syncthreads();
    const XcdBarrier xbar = xcd_barrier_post((unsigned*)(pin.ws + WS_BAR), bst);
    for (int ph = pin.ph_lo; ph < pin.ph_hi; ++ph) {
        Params p = pin;
        { unsigned long long w = (unsigned long long)pin.ws, o = (unsigned long long)pin.out; asm volatile("" : "+s"(w), "+s"(o)); p.ws = (unsigned char*)w; p.out = (float*)o; }
        unsigned char* ws = p.ws;
        bf16* WB = (bf16*)(ws + WS_W);
        bf16* hb = (bf16*)(ws + WS_HB); bf16* mix = (bf16*)(ws + WS_MIX); bf16* big = (bf16*)(ws + WS_BIG);
        unsigned long long* SS = (unsigned long long*)(ws + WS_SS);
        if (ph == 0) prologue_phase(p, lds);
        else if (ph == 23) final_phase(p);
        else {
            const int li = (ph - 1) / 11, r = (ph - 1) % 11;
            const int l = (r < 6) ? 2 * li : 2 * li + 1;
            if (r == 0) { pg8::Gemm g{hb, WB + W_INE + (size_t)li * 4096 * 1024, T, 4096, 1024}; pg8::StaticOrder S; S.init(T, 4096, G, c);
                pg8::EpiEvenIn E{big, SS + (size_t)(2 * l) * T}; pg8::gemm_phase<pg8::EpiEvenIn, pg8::StaticOrder, true, true>(lds, g, S, E); }
            else if (r == 1) { hg2::hgrn_phase(p, li, (char*)lds_raw); att::attn_phase(p, li, (char*)lds_raw); }
            else if (r == 2) { hg::hgpost_phase(p, li); }
            else if (r == 3 || r == 8) { const bf16* Wt = (r == 3) ? WB + W_OUTE + (size_t)li * 1024 * 1024 : WB + W_OUTO + (size_t)li * 1024 * 1024;
                pg8::Gemm g{mix, Wt, T, 1024, 1024}; pg8::StaticOrder S; S.init(T, 1024, G, c);
                pg8::EpiRes E{hb, SS + (size_t)(2 * l + 1) * T}; pg8::gemm_phase<pg8::EpiRes, pg8::StaticOrder, true, true>(lds, g, S, E); }
            else if (r == 4 || r == 9) { pg8::Gemm g{hb, WB + W_FIN + (size_t)l * 5632 * 1024, T, 5632, 1024}; pg8::StaticOrder S; S.init(T, 5632, G, c);
                pg8::EpiFfnIn E{big, SS + (size_t)(2 * l + 1) * T}; pg8::gemm_phase<pg8::EpiFfnIn, pg8::StaticOrder, true, true>(lds, g, S, E); }
            else if (r == 5 || r == 10) { pg8::Gemm g{big, WB + W_FOUT + (size_t)l * 1024 * 2816, T, 1024, 2816}; pg8::StaticOrder S; S.init(T, 1024, G, c);
                pg8::EpiRes E{hb, SS + (size_t)(2 * l + 2) * T}; pg8::gemm_phase<pg8::EpiRes, pg8::StaticOrder, true, true>(lds, g, S, E); }
            else if (r == 6) { pg8::Gemm g{hb, WB + W_INO + (size_t)li * 2048 * 1024, T, 2048, 1024}; pg8::StaticOrder S; S.init(T, 2048, G, c);
                pg8::EpiOddIn E{big, SS + (size_t)(2 * l) * T, SS + (size_t)(9 + li) * T}; pg8::gemm_phase<pg8::EpiOddIn, pg8::StaticOrder, true, true>(lds, g, S, E); }
            else if (r == 7) { sgu::sgu_phase(p, li, (char*)lds_raw); }
        }
        if (ph + 1 < pin.ph_hi) { if (ph == 0) cg::this_grid().sync(); else xcd_barrier(xbar); }
    }
}

#ifndef MK_MULTI
#define MK_MULTI 0
#endif
extern "C" void kernel_launch(void* const* d_in, const int* in_sizes, int n_in, void* d_out, int out_size, void* d_ws, size_t ws_size, hipStream_t stream) {
    static int grid = 0;
    if (grid == 0) {
        if (n_in != 22 || in_sizes[0] != T * D_MODEL || out_size != T * D_MODEL || ws_size < WS_END) { fprintf(stderr, "kernel_launch: unexpected shapes / workspace (n_in %d, in0 %d, out %d, ws %zu need %zu)\n", n_in, n_in > 0 ? in_sizes[0] : -1, out_size, ws_size, (size_t)WS_END); grid = -1; return; }
        int dev = 0, cus = 0, per_cu = 0;
        if (hipGetDevice(&dev) != hipSuccess || hipDeviceGetAttribute(&cus, hipDeviceAttributeMultiprocessorCount, dev) != hipSuccess) { grid = -1; return; }
        if (hipFuncSetAttribute((const void*)mega_fwd, hipFuncAttributeMaxDynamicSharedMemorySize, LDS_BYTES) != hipSuccess) { fprintf(stderr, "kernel_launch: hipFuncSetAttribute failed\n"); grid = -1; return; }
        if (hipOccupancyMaxActiveBlocksPerMultiprocessor(&per_cu, (const void*)mega_fwd, 512, LDS_BYTES) != hipSuccess || per_cu < 1) { fprintf(stderr, "kernel_launch: occupancy query says %d\n", per_cu); per_cu = 1; }
        (void)hipGetLastError();
        grid = cus * 1;
    }
    if (grid < 0) return;
    Params p{};
    const float* const* in = (const float* const*)d_in;
    p.x = in[0]; p.rel_bias = in[1]; p.norm_mix = in[2]; p.norm_ffn = in[3]; p.norm_final = in[4]; p.w_in_even = in[5]; p.w_out_even = in[6];
    p.lq1 = in[7]; p.lk1 = in[8]; p.lq2 = in[9]; p.lk2 = in[10]; p.da_subln = in[11]; p.lb_fwd = in[12]; p.lb_bwd = in[13]; p.hg_norm = in[14];
    p.w_in_odd = in[15]; p.sg_norm = in[16]; p.sg_w = in[17]; p.sg_b = in[18]; p.w_out_odd = in[19]; p.w_ffn_in = in[20]; p.w_ffn_out = in[21];
    p.out = (float*)d_out; p.ws = (unsigned char*)d_ws;
#if MK_MULTI
    for (int ph = 0; ph < NPHASE; ++ph) { p.ph_lo = ph; p.ph_hi = ph + 1; hipLaunchKernelGGL(mega_fwd, dim3(grid), dim3(512), LDS_BYTES, stream, p); }
#else
    p.ph_lo = 0; p.ph_hi = NPHASE;
    if (hipMemsetAsync((char*)d_ws + WS_BAR, 0, XCD_BAR_WORDS * 4, stream) != hipSuccess) { fprintf(stderr, "kernel_launch: memset of the barrier words failed\n"); return; }
    void* args[] = {&p};
    hipError_t e = hipLaunchCooperativeKernel((const void*)mega_fwd, dim3(grid), dim3(512), args, LDS_BYTES, stream);
    if (e != hipSuccess) fprintf(stderr, "cooperative launch failed: %s (grid %d)\n", hipGetErrorString(e), grid);
#endif
}
```

```cpp
#include <hip/hip_runtime.h>
#include <hip/hip_cooperative_groups.h>
#include <cstdio>
#include <cstdint>
namespace cg = cooperative_groups;
namespace pg8 {
#define PG8_LAS __attribute__((address_space(3)))
typedef unsigned short bf16_t;
typedef short bf16x8 __attribute__((ext_vector_type(8)));
typedef float f32x4 __attribute__((ext_vector_type(4)));
typedef unsigned u32x4 __attribute__((ext_vector_type(4)));
constexpr int BM = 256, BK = 64, HALF = 128, HTB = HALF * BK * 2  , STAGE_BYTES = 8 * HTB, NXCD = 8, WGM = 8;

__host__ __device__ __forceinline__ int lds_byte(int r, int c) { const int st = (r >> 4) * 2 + (c >> 5), rr = r & 15, cc = c & 31, ob = rr * 64 + cc * 2; return st * 1024 + (ob ^ (((ob >> 9) & 1) << 5)); }
__host__ __device__ __forceinline__ void stage_rc(int b, int& R, int& C) { const int st = b / 1024, sb = b % 1024, swz = sb ^ (((sb >> 9) & 1) << 5); R = (st >> 1) * 16 + swz / 64; C = (st & 1) * 32 + (swz % 64) / 2; }
__host__ __device__ __forceinline__ int perm32(int rho) { const int n = rho >> 4, i = rho & 15; return 8 * (i >> 2) + 4 * n + (i & 3); }

struct Unit { int pm, pn; };
struct Gemm { const bf16_t* A; const bf16_t* Bt; int M, N, K; };

struct StaticOrder {
    int nM, nN, nwg, G, c;
    __host__ __device__ void init(int M, int N, int G_, int c_) { nM = M / BM; nN = N / BM; nwg = nM * nN; G = G_; c = c_; }
    __host__ __device__ bool next(int i, Unit& u) const {
        const long L = (long)i * G + c; if (L >= nwg) return false;
        int wgid = (int)L; { const int q = nwg / NXCD, r = nwg % NXCD, xcd = wgid % NXCD, off = wgid / NXCD; wgid = (xcd < r ? xcd * (q + 1) : r * (q + 1) + (xcd - r) * q) + off; }
        const int nig = WGM * nN, gid = wgid / nig, fm = gid * WGM, gsz = (nM - fm) < WGM ? (nM - fm) : WGM;
        u.pm = fm + ((wgid % nig) % gsz); u.pn = (wgid % nig) / gsz; return true;
    }
    __device__ __forceinline__ void a_ready(const Unit&) const {}
    __device__ __forceinline__ void done(const Unit&) const {}
};

__device__ __forceinline__ unsigned cvt_pk_bf16(float lo, float hi) { unsigned r; asm volatile("v_cvt_pk_bf16_f32 %0, %1, %2" : "=v"(r) : "v"(lo), "v"(hi)); return r; }
typedef float f32x2 __attribute__((ext_vector_type(2)));
__device__ __forceinline__ f32x2 gelu_pk(f32x2 v) {
    const f32x2 av = __builtin_elementwise_abs(v), d = av * 0.2316418882f + 1.0f;
    f32x2 t; t.x = __builtin_amdgcn_rcpf(d.x); t.y = __builtin_amdgcn_rcpf(d.y);
    f32x2 q = t * 0.5307027145f + (-0.7265760135f); q = q * t + 0.7107068705f; q = q * t + (-0.142248368f); q = q * t + 0.127414796f; q = q * t;
    const f32x2 s = (v * v) * (-0.72134752044f);
    f32x2 e; e.x = __builtin_amdgcn_exp2f(s.x); e.y = __builtin_amdgcn_exp2f(s.y);
    const f32x2 m = v * (q * e), r = v - m;
    f32x2 o; o.x = v.x < 0.f ? m.x : r.x; o.y = v.y < 0.f ? m.y : r.y; return o;
}

constexpr float RMS_EPS = 1e-6f;
__device__ __forceinline__ float ss2f(unsigned long long v) { return (float)v * (1.0f / 16777216.0f); }
__device__ __forceinline__ unsigned long long f2ss(float v) { return (unsigned long long)(v * 16777216.0f); }
struct PreSS { unsigned long long v0, v1; };
struct PreNone {};
__device__ __forceinline__ void prefetch_ss(PreSS& p, const unsigned long long* ss, const Unit& u, int wr, int fr, int fq) {
    const int k0 = 2 * fq, k1 = 2 * fq + 1, base = u.pm * BM + wr * 64 + fr;
    p.v0 = *(const __attribute__((address_space(1))) unsigned long long*)(ss + base + (k0 >> 2) * HALF + (k0 & 3) * 16);
    p.v1 = *(const __attribute__((address_space(1))) unsigned long long*)(ss + base + (k1 >> 2) * HALF + (k1 & 3) * 16);
}
__device__ __forceinline__ void rstd8(float (&r)[8], const PreSS& p, int fr) {
    const float a = __builtin_amdgcn_rsqf(ss2f(p.v0) * (1.0f / 1024.0f) + RMS_EPS), b = __builtin_amdgcn_rsqf(ss2f(p.v1) * (1.0f / 1024.0f) + RMS_EPS);
#pragma unroll
    for (int k = 0; k < 8; ++k) r[k] = __shfl((k & 1) ? b : a, fr + 16 * (k >> 1));
}
__device__ __forceinline__ float silu1(float v) { return v * __builtin_amdgcn_rcpf(1.0f + __builtin_amdgcn_exp2f(-1.4426950408889634f * v)); }
__device__ __forceinline__ f32x4 silu4(f32x4 v) { return (f32x4){silu1(v[0]), silu1(v[1]), silu1(v[2]), silu1(v[3])}; }
__device__ __forceinline__ u32x4 pack8(f32x4 v0, f32x4 v1) { u32x4 w; w.x = cvt_pk_bf16(v0[0], v0[1]); w.y = cvt_pk_bf16(v0[2], v0[3]); w.z = cvt_pk_bf16(v1[0], v1[1]); w.w = cvt_pk_bf16(v1[2], v1[3]); return w; }

struct EpiEvenIn {
    static constexpr bool PERM = true, AFTER_DRAIN = false;
    bf16_t* O; const unsigned long long* ss;
    typedef PreSS Pre;
    __device__ __forceinline__ void prefetch(Pre& p, const Unit& u, int wr, int fr, int fq) const { prefetch_ss(p, ss, u, wr, fr, fq); }
    __device__ __forceinline__ void operator()(const f32x4 (&acc)[2][2][4][2], const Unit& u, int wr, int wc, int fr, int fq, const Pre& pre) const {
        const int row0 = u.pm * BM + wr * 64 + fr, col0 = u.pn * BM + wc * 32 + 8 * fq;
        float rs8[8]; rstd8(rs8, pre, fr);
        const bool act = (u.pn == 6) || (u.pn == 7) || (u.pn == 14) || (u.pn == 15);
        const float sc = (u.pn < 2) ? 0.125f : 1.0f;
#pragma unroll
        for (int ai = 0; ai < 2; ++ai)
#pragma unroll
            for (int m = 0; m < 4; ++m) { const int row = row0 + ai * HALF + m * 16; const float r = rs8[ai * 4 + m] * sc;
                bf16_t* rowp = O + (size_t)row * 4096 + col0;
#pragma unroll
                for (int bj = 0; bj < 2; ++bj) { f32x4 v0 = acc[ai][bj][m][0] * r, v1 = acc[ai][bj][m][1] * r;
                    if (act) { v0 = silu4(v0); v1 = silu4(v1); }
                    *(u32x4*)(rowp + bj * HALF) = pack8(v0, v1); } }
    }
};
struct EpiOddIn {
    static constexpr bool PERM = true, AFTER_DRAIN = false;
    bf16_t* O; const unsigned long long* ss; unsigned long long* vss;
    typedef PreSS Pre;
    __device__ __forceinline__ void prefetch(Pre& p, const Unit& u, int wr, int fr, int fq) const { prefetch_ss(p, ss, u, wr, fr, fq); }
    __device__ __forceinline__ void operator()(const f32x4 (&acc)[2][2][4][2], const Unit& u, int wr, int wc, int fr, int fq, const Pre& pre) const {
        const int row0 = u.pm * BM + wr * 64 + fr, col0 = u.pn * BM + wc * 32 + 8 * fq;
        float rs8[8]; rstd8(rs8, pre, fr);
        const bool isv = u.pn >= 4;
#pragma unroll
        for (int ai = 0; ai < 2; ++ai)
#pragma unroll
            for (int m = 0; m < 4; ++m) { const int row = row0 + ai * HALF + m * 16; const float r = rs8[ai * 4 + m];
                bf16_t* rowp = O + (size_t)row * 2048 + col0; float sq = 0.f;
#pragma unroll
                for (int bj = 0; bj < 2; ++bj) { f32x4 v0 = acc[ai][bj][m][0] * r, v1 = acc[ai][bj][m][1] * r;
                    f32x2 a = gelu_pk((f32x2){v0[0], v0[1]}), b = gelu_pk((f32x2){v0[2], v0[3]}), c = gelu_pk((f32x2){v1[0], v1[1]}), d = gelu_pk((f32x2){v1[2], v1[3]});
                    v0 = (f32x4){a.x, a.y, b.x, b.y}; v1 = (f32x4){c.x, c.y, d.x, d.y};
                    sq += (v0[0] * v0[0] + v0[1] * v0[1]) + (v0[2] * v0[2] + v0[3] * v0[3]) + (v1[0] * v1[0] + v1[1] * v1[1]) + (v1[2] * v1[2] + v1[3] * v1[3]);
                    *(u32x4*)(rowp + bj * HALF) = pack8(v0, v1); }
                if (isv) { sq += __shfl_xor(sq, 16); sq += __shfl_xor(sq, 32); if (fq == 0) atomicAdd(vss + row, f2ss(sq)); } }
    }
};
struct EpiFfnIn {
    static constexpr bool PERM = true, AFTER_DRAIN = false;
    bf16_t* O; const unsigned long long* ss;
    typedef PreSS Pre;
    __device__ __forceinline__ void prefetch(Pre& p, const Unit& u, int wr, int fr, int fq) const { prefetch_ss(p, ss, u, wr, fr, fq); }
    __device__ __forceinline__ void operator()(const f32x4 (&acc)[2][2][4][2], const Unit& u, int wr, int wc, int fr, int fq, const Pre& pre) const {
        const int row0 = u.pm * BM + wr * 64 + fr, col0 = u.pn * HALF + wc * 32 + 8 * fq;
        float rs8[8]; rstd8(rs8, pre, fr);
#pragma unroll
        for (int ai = 0; ai < 2; ++ai)
#pragma unroll
            for (int m = 0; m < 4; ++m) { const int row = row0 + ai * HALF + m * 16; const float r = rs8[ai * 4 + m];
                const f32x4 g0 = silu4(acc[ai][0][m][0] * r), g1 = silu4(acc[ai][0][m][1] * r);
                const f32x4 v0 = g0 * (acc[ai][1][m][0] * r), v1 = g1 * (acc[ai][1][m][1] * r);
                *(u32x4*)(O + (size_t)row * 2816 + col0) = pack8(v0, v1); }
    }
};
struct EpiRes {
    static constexpr bool PERM = true, AFTER_DRAIN = false;
    bf16_t* hb; unsigned long long* ssn;
    typedef PreNone Pre;
    __device__ __forceinline__ void prefetch(Pre&, const Unit&, int, int, int) const {}
    __device__ __forceinline__ void operator()(const f32x4 (&acc)[2][2][4][2], const Unit& u, int wr, int wc, int fr, int fq, const Pre&) const {
        const int row0 = u.pm * BM + wr * 64 + fr, col0 = u.pn * BM + wc * 32 + 8 * fq;
#pragma unroll
        for (int ai = 0; ai < 2; ++ai)
#pragma unroll
            for (int m = 0; m < 4; ++m) { const int row = row0 + ai * HALF + m * 16; const size_t off = (size_t)row * 1024 + col0; float sq = 0.f;
#pragma unroll
                for (int bj = 0; bj < 2; ++bj) { const u32x4 bw = *(const u32x4*)(hb + off + bj * HALF);
                    const f32x4 b0 = (f32x4){__uint_as_float(bw.x << 16), __uint_as_float(bw.x & 0xffff0000u), __uint_as_float(bw.y << 16), __uint_as_float(bw.y & 0xffff0000u)};
                    const f32x4 b1 = (f32x4){__uint_as_float(bw.z << 16), __uint_as_float(bw.z & 0xffff0000u), __uint_as_float(bw.w << 16), __uint_as_float(bw.w & 0xffff0000u)};
                    const f32x4 v0 = acc[ai][bj][m][0] + b0, v1 = acc[ai][bj][m][1] + b1;
                    *(u32x4*)(hb + off + bj * HALF) = pack8(v0, v1);
                    sq += (v0[0] * v0[0] + v0[1] * v0[1]) + (v0[2] * v0[2] + v0[3] * v0[3]) + (v1[0] * v1[0] + v1[1] * v1[1]) + (v1[2] * v1[2] + v1[3] * v1[3]); }
                sq += __shfl_xor(sq, 16); sq += __shfl_xor(sq, 32); if (fq == 0) atomicAdd(ssn + row, f2ss(sq)); }
    }
};
template <class Epi, class Sched, bool ALIGN_EPI = false, bool SP2 = false>
__device__ __forceinline__ void gemm_phase(PG8_LAS unsigned char* lds, const Gemm g, const Sched& S, const Epi& E) {
    int tid_ = threadIdx.x; asm volatile("" : "+v"(tid_));
    const int tid = tid_, wid = __builtin_amdgcn_readfirstlane(tid >> 6), lane = tid & 63, wr = wid >> 2, wc = wid & 3, fr = lane & 15, fq = lane >> 4;
    const int K = g.K, nt = K / BK;
    unsigned voffA[2], voffB[2];
#pragma unroll
    for (int i = 0; i < 2; ++i) { int R, C; stage_rc(tid * 16 + i * 8192, R, C); const int Rb = Epi::PERM ? ((R & ~31) + perm32(R & 31)) : R;
        voffA[i] = (unsigned)(R * K + C) * 2u; voffB[i] = (unsigned)(Rb * K + C) * 2u; }
    const size_t kstep = (size_t)(BK * 2);
    const size_t hstep = (size_t)HALF * K * 2;
    const size_t tstep = 2 * hstep;
    const unsigned ldsw = (unsigned)wid * 1024u;
    const int aoff = lds_byte(wr * 64 + fr, fq * 8), boff = lds_byte(wc * 32 + fr, fq * 8);
#define PG8_SA(b, h) (((b) * 2 + (h)) * HTB)
#define PG8_SB(b, h) ((4 + (b) * 2 + (h)) * HTB)
#define PG8_STAGE(bufoff, gbase, voff) do { _Pragma("unroll") for (int _i = 0; _i < 2; ++_i) \
        __builtin_amdgcn_global_load_lds((const unsigned*)((const char*)(gbase) + (voff)[_i]), (PG8_LAS unsigned*)(lds + (bufoff) + ldsw + _i * 8192), 16, 0, 0); } while (0)
#define PG8_LDA(dst, b, h) do { _Pragma("unroll") for (int m = 0; m < 4; ++m) _Pragma("unroll") for (int k = 0; k < 2; ++k) dst[m][k] = *(const PG8_LAS bf16x8*)(lds + PG8_SA(b, h) + aoff + m * 2048 + k * 1024); } while (0)
#define PG8_LDB(dst, b, h) do { _Pragma("unroll") for (int n = 0; n < 2; ++n) _Pragma("unroll") for (int k = 0; k < 2; ++k) dst[n][k] = *(const PG8_LAS bf16x8*)(lds + PG8_SB(b, h) + boff + n * 2048 + k * 1024); } while (0)
#define PG8_MMA(ai, bj, At, Bt) do { __builtin_amdgcn_s_setprio(1); _Pragma("unroll") for (int m = 0; m < 4; ++m) _Pragma("unroll") for (int n = 0; n < 2; ++n) _Pragma("unroll") for (int k = 0; k < 2; ++k) \
        acc[ai][bj][m][n] = __builtin_amdgcn_mfma_f32_16x16x32_bf16(Bt[n][k], At[m][k], acc[ai][bj][m][n], 0, 0, 0); __builtin_amdgcn_s_setprio(0); } while (0)
#define PG8_WAIT_V(n) asm volatile("s_waitcnt vmcnt(" #n ")" ::: "memory")
#define PG8_WAIT_L(n) asm volatile("s_waitcnt lgkmcnt(" #n ")" ::: "memory")
#define PG8_BAR __builtin_amdgcn_s_barrier()
#define PG8_SCHED __builtin_amdgcn_sched_barrier(0)
    Unit cur, nxt; int ui = 0;
    if (!S.next(0, cur)) return;
    f32x4 acc[2][2][4][2];
#pragma unroll
    for (int a = 0; a < 2; ++a)
#pragma unroll
        for (int b = 0; b < 2; ++b)
#pragma unroll
            for (int m = 0; m < 4; ++m)
#pragma unroll
                for (int n = 0; n < 2; ++n) acc[a][b][m][n] = (f32x4){0.f, 0.f, 0.f, 0.f};
    bf16x8 At[4][2], B0[2][2], B1[2][2];
    const char* cA = (const char*)g.A + (size_t)cur.pm * tstep; const char* cB = (const char*)g.Bt + (size_t)cur.pn * tstep;
    S.a_ready(cur);
    if constexpr (SP2) {
        PG8_STAGE(PG8_SB(0, 0), cB, voffB); PG8_STAGE(PG8_SB(0, 1), cB + hstep, voffB); PG8_STAGE(PG8_SA(0, 0), cA, voffA); PG8_STAGE(PG8_SA(0, 1), cA + hstep, voffA);
        if (wr == 1) PG8_BAR;
        PG8_WAIT_V(2); PG8_BAR;
        PG8_STAGE(PG8_SB(1, 0), cB + kstep, voffB); PG8_STAGE(PG8_SA(1, 0), cA + kstep, voffA); PG8_STAGE(PG8_SB(1, 1), cB + hstep + kstep, voffB);
        PG8_WAIT_V(6); PG8_BAR;
    } else {
        PG8_STAGE(PG8_SB(0, 0), cB, voffB); PG8_STAGE(PG8_SA(0, 0), cA, voffA); PG8_STAGE(PG8_SB(0, 1), cB + hstep, voffB); PG8_STAGE(PG8_SA(0, 1), cA + hstep, voffA);
        if (wr == 1) PG8_BAR;
        PG8_WAIT_V(4); PG8_BAR;
        PG8_STAGE(PG8_SB(1, 0), cB + kstep, voffB); PG8_STAGE(PG8_SA(1, 0), cA + kstep, voffA); PG8_STAGE(PG8_SB(1, 1), cB + hstep + kstep, voffB);
        PG8_WAIT_V(6); PG8_BAR;
    }
    for (;;) {
        const bool has_next = S.next(ui + 1, nxt);
        typename Epi::Pre pre; E.prefetch(pre, cur, wr, fr, fq);
        const char* nA = has_next ? (const char*)g.A + (size_t)nxt.pm * tstep : cA; const char* nB = has_next ? (const char*)g.Bt + (size_t)nxt.pn * tstep : cB;
        for (int t = 0; t < nt; t += 2) {
            const bool last = (t == nt - 2);
            const char* a1 = cA + (size_t)(t + 1) * kstep;
            const char* a2 = last ? nA : cA + (size_t)(t + 2) * kstep; const char* b2 = last ? nB : cB + (size_t)(t + 2) * kstep;
            const char* a3 = a2 + kstep; const char* b3 = b2 + kstep;
            if (last && has_next) S.a_ready(nxt);
            if constexpr (SP2) {
            PG8_LDB(B0, 0, 0); PG8_LDB(B1, 0, 1); PG8_SCHED; PG8_LDA(At, 0, 0); PG8_STAGE(PG8_SA(1, 1), a1 + hstep, voffA);
            PG8_WAIT_V(8); PG8_WAIT_L(0); PG8_BAR; PG8_MMA(0, 0, At, B0); PG8_MMA(0, 1, At, B1); PG8_BAR; PG8_SCHED;
            PG8_LDA(At, 0, 1); PG8_STAGE(PG8_SB(0, 0), b2, voffB); PG8_STAGE(PG8_SB(0, 1), b2 + hstep, voffB); PG8_STAGE(PG8_SA(0, 0), a2, voffA);
            PG8_WAIT_V(8); PG8_WAIT_L(0); PG8_BAR; PG8_MMA(1, 0, At, B0); PG8_MMA(1, 1, At, B1); PG8_BAR; PG8_SCHED;
            PG8_LDB(B0, 1, 0); PG8_LDB(B1, 1, 1); PG8_SCHED; PG8_LDA(At, 1, 0); PG8_STAGE(PG8_SA(0, 1), a2 + hstep, voffA);
            PG8_WAIT_V(8); PG8_WAIT_L(0); PG8_BAR; PG8_MMA(0, 0, At, B0); PG8_MMA(0, 1, At, B1); PG8_BAR; PG8_SCHED;
            PG8_LDA(At, 1, 1); PG8_STAGE(PG8_SB(1, 0), b3, voffB); PG8_STAGE(PG8_SB(1, 1), b3 + hstep, voffB); PG8_STAGE(PG8_SA(1, 0), a3, voffA);
            PG8_WAIT_V(8); PG8_WAIT_L(0); PG8_BAR; PG8_MMA(1, 0, At, B0); PG8_MMA(1, 1, At, B1); PG8_BAR; PG8_SCHED;
            } else {
            PG8_LDB(B0, 0, 0); PG8_SCHED; PG8_LDA(At, 0, 0); PG8_STAGE(PG8_SA(1, 1), a1 + hstep, voffA);
            PG8_WAIT_L(8); PG8_BAR; PG8_WAIT_L(0); PG8_MMA(0, 0, At, B0); PG8_BAR; PG8_SCHED;
            PG8_LDB(B1, 0, 1); PG8_STAGE(PG8_SB(0, 0), b2, voffB);
            PG8_BAR; PG8_WAIT_L(0); PG8_MMA(0, 1, At, B1); PG8_BAR;
            PG8_LDA(At, 0, 1); PG8_STAGE(PG8_SA(0, 0), a2, voffA);
            PG8_BAR; PG8_WAIT_L(0); PG8_MMA(1, 0, At, B0); PG8_BAR; PG8_SCHED;
            PG8_STAGE(PG8_SB(0, 1), b2 + hstep, voffB);
            PG8_WAIT_V(6); PG8_BAR; PG8_MMA(1, 1, At, B1); PG8_BAR;
            PG8_LDB(B0, 1, 0); PG8_SCHED; PG8_LDA(At, 1, 0); PG8_STAGE(PG8_SA(0, 1), a2 + hstep, voffA);
            PG8_WAIT_L(8); PG8_BAR; PG8_WAIT_L(0); PG8_MMA(0, 0, At, B0); PG8_BAR; PG8_SCHED;
            PG8_LDB(B1, 1, 1); PG8_STAGE(PG8_SB(1, 0), b3, voffB);
            PG8_BAR; PG8_WAIT_L(0); PG8_MMA(0, 1, At, B1); PG8_BAR;
            PG8_LDA(At, 1, 1); PG8_STAGE(PG8_SA(1, 0), a3, voffA);
            PG8_BAR; PG8_WAIT_L(0); PG8_MMA(1, 0, At, B0); PG8_BAR; PG8_SCHED;
            PG8_STAGE(PG8_SB(1, 1), b3 + hstep, voffB);
            PG8_WAIT_V(6); PG8_BAR; PG8_MMA(1, 1, At, B1); PG8_BAR;
            }
        }
        if constexpr (ALIGN_EPI) { if (wr == 0) PG8_BAR; }
        if constexpr (!Epi::AFTER_DRAIN) { E(acc, cur, wr, wc, fr, fq, pre); S.done(cur); }
        if (!has_next) break;
#pragma unroll
        for (int a = 0; a < 2; ++a)
#pragma unroll
            for (int b = 0; b < 2; ++b)
#pragma unroll
                for (int m = 0; m < 4; ++m)
#pragma unroll
                    for (int n = 0; n < 2; ++n) acc[a][b][m][n] = (f32x4){0.f, 0.f, 0.f, 0.f};
        cur = nxt; cA = nA; cB = nB; ++ui;
        if constexpr (ALIGN_EPI) { if (wr == 1) PG8_BAR; }
    }
    PG8_WAIT_V(0);
    if constexpr (!ALIGN_EPI) { if (wr == 0) PG8_BAR; }
    PG8_BAR;
    if constexpr (Epi::AFTER_DRAIN) { E.fused(acc, cur, wr, wc, fr, fq, lds, wid, lane); S.done(cur); }
#undef PG8_SA
#undef PG8_SB
#undef PG8_STAGE
#undef PG8_LDA
#undef PG8_LDB
#undef PG8_MMA
#undef PG8_WAIT_V
#undef PG8_WAIT_L
#undef PG8_BAR
#undef PG8_SCHED
}
}

constexpr int D_MODEL = 1024, BATCH = 16, SEQ = 4096, T = BATCH * SEQ, DFF = 2816, DEPTH = 4;
constexpr int EVEN_IN = 4096, ODD_IN = 2048;
constexpr float EPS = 1e-6f;
typedef unsigned short bf16;
typedef unsigned u32x4 __attribute__((ext_vector_type(4)));
typedef unsigned u32x2 __attribute__((ext_vector_type(2)));
typedef float f32x4 __attribute__((ext_vector_type(4)));
typedef float f32x2 __attribute__((ext_vector_type(2)));
typedef float f32x8 __attribute__((ext_vector_type(8)));
typedef float f32x16 __attribute__((ext_vector_type(16)));
typedef short bf16x8 __attribute__((ext_vector_type(8)));
typedef short s16x4 __attribute__((ext_vector_type(4)));
#define LAS __attribute__((address_space(3)))
#define GAS __attribute__((address_space(1)))

constexpr size_t MiB = 1u << 20;
constexpr size_t WS_SS = 0;
constexpr size_t WS_BAR = 6 * MiB;
constexpr size_t WS_W = 8 * MiB;
constexpr size_t W_INE = 0, W_OUTE = W_INE + 2ull * 4096 * 1024, W_INO = W_OUTE + 2ull * 1024 * 1024, W_OUTO = W_INO + 2ull * 2048 * 1024,
                 W_FIN = W_OUTO + 2ull * 1024 * 1024, W_FOUT = W_FIN + 4ull * 5632 * 1024, W_SGW = W_FOUT + 4ull * 1024 * 2816, W_END = W_SGW + 2ull * 8 * 128 * 128;
static_assert(WS_W + W_END * 2 <= 108 * MiB, "weights");
constexpr size_t WS_ASCR = 108 * MiB;
constexpr size_t WS_HB = 140 * MiB;
constexpr size_t WS_MIX = 268 * MiB;
constexpr size_t WS_BIG = 396 * MiB;
constexpr size_t WS_END = 908 * MiB;
constexpr int LDS_BYTES = 147456;

struct Params {
    const float* x; const float* rel_bias; const float* norm_mix; const float* norm_ffn; const float* norm_final; const float* w_in_even; const float* w_out_even;
    const float* lq1; const float* lk1; const float* lq2; const float* lk2; const float* da_subln; const float* lb_fwd; const float* lb_bwd; const float* hg_norm;
    const float* w_in_odd; const float* sg_norm; const float* sg_w; const float* sg_b; const float* w_out_odd; const float* w_ffn_in; const float* w_ffn_out;
    float* out; unsigned char* ws; int ph_lo, ph_hi;
};

__device__ __forceinline__ unsigned cvtpk(float lo, float hi) { unsigned r; asm volatile("v_cvt_pk_bf16_f32 %0, %1, %2" : "=v"(r) : "v"(lo), "v"(hi)); return r; }
typedef __bf16 bf16v2 __attribute__((ext_vector_type(2)));
__device__ __forceinline__ unsigned cvtpk_c(float lo, float hi) { bf16v2 v; v.x = (__bf16)lo; v.y = (__bf16)hi; return __builtin_bit_cast(unsigned, v); }
__device__ __forceinline__ float bf2f(unsigned short b) { return __uint_as_float(((unsigned)b) << 16); }
__device__ __forceinline__ float bflo(unsigned w) { return __uint_as_float(w << 16); }
__device__ __forceinline__ float bfhi(unsigned w) { return __uint_as_float(w & 0xffff0000u); }
__device__ __forceinline__ float wave_sum(float v) {
#pragma unroll
    for (int o = 1; o < 64; o <<= 1) v += __shfl_xor(v, o);
    return v;
}

__device__ __forceinline__ void transpose_item(const float* W, int K, int N, bf16* WT, const float* gain, int ffn_perm, LAS float* scr, int item, int lane) {
    const int nblk = N / 32, kb = item / nblk, nb = item % nblk, k0 = 64 * kb, n0 = 32 * nb;
    float wv[32];
#pragma unroll
    for (int i = 0; i < 32; ++i) { const int kk = 2 * i + (lane >> 5); wv[i] = W[(size_t)(k0 + kk) * N + n0 + (lane & 31)]; }
#pragma unroll
    for (int i = 0; i < 32; ++i) { const int kk = 2 * i + (lane >> 5); const float g = gain ? gain[k0 + kk] : 1.0f; scr[kk * 33 + (lane & 31)] = wv[i] * g; }
    asm volatile("s_waitcnt lgkmcnt(0)" ::: "memory");
    int r0 = n0;
    if (ffn_perm) { r0 = (n0 < DFF) ? ((n0 >> 7) * 256 + (n0 & 127)) : (((n0 - DFF) >> 7) * 256 + 128 + ((n0 - DFF) & 127)); }
    const int c = lane & 7;
#pragma unroll
    for (int j = 0; j < 4; ++j) { const int n = (lane >> 3) + 8 * j; const LAS float* s = scr + (8 * c) * 33 + n;
        u32x4 o; o.x = cvtpk(s[0 * 33], s[1 * 33]); o.y = cvtpk(s[2 * 33], s[3 * 33]); o.z = cvtpk(s[4 * 33], s[5 * 33]); o.w = cvtpk(s[6 * 33], s[7 * 33]);
        *(u32x4*)(WT + (size_t)(r0 + n) * K + k0 + 8 * c) = o; }
    asm volatile("s_waitcnt lgkmcnt(0)" ::: "memory");
}

__device__ __forceinline__ void prologue_phase(const Params& p, LAS unsigned char* lds) {
    int tid_ = threadIdx.x; asm volatile("" : "+v"(tid_));
    const int tid = tid_, lane = tid & 63, wave = tid >> 6;
    const int gw = blockIdx.x * 8 + wave, NGW = gridDim.x * 8;
    const int gt = blockIdx.x * 512 + tid, NGT = gridDim.x * 512;
    { f32x4* z = (f32x4*)(p.ws + WS_SS); for (int i = T / 2 + gt; i < 11 * T / 2; i += NGT) z[i] = (f32x4){0.f, 0.f, 0.f, 0.f}; }
    bf16* WB = (bf16*)(p.ws + WS_W);
    LAS float* scr = (LAS float*)(lds + wave * 16384);
    constexpr int I_INE = 16 * 128, I_OUT = 16 * 32, I_INO = 16 * 64, I_FIN = 16 * 176, I_FOUT = 44 * 32;
    constexpr int NITEMS = 2 * I_INE + 2 * I_OUT + 2 * I_INO + 2 * I_OUT + 4 * I_FIN + 4 * I_FOUT;
    for (int it = gw; it < NITEMS; it += NGW) {
        int r = it;
        if (r < 2 * I_INE) { const int e = r / I_INE; transpose_item(p.w_in_even + (size_t)e * 1024 * 4096, 1024, 4096, WB + W_INE + (size_t)e * 4096 * 1024, p.norm_mix + (2 * e) * 1024, 0, scr, r % I_INE, lane); continue; } r -= 2 * I_INE;
        if (r < 2 * I_OUT) { const int e = r / I_OUT; transpose_item(p.w_out_even + (size_t)e * 1024 * 1024, 1024, 1024, WB + W_OUTE + (size_t)e * 1024 * 1024, nullptr, 0, scr, r % I_OUT, lane); continue; } r -= 2 * I_OUT;
        if (r < 2 * I_INO) { const int e = r / I_INO; transpose_item(p.w_in_odd + (size_t)e * 1024 * 2048, 1024, 2048, WB + W_INO + (size_t)e * 2048 * 1024, p.norm_mix + (2 * e + 1) * 1024, 0, scr, r % I_INO, lane); continue; } r -= 2 * I_INO;
        if (r < 2 * I_OUT) { const int e = r / I_OUT; transpose_item(p.w_out_odd + (size_t)e * 1024 * 1024, 1024, 1024, WB + W_OUTO + (size_t)e * 1024 * 1024, nullptr, 0, scr, r % I_OUT, lane); continue; } r -= 2 * I_OUT;
        if (r < 4 * I_FIN) { const int l = r / I_FIN; transpose_item(p.w_ffn_in + (size_t)l * 1024 * 5632, 1024, 5632, WB + W_FIN + (size_t)l * 5632 * 1024, p.norm_ffn + l * 1024, 1, scr, r % I_FIN, lane); continue; } r -= 4 * I_FIN;
        { const int l = r / I_FOUT; transpose_item(p.w_ffn_out + (size_t)l * 2816 * 1024, 2816, 1024, WB + W_FOUT + (size_t)l * 1024 * 2816, nullptr, 0, scr, r % I_FOUT, lane); }
    }
    { const f32x4* s = (const f32x4*)p.sg_w; u32x2* d = (u32x2*)(WB + W_SGW);
      for (int i = gt; i < 2 * 8 * 128 * 128 / 4; i += NGT) { const f32x4 v = s[i]; u32x2 o; o.x = cvtpk(v[0], v[1]); o.y = cvtpk(v[2], v[3]); d[i] = o; } }
    { unsigned long long* ss0 = (unsigned long long*)(p.ws + WS_SS); bf16* hb = (bf16*)(p.ws + WS_HB);
      for (int m = gw; m < T; m += 2 * NGW) {
        const int m1 = m + NGW; const bool has1 = m1 < T;
        const f32x4* xr0 = (const f32x4*)(p.x + (size_t)m * 1024) + lane; const f32x4* xr1 = (const f32x4*)(p.x + (size_t)(has1 ? m1 : m) * 1024) + lane;
        f32x4 a[4], b[4];
#pragma unroll
        for (int j = 0; j < 4; ++j) { a[j] = xr0[64 * j]; b[j] = xr1[64 * j]; }
        float s0 = 0.f, s1 = 0.f;
        u32x2* o0 = (u32x2*)(hb + (size_t)m * 1024) + lane; u32x2* o1 = (u32x2*)(hb + (size_t)m1 * 1024) + lane;
#pragma unroll
        for (int j = 0; j < 4; ++j) { const f32x4 v = a[j]; s0 += (v[0] * v[0] + v[1] * v[1]) + (v[2] * v[2] + v[3] * v[3]); u32x2 w; w.x = cvtpk(v[0], v[1]); w.y = cvtpk(v[2], v[3]); o0[64 * j] = w; }
        if (has1) {
#pragma unroll
          for (int j = 0; j < 4; ++j) { const f32x4 v = b[j]; s1 += (v[0] * v[0] + v[1] * v[1]) + (v[2] * v[2] + v[3] * v[3]); u32x2 w; w.x = cvtpk(v[0], v[1]); w.y = cvtpk(v[2], v[3]); o1[64 * j] = w; } }
        s0 = wave_sum(s0); s1 = wave_sum(s1);
        if (lane == 0) { ss0[m] = pg8::f2ss(s0); if (has1) ss0[m1] = pg8::f2ss(s1); } } }
}

__device__ __forceinline__ void final_phase(const Params& p) {
    int tid_ = threadIdx.x; asm volatile("" : "+v"(tid_));
    const int tid = tid_, lane = tid & 63, wave = tid >> 6;
    const int gw = blockIdx.x * 8 + wave, NGW = gridDim.x * 8;
    const unsigned long long* ss = (const unsigned long long*)(p.ws + WS_SS) + (size_t)8 * T;
    const bf16* hb = (const bf16*)(p.ws + WS_HB);
    f32x4 g0[2], g1[2];
#pragma unroll
    for (int j = 0; j < 2; ++j) { const int c = j * 512 + lane * 8; g0[j] = *(const f32x4*)(p.norm_final + c); g1[j] = *(const f32x4*)(p.norm_final + c + 4); }
    for (int m0 = gw; m0 < T; m0 += 4 * NGW) {
        u32x4 w[4][2]; unsigned long long sv[4];
#pragma unroll
        for (int q = 0; q < 4; ++q) { const int m = m0 + q * NGW; const int mc = m < T ? m : m0; sv[q] = ss[mc];
#pragma unroll
            for (int j = 0; j < 2; ++j) w[q][j] = *(const u32x4*)(hb + (size_t)mc * 1024 + j * 512 + lane * 8); }
#pragma unroll
        for (int q = 0; q < 4; ++q) { const int m = m0 + q * NGW; if (m < T) { const float r = __builtin_amdgcn_rsqf(pg8::ss2f(sv[q]) * (1.0f / 1024.0f) + EPS);
#pragma unroll
            for (int j = 0; j < 2; ++j) { const int c = j * 512 + lane * 8; const u32x4 x = w[q][j];
                const f32x4 v0 = (f32x4){bflo(x.x), bfhi(x.x), bflo(x.y), bfhi(x.y)}, v1 = (f32x4){bflo(x.z), bfhi(x.z), bflo(x.w), bfhi(x.w)};
                *(f32x4*)(p.out + (size_t)m * 1024 + c) = v0 * r * g0[j]; *(f32x4*)(p.out + (size_t)m * 1024 + c + 4) = v1 * r * g1[j]; } } } }
}

namespace att {
constexpr int KVBLK = 64, LDK = 4096;
constexpr int SHM_V = 64 * 128 * 2, SHM_K = 64 * 64 * 2;
constexpr int OFF_V = 0, OFF_K = 3 * SHM_V, OFF_WS = OFF_K + 3 * SHM_K, OFF_TB = OFF_WS + 8 * 64 * 4, OFF_OST = OFF_TB + 1552, OST_PITCH = 272, OFF_END = OFF_OST + 8 * 32 * OST_PITCH;
constexpr float LOG2E = 1.4426950408889634f;
constexpr float C1 = LOG2E;
constexpr float THR2 = 8.0f * LOG2E;
#define KSWZ64(row, colB) ((row) * 128 + ((colB) ^ ((((row) >> 1) & 7) << 4)))
#define SBAR() __builtin_amdgcn_sched_barrier(0)
__device__ __forceinline__ int crow(int r, int hi) { return (r & 3) + 8 * (r >> 2) + 4 * hi; }

__device__ __forceinline__ void partialSM(f32x16& p0, f32x16& p1, float& m_reg, float& mn, float& alpha, int kt0, int qpos, int qw, int hi, const float* tb2, float cL, float cR) {
  const int rel_hi = kt0 + 63 - qw, rel_lo = kt0 - (qw + 31);
  if (rel_hi <= -91 || rel_lo >= 91) {
    const float c = (rel_hi <= -91) ? cL : cR;
    float pmax = p0[0];
#pragma unroll
    for (int r = 1; r < 16; ++r) pmax = fmaxf(pmax, p0[r]);
#pragma unroll
    for (int r = 0; r < 16; ++r) pmax = fmaxf(pmax, p1[r]);
    pmax = fmaf(pmax, C1, c);
    { auto rr = __builtin_amdgcn_permlane32_swap(__float_as_uint(pmax), __float_as_uint(pmax), false, false);
      pmax = fmaxf(__uint_as_float(rr[0]), __uint_as_float(rr[1])); }
    if (__builtin_expect(__all(pmax - m_reg <= THR2), 1)) { mn = m_reg; alpha = 1.f; }
    else { mn = fmaxf(m_reg, pmax); alpha = __builtin_amdgcn_exp2f(m_reg - mn); m_reg = mn; }
    const float cm = c - mn;
#pragma unroll
    for (int r = 0; r < 16; ++r) { p0[r] = fmaf(p0[r], C1, cm); p1[r] = fmaf(p1[r], C1, cm); }
#pragma unroll
    for (int r = 0; r < 16; ++r) p0[r] = __builtin_amdgcn_exp2f(p0[r]);
    return;
  }
  {
    const float* tp = tb2 + (kt0 - qpos + 192 + 4 * hi);
#pragma unroll
    for (int r4 = 0; r4 < 4; ++r4) {
      float ta[4], tb[4];
#pragma unroll
      for (int i = 0; i < 4; ++i) { ta[i] = tp[8 * r4 + i]; tb[i] = tp[32 + 8 * r4 + i]; }
#pragma unroll
      for (int i = 0; i < 4; ++i) { p0[4 * r4 + i] = fmaf(p0[4 * r4 + i], C1, ta[i]); p1[4 * r4 + i] = fmaf(p1[4 * r4 + i], C1, tb[i]); }
      asm volatile("" ::: "memory");
    }
  }
  float pmax = p0[0];
#pragma unroll
  for (int r = 1; r < 16; ++r) pmax = fmaxf(pmax, p0[r]);
#pragma unroll
  for (int r = 0; r < 16; ++r) pmax = fmaxf(pmax, p1[r]);
  { auto rr = __builtin_amdgcn_permlane32_swap(__float_as_uint(pmax), __float_as_uint(pmax), false, false);
    pmax = fmaxf(__uint_as_float(rr[0]), __uint_as_float(rr[1])); }
  if (__builtin_expect(__all(pmax - m_reg <= THR2), 1)) { mn = m_reg; alpha = 1.f; }
  else { mn = fmaxf(m_reg, pmax); alpha = __builtin_amdgcn_exp2f(m_reg - mn); m_reg = mn; }
#pragma unroll
  for (int r = 0; r < 16; ++r) { p0[r] = p0[r] - mn; p1[r] = p1[r] - mn; }
#pragma unroll
  for (int r = 0; r < 16; ++r) p0[r] = __builtin_amdgcn_exp2f(p0[r]);
}
__device__ __forceinline__ void finishSM(f32x16& p0, f32x16& p1, float alpha, float& l_reg, bf16x8& pa0, bf16x8& pa1, bf16x8& pa2, bf16x8& pa3) {
#pragma unroll
  for (int r = 0; r < 16; ++r) p1[r] = __builtin_amdgcn_exp2f(p1[r]);
  float ps = 0;
#pragma unroll
  for (int r = 0; r < 16; ++r) ps += p0[r];
#pragma unroll
  for (int r = 0; r < 16; ++r) ps += p1[r];
  { auto rr = __builtin_amdgcn_permlane32_swap(__float_as_uint(ps), __float_as_uint(ps), false, false);
    ps = __uint_as_float(rr[0]) + __uint_as_float(rr[1]); }
  l_reg = l_reg * alpha + ps;
#define PK4(P, BASE, OUT) do { unsigned a0 = cvtpk(P[BASE + 0], P[BASE + 1]), a1 = cvtpk(P[BASE + 2], P[BASE + 3]);   \
    unsigned b0 = cvtpk(P[BASE + 4], P[BASE + 5]), b1 = cvtpk(P[BASE + 6], P[BASE + 7]);                              \
    auto r0 = __builtin_amdgcn_permlane32_swap(a0, b0, false, false); auto r1 = __builtin_amdgcn_permlane32_swap(a1, b1, false, false); \
    u32x4 w = {r0[0], r1[0], r0[1], r1[1]}; OUT = *reinterpret_cast<bf16x8*>(&w); } while (0)
  PK4(p0, 0, pa0); PK4(p0, 8, pa1); PK4(p1, 0, pa2); PK4(p1, 8, pa3);
#undef PK4
}
__device__ __forceinline__ void qkt(f32x16& p0, f32x16& p1, const char* Ks, const bf16x8* qr, int r32, int hi) {
  bf16x8 ka[4], kb[4];
#pragma unroll
  for (int d0 = 0; d0 < 4; ++d0) { const int cb = (d0 * 16 + hi * 8) * 2;
    ka[d0] = *reinterpret_cast<const bf16x8*>(Ks + KSWZ64(r32, cb)); kb[d0] = *reinterpret_cast<const bf16x8*>(Ks + KSWZ64(32 + r32, cb)); }
  asm volatile("s_waitcnt lgkmcnt(0)" ::: "memory"); SBAR();
  p0 = f32x16{}; p1 = f32x16{};
#pragma unroll
  for (int d0 = 0; d0 < 4; ++d0) {
    p0 = __builtin_amdgcn_mfma_f32_32x32x16_bf16(ka[d0], qr[d0], p0, 0, 0, 0);
    p1 = __builtin_amdgcn_mfma_f32_32x32x16_bf16(kb[d0], qr[d0], p1, 0, 0, 0); }
}
__device__ __forceinline__ int v_st(int k, int c) { const int kk = (k & ~0xC) | ((k & 4) << 1) | ((k & 8) >> 1); return ((kk >> 3) * 4 + (c >> 5)) * 512 + ((kk & 7) * 32 + (c & 31)) * 2; }
__device__ __forceinline__ int v_rd_base(int lane) { return ((lane & 3) << 3) | (((lane >> 2) & 3) << 6) | (((lane >> 4) & 1) << 5) | (((lane >> 5) & 1) << 8); }
constexpr int v_rd_off(int d0, int ks, int half) { return d0 * 512 + ks * 4096 + half * 2048; }
template <int OFF> __device__ __forceinline__ s16x4 tr_read(int vb) {
  s16x4 r; asm volatile("ds_read_b64_tr_b16 %0, %1 offset:%2" : "=&v"(r) : "v"(vb), "i"(OFF) : "memory"); return r;
}
template <int D0> __device__ __forceinline__ void pv_one(f32x16& od, int vb, bf16x8 pa0, bf16x8 pa1, bf16x8 pa2, bf16x8 pa3) {
  const s16x4 l0 = tr_read<v_rd_off(D0, 0, 0)>(vb), h0 = tr_read<v_rd_off(D0, 0, 1)>(vb), l1 = tr_read<v_rd_off(D0, 1, 0)>(vb), h1 = tr_read<v_rd_off(D0, 1, 1)>(vb);
  const s16x4 l2 = tr_read<v_rd_off(D0, 2, 0)>(vb), h2 = tr_read<v_rd_off(D0, 2, 1)>(vb), l3 = tr_read<v_rd_off(D0, 3, 0)>(vb), h3 = tr_read<v_rd_off(D0, 3, 1)>(vb);
  asm volatile("s_waitcnt lgkmcnt(0)" ::: "memory"); SBAR();
#define PK(L, H) (bf16x8){L[0], L[1], L[2], L[3], H[0], H[1], H[2], H[3]}
  od = __builtin_amdgcn_mfma_f32_32x32x16_bf16(pa0, PK(l0, h0), od, 0, 0, 0);
  od = __builtin_amdgcn_mfma_f32_32x32x16_bf16(pa1, PK(l1, h1), od, 0, 0, 0);
  od = __builtin_amdgcn_mfma_f32_32x32x16_bf16(pa2, PK(l2, h2), od, 0, 0, 0);
  od = __builtin_amdgcn_mfma_f32_32x32x16_bf16(pa3, PK(l3, h3), od, 0, 0, 0);
#undef PK
}
__device__ __forceinline__ void pv_d0(f32x16* o, int vb, bf16x8 pa0, bf16x8 pa1, bf16x8 pa2, bf16x8 pa3) {
  pv_one<0>(o[0], vb, pa0, pa1, pa2, pa3); pv_one<1>(o[1], vb, pa0, pa1, pa2, pa3); pv_one<2>(o[2], vb, pa0, pa1, pa2, pa3); pv_one<3>(o[3], vb, pa0, pa1, pa2, pa3);
}

template <bool GRPB> __device__ __forceinline__ void attn_pass(const int pass, float* __restrict__ scr, bf16* __restrict__ mixrow, const float lam, const float* __restrict__ gsub, const float one_m_li,
                                          const bf16* __restrict__ Qb, const bf16* __restrict__ Kh, const bf16* __restrict__ Vh, int q0seq, char* lds, const float* tb2) {
  int tid_ = threadIdx.x; asm volatile("" : "+v"(tid_));
  const int tid = tid_, wid = tid >> 6, lane = tid & 63, r32 = lane & 31, hi = lane >> 5;
  char* V_lds = lds + OFF_V; char* K_lds = lds + OFF_K;
  float* ws = (float*)(lds + OFF_WS) + wid * 64; float* li_l = ws; float* al_l = ws + 32; char* ost = lds + OFF_OST + wid * (32 * OST_PITCH);
  const float cL = __uint_as_float(__builtin_amdgcn_readfirstlane(__float_as_uint(tb2[0]))), cR = __uint_as_float(__builtin_amdgcn_readfirstlane(__float_as_uint(tb2[384])));
  const int qw = __builtin_amdgcn_readfirstlane(q0seq + wid * 32), qpos = qw + r32;
  float m_reg = -1e30f, l_reg = 0; bf16x8 qr[4]; f32x16 o[4];
#pragma unroll
  for (int d = 0; d < 4; ++d) o[d] = f32x16{};
  const bf16* Qw = Qb + (long)(wid * 32 + r32) * LDK + hi * 8;
#pragma unroll
  for (int d0 = 0; d0 < 4; ++d0) qr[d0] = *(const GAS bf16x8*)(Qw + d0 * 16);
  const int sr = tid >> 4, sc = (tid & 15) * 8, vst0 = v_st(sr, sc), vst1 = v_st(32 + sr, sc);
  const int kr = tid >> 3, kc = (tid & 7) * 8, kst = KSWZ64(kr, kc * 2);
  const int vb0 = (int)(uintptr_t)V_lds + v_rd_base(lane);
  struct { bf16x8 vs0, vs1, ks0; } sr_[2];
#define SLOAD(i, k0) do { sr_[i].vs0 = *(const GAS bf16x8*)(&Vh[(long)((k0) + sr) * LDK + sc]); sr_[i].vs1 = *(const GAS bf16x8*)(&Vh[(long)((k0) + 32 + sr) * LDK + sc]); \
    sr_[i].ks0 = *(const GAS bf16x8*)(&Kh[(long)((k0) + kr) * LDK + kc]); } while (0)
#define SWRITE(b, i) do { *(bf16x8*)(V_lds + (b) * SHM_V + vst0) = sr_[i].vs0; *(bf16x8*)(V_lds + (b) * SHM_V + vst1) = sr_[i].vs1; \
    *(bf16x8*)(K_lds + (b) * SHM_K + kst) = sr_[i].ks0; } while (0)
#define SWAIT() asm volatile("s_waitcnt vmcnt(3)" ::: "memory")
#define RESC(a) do { if (__any((a) < 1.f)) { if (hi == 0) al_l[r32] = (a); asm volatile("s_waitcnt lgkmcnt(0)" ::: "memory"); \
    _Pragma("unroll") for (int d = 0; d < 4; ++d) _Pragma("unroll") for (int r = 0; r < 16; ++r) o[d][r] *= al_l[crow(r, hi)]; } } while (0)
  f32x16 pA0, pA1, pB0, pB1; float mnA, mnB, alA, alB; bf16x8 pa0, pa1, pa2, pa3; constexpr int NT = SEQ / KVBLK;
  __syncthreads();
  SLOAD(0, 0); SLOAD(1, KVBLK); asm volatile("s_waitcnt vmcnt(0)" ::: "memory"); SWRITE(0, 0); SWRITE(1, 1);
  SLOAD(0, 2 * KVBLK); asm volatile("s_waitcnt vmcnt(0)" ::: "memory"); SWRITE(2, 0); __syncthreads();
  qkt(pA0, pA1, K_lds, qr, r32, hi); partialSM(pA0, pA1, m_reg, mnA, alA, 0, qpos, qw, hi, tb2, cL, cR);
  int bm1 = 0, b0 = 1, bp1 = 2;
#define HSTEP(N0, N1, MN, AL, C0, C1, ALC, TPOS, LOADSTMT) do { \
    if constexpr (GRPB) { SBAR(); finishSM(C0, C1, ALC, l_reg, pa0, pa1, pa2, pa3); SBAR(); qkt(N0, N1, K_lds + b0 * SHM_K, qr, r32, hi); SBAR(); LOADSTMT; SBAR(); \
                partialSM(N0, N1, m_reg, MN, AL, (TPOS), qpos, qw, hi, tb2, cL, cR); SBAR(); pv_d0(o, vb0 + bm1 * SHM_V, pa0, pa1, pa2, pa3); } \
    else      { SBAR(); qkt(N0, N1, K_lds + b0 * SHM_K, qr, r32, hi); finishSM(C0, C1, ALC, l_reg, pa0, pa1, pa2, pa3); SBAR(); LOADSTMT; SBAR(); \
                pv_d0(o, vb0 + bm1 * SHM_V, pa0, pa1, pa2, pa3); partialSM(N0, N1, m_reg, MN, AL, (TPOS), qpos, qw, hi, tb2, cL, cR); } } while (0)
  for (int t = 1; t + 1 < NT; t += 2) {
    HSTEP(pB0, pB1, mnB, alB, pA0, pA1, alA, t * KVBLK, SLOAD(0, (t + 2) * KVBLK));
    __syncthreads(); SWRITE(bm1, 0);
    RESC(alB);
    { const int tmp = bm1; bm1 = b0; b0 = bp1; bp1 = tmp; }
    HSTEP(pA0, pA1, mnA, alA, pB0, pB1, alB, (t + 1) * KVBLK, if (t + 3 < NT) SLOAD(0, (t + 3) * KVBLK));
    __syncthreads(); if (t + 3 < NT) SWRITE(bm1, 0);
    RESC(alA);
    { const int tmp = bm1; bm1 = b0; b0 = bp1; bp1 = tmp; }
  }
#undef HSTEP
  SBAR(); qkt(pB0, pB1, K_lds + b0 * SHM_K, qr, r32, hi);
  finishSM(pA0, pA1, alA, l_reg, pa0, pa1, pa2, pa3); SBAR();
  pv_d0(o, vb0 + bm1 * SHM_V, pa0, pa1, pa2, pa3); partialSM(pB0, pB1, m_reg, mnB, alB, (NT - 1) * KVBLK, qpos, qw, hi, tb2, cL, cR);
  RESC(alB);
  finishSM(pB0, pB1, alB, l_reg, pa0, pa1, pa2, pa3); SBAR();
  pv_d0(o, vb0 + b0 * SHM_V, pa0, pa1, pa2, pa3);
  if (hi == 0) li_l[r32] = l_reg; asm volatile("s_waitcnt lgkmcnt(0)" ::: "memory");
  GAS f32x4* scr4 = (GAS f32x4*)(scr + (size_t)tid * 64);
  if (pass == 0) {
#pragma unroll
    for (int r4 = 0; r4 < 4; ++r4) { const f32x4 lv = *(const f32x4*)(li_l + 8 * r4 + 4 * hi);
      const f32x4 rl = (f32x4){__builtin_amdgcn_rcpf(lv[0]), __builtin_amdgcn_rcpf(lv[1]), __builtin_amdgcn_rcpf(lv[2]), __builtin_amdgcn_rcpf(lv[3])};
#pragma unroll
      for (int d0 = 0; d0 < 4; ++d0) scr4[d0 * 4 + r4] = (f32x4){o[d0][4 * r4 + 0] * rl[0], o[d0][4 * r4 + 1] * rl[1], o[d0][4 * r4 + 2] * rl[2], o[d0][4 * r4 + 3] * rl[3]}; }
  } else {
    float g[4];
#pragma unroll
    for (int d0 = 0; d0 < 4; ++d0) g[d0] = gsub[d0 * 32 + r32] * one_m_li;
#pragma unroll
    for (int r4 = 0; r4 < 4; ++r4) { const f32x4 lv = *(const f32x4*)(li_l + 8 * r4 + 4 * hi);
      f32x4 av[4];
#pragma unroll
      for (int d0 = 0; d0 < 4; ++d0) av[d0] = scr4[d0 * 4 + r4];
#pragma unroll
      for (int i = 0; i < 4; ++i) { const float rl = __builtin_amdgcn_rcpf(lv[i]) * lam; float dv[4]; float sq = 0.f;
#pragma unroll
        for (int d0 = 0; d0 < 4; ++d0) { dv[d0] = av[d0][i] - rl * o[d0][4 * r4 + i]; sq += dv[d0] * dv[d0]; }
        sq += __shfl_xor(sq, 1); sq += __shfl_xor(sq, 2); sq += __shfl_xor(sq, 4); sq += __shfl_xor(sq, 8); sq += __shfl_xor(sq, 16);
        const float rs = __builtin_amdgcn_rsqf(sq * (1.0f / 128.0f) + EPS);
        unsigned short* orow = (unsigned short*)(ost + (8 * r4 + 4 * hi + i) * OST_PITCH) + r32;
#pragma unroll
        for (int d0 = 0; d0 < 4; ++d0) orow[d0 * 32] = (unsigned short)(cvtpk(dv[d0] * rs * g[d0], 0.f) & 0xffffu); } }
    asm volatile("s_waitcnt lgkmcnt(0)" ::: "memory");
    { const int rr = lane >> 4, c16 = lane & 15; char* gdst = (char*)(mixrow + (size_t)(wid * 32 + rr) * 1024) + c16 * 16;
#pragma unroll
      for (int j = 0; j < 8; ++j) { const u32x4 w = *(const u32x4*)(ost + (4 * j + rr) * OST_PITCH + c16 * 16); *(GAS u32x4*)(gdst + (size_t)j * 8192) = w; } }
  }
#undef SLOAD
#undef SWRITE
#undef SWAIT
#undef RESC
}

__device__ __forceinline__ int rel_bucket(int rel) {
  const int ret = rel > 0 ? 16 : 0; const int n = rel < 0 ? -rel : rel;
  if (n < 8) return ret + n;
  int large = 2 + (31 - __clz(n * n)); if (large > 15) large = 15;
  return ret + large;
}

__device__ __forceinline__ void attn_phase(const Params& p, int e, char* lds) {
  int tid_ = threadIdx.x; asm volatile("" : "+v"(tid_));
  const int tid = tid_, wid = tid >> 6, lane = tid & 63, r32 = lane & 31, hi = lane >> 5;
  const bf16* big = (const bf16*)(p.ws + WS_BIG); bf16* mix = (bf16*)(p.ws + WS_MIX);
  float* scr = (float*)(p.ws + WS_ASCR) + (size_t)blockIdx.x * 32768;
  float* tb2 = (float*)(lds + OFF_TB);
  float lam, one_m_li;
  { const float a = p.lq1[e * 64 + lane] * p.lk1[e * 64 + lane], b = p.lq2[e * 64 + lane] * p.lk2[e * 64 + lane];
    const float s1 = wave_sum(a), s2 = wave_sum(b); const float li = 0.8f - 0.6f * __expf(-0.3f * (float)(2 * e));
    lam = __uint_as_float(__builtin_amdgcn_readfirstlane(__float_as_uint(__expf(s1) - __expf(s2) + li))); one_m_li = 1.0f - li; }
  int cur_h = -1;
  const bool xmap = (gridDim.x == 256);
  const int nrounds = xmap ? 4 : (BATCH * 4 * 16 + (int)gridDim.x - 1) / (int)gridDim.x;
  for (int k = 0; k < nrounds; ++k) {
    const int u = xmap ? ((((k * 16) + ((int)(blockIdx.x & 7) * 2) + (int)(blockIdx.x >> 7)) << 4) | (int)((blockIdx.x >> 3) & 15)) : ((int)blockIdx.x + k * (int)gridDim.x);
    if (u >= BATCH * 4 * 16) break;
    const int qb = u & 15, h = (u >> 4) & 3, b = u >> 6;
    if (h != cur_h) { __syncthreads(); for (int d = tid; d < 385; d += 512) tb2[d] = p.rel_bias[rel_bucket(d - 192) * 4 + h] * LOG2E; cur_h = h; __syncthreads(); }
    const long row0 = (long)b * SEQ + qb * 256;
    if (__builtin_amdgcn_readfirstlane(wid) & 1) {
      attn_pass<true>(0, scr, mix + (size_t)row0 * 1024 + h * 128, lam, p.da_subln + e * 128, one_m_li,
                big + row0 * LDK + h * 128, big + (long)b * SEQ * LDK + 512 + h * 128, big + (long)b * SEQ * LDK + 1024 + h * 128, qb * 256, lds, tb2);
      attn_pass<true>(1, scr, mix + (size_t)row0 * 1024 + h * 128, lam, p.da_subln + e * 128, one_m_li,
                big + row0 * LDK + h * 128 + 64, big + (long)b * SEQ * LDK + 512 + h * 128 + 64, big + (long)b * SEQ * LDK + 1024 + h * 128, qb * 256, lds, tb2);
    } else {
      attn_pass<false>(0, scr, mix + (size_t)row0 * 1024 + h * 128, lam, p.da_subln + e * 128, one_m_li,
                big + row0 * LDK + h * 128, big + (long)b * SEQ * LDK + 512 + h * 128, big + (long)b * SEQ * LDK + 1024 + h * 128, qb * 256, lds, tb2);
      attn_pass<false>(1, scr, mix + (size_t)row0 * 1024 + h * 128, lam, p.da_subln + e * 128, one_m_li,
                big + row0 * LDK + h * 128 + 64, big + (long)b * SEQ * LDK + 512 + h * 128 + 64, big + (long)b * SEQ * LDK + 1024 + h * 128, qb * 256, lds, tb2);
    }
  }
}
}

namespace hg {
constexpr int TB = 32;
constexpr int OFF_F = 0, OFF_Q = 16384, OFF_V = 32768, OFF_OP = 40960, OFF_END = 40960 + 65536;
__device__ __forceinline__ void hgrn_phase(const Params& p, int e, char* lds) {
  int tid_ = threadIdx.x; asm volatile("" : "+v"(tid_));
  const int tid = tid_, wave = tid >> 6, lane = tid & 63;
  const bf16* big = (const bf16*)(p.ws + WS_BIG);
  bf16* ohg = (bf16*)(p.ws + WS_HB);
  float* F = (float*)(lds + OFF_F); float* Q = (float*)(lds + OFF_Q); float* Vv = (float*)(lds + OFF_V); float* OP = (float*)(lds + OFF_OP);
  const int lt = tid >> 4, lk8 = (tid & 15) * 8;
  const int vt = (tid & 255) >> 3, vv8 = (tid & 7) * 8;
  const int vg = lane & 15, kg = wave * 4 + (lane >> 4), k0 = kg * 4, v0 = vg * 4;
  const int st = tid >> 4, sv4 = (tid & 15) * 4;
  for (int u = blockIdx.x; u < 256; u += gridDim.x) {
    const int vh = u & 1, dir = (u >> 1) & 1, h = (u >> 2) & 3, b = u >> 4;
    const float* lbsrc = dir ? p.lb_bwd : p.lb_fwd;
    float lb[8];
#pragma unroll
    for (int i = 0; i < 8; ++i) { if (e == 0) lb[i] = 0.f; else { const float a0 = lbsrc[h * 128 + lk8 + i], a1 = lbsrc[512 + h * 128 + lk8 + i]; lb[i] = 1.0f / (1.0f + __expf(a0 - a1)); } }
    const bf16* qbase = big + (size_t)b * SEQ * 4096 + 1536 + h * 128 + lk8;
    const bf16* zbase = big + (size_t)b * SEQ * 4096 + (dir ? 2560 : 2048) + h * 128 + lk8;
    const bf16* vbase = big + (size_t)b * SEQ * 4096 + 3072 + h * 128 + vh * 64 + vv8;
    bf16* obase = ohg + (size_t)dir * T * 512 + (size_t)b * SEQ * 512 + h * 128 + vh * 64 + sv4;
    f32x2 S[4][2];
#pragma unroll
    for (int i = 0; i < 4; ++i) { S[i][0] = (f32x2){0.f, 0.f}; S[i][1] = (f32x2){0.f, 0.f}; }
    u32x4 rq, rz, rv;
    { const int pos = dir ? (SEQ - 1 - lt) : lt; rq = *(const u32x4*)(qbase + (size_t)pos * 4096); rz = *(const u32x4*)(zbase + (size_t)pos * 4096);
      const int pv = dir ? (SEQ - 1 - vt) : vt; rv = (tid < 256) ? *(const u32x4*)(vbase + (size_t)pv * 4096) : (u32x4){0, 0, 0, 0}; }
    for (int blk = 0; blk < SEQ / TB; ++blk) {
      { float zf[8], qf[8];
        zf[0] = bflo(rz.x); zf[1] = bfhi(rz.x); zf[2] = bflo(rz.y); zf[3] = bfhi(rz.y); zf[4] = bflo(rz.z); zf[5] = bfhi(rz.z); zf[6] = bflo(rz.w); zf[7] = bfhi(rz.w);
        qf[0] = bflo(rq.x); qf[1] = bfhi(rq.x); qf[2] = bflo(rq.y); qf[3] = bfhi(rq.y); qf[4] = bflo(rq.z); qf[5] = bfhi(rq.z); qf[6] = bflo(rq.w); qf[7] = bfhi(rq.w);
        float ff[8];
#pragma unroll
        for (int i = 0; i < 8; ++i) { const float sg = __builtin_amdgcn_rcpf(1.0f + __builtin_amdgcn_exp2f(-1.4426950408889634f * zf[i])); ff[i] = lb[i] + (1.0f - lb[i]) * sg; }
        *(f32x4*)(F + lt * 128 + lk8) = (f32x4){ff[0], ff[1], ff[2], ff[3]}; *(f32x4*)(F + lt * 128 + lk8 + 4) = (f32x4){ff[4], ff[5], ff[6], ff[7]};
        *(f32x4*)(Q + lt * 128 + lk8) = (f32x4){qf[0], qf[1], qf[2], qf[3]}; *(f32x4*)(Q + lt * 128 + lk8 + 4) = (f32x4){qf[4], qf[5], qf[6], qf[7]};
        if (tid < 256) { *(f32x4*)(Vv + vt * 64 + vv8) = (f32x4){bflo(rv.x), bfhi(rv.x), bflo(rv.y), bfhi(rv.y)}; *(f32x4*)(Vv + vt * 64 + vv8 + 4) = (f32x4){bflo(rv.z), bfhi(rv.z), bflo(rv.w), bfhi(rv.w)}; } }
      __syncthreads();
      if (blk + 1 < SEQ / TB) { const int t1 = (blk + 1) * TB;
        const int pos = dir ? (SEQ - 1 - (t1 + lt)) : (t1 + lt); rq = *(const u32x4*)(qbase + (size_t)pos * 4096); rz = *(const u32x4*)(zbase + (size_t)pos * 4096);
        const int pv = dir ? (SEQ - 1 - (t1 + vt)) : (t1 + vt); if (tid < 256) rv = *(const u32x4*)(vbase + (size_t)pv * 4096); }
#pragma unroll 4
      for (int t = 0; t < TB; ++t) {
        const f32x4 f4 = *(const f32x4*)(F + t * 128 + k0), q4 = *(const f32x4*)(Q + t * 128 + k0), v4 = *(const f32x4*)(Vv + t * 64 + v0);
        const f32x2 va = (f32x2){v4[0], v4[1]}, vb = (f32x2){v4[2], v4[3]};
        f32x2 oa = (f32x2){0.f, 0.f}, ob = (f32x2){0.f, 0.f};
#pragma unroll
        for (int i = 0; i < 4; ++i) { const f32x2 fi = (f32x2){f4[i], f4[i]}, qi = (f32x2){q4[i], q4[i]};
          S[i][0] = fi * (S[i][0] - va) + va; S[i][1] = fi * (S[i][1] - vb) + vb;
          oa += S[i][0] * qi; ob += S[i][1] * qi; }
        float o0 = oa.x, o1 = oa.y, o2 = ob.x, o3 = ob.y;
        o0 += __shfl_xor(o0, 16); o1 += __shfl_xor(o1, 16); o2 += __shfl_xor(o2, 16); o3 += __shfl_xor(o3, 16);
        o0 += __shfl_xor(o0, 32); o1 += __shfl_xor(o1, 32); o2 += __shfl_xor(o2, 32); o3 += __shfl_xor(o3, 32);
        if (lane < 16) *(f32x4*)(OP + (wave * TB + t) * 64 + v0) = (f32x4){o0, o1, o2, o3};
      }
      __syncthreads();
      { f32x4 s = *(const f32x4*)(OP + (0 * TB + st) * 64 + sv4);
#pragma unroll
        for (int w = 1; w < 8; ++w) s += *(const f32x4*)(OP + (w * TB + st) * 64 + sv4);
        const int tt = blk * TB + st; const int pos = dir ? (SEQ - 1 - tt) : tt;
        u32x2 o; o.x = cvtpk(s[0], s[1]); o.y = cvtpk(s[2], s[3]); *(u32x2*)(obase + (size_t)pos * 512) = o; }
    }
    __syncthreads();
  }
}
__device__ __forceinline__ void hgpost_phase(const Params& p, int e) {
  int tid_ = threadIdx.x; asm volatile("" : "+v"(tid_));
  const int tid = tid_, lane = tid & 63, wave = tid >> 6;
  const int gw = blockIdx.x * 8 + wave, NGW = gridDim.x * 8;
  const bf16* big = (const bf16*)(p.ws + WS_BIG); const bf16* ohg = (const bf16*)p.out; bf16* mix = (bf16*)(p.ws + WS_MIX);
  float gn[8];
#pragma unroll
  for (int i = 0; i < 8; ++i) gn[i] = p.hg_norm[e * 128 + (lane & 15) * 8 + i];
  for (int m0 = gw; m0 < T; m0 += 4 * NGW) {
    u32x4 av[4], bv[4], gv[4];
#pragma unroll
    for (int q = 0; q < 4; ++q) { const int m = m0 + q * NGW; const int mc = m < T ? m : m0;
      av[q] = *(const u32x4*)(ohg + (size_t)mc * 512 + lane * 8); bv[q] = *(const u32x4*)(ohg + (size_t)T * 512 + (size_t)mc * 512 + lane * 8); gv[q] = *(const u32x4*)(big + (size_t)mc * 4096 + 3584 + lane * 8); }
#pragma unroll
    for (int q = 0; q < 4; ++q) { const int m = m0 + q * NGW; const u32x4 a = av[q], b = bv[q], g = gv[q];
      float s[8];
      s[0] = bflo(a.x) + bflo(b.x); s[1] = bfhi(a.x) + bfhi(b.x); s[2] = bflo(a.y) + bflo(b.y); s[3] = bfhi(a.y) + bfhi(b.y);
      s[4] = bflo(a.z) + bflo(b.z); s[5] = bfhi(a.z) + bfhi(b.z); s[6] = bflo(a.w) + bflo(b.w); s[7] = bfhi(a.w) + bfhi(b.w);
      float sq = 0.f;
#pragma unroll
      for (int i = 0; i < 8; ++i) sq += s[i] * s[i];
      sq += __shfl_xor(sq, 1); sq += __shfl_xor(sq, 2); sq += __shfl_xor(sq, 4); sq += __shfl_xor(sq, 8);
      const float rs = __builtin_amdgcn_rsqf(sq * (1.0f / 128.0f) + EPS);
      float gg[8]; gg[0] = bflo(g.x); gg[1] = bfhi(g.x); gg[2] = bflo(g.y); gg[3] = bfhi(g.y); gg[4] = bflo(g.z); gg[5] = bfhi(g.z); gg[6] = bflo(g.w); gg[7] = bfhi(g.w);
      float o[8];
#pragma unroll
      for (int i = 0; i < 8; ++i) o[i] = s[i] * rs * gn[i] * gg[i];
      u32x4 w; w.x = cvtpk(o[0], o[1]); w.y = cvtpk(o[2], o[3]); w.z = cvtpk(o[4], o[5]); w.w = cvtpk(o[6], o[7]);
      if (m < T) *(u32x4*)(mix + (size_t)m * 1024 + 512 + lane * 8) = w; }
  }
}
}


namespace hg2 {
constexpr int PQ = 272, PJ = 144;
constexpr int OFF_QD = 0, OFF_QA = 17408, OFF_KB = 34816, OFF_KS = 52224, OFF_VT = 70656, OFF_P = 79872, OFF_ST = 89088, OFF_TOT = 123904, OFF_D = 125952, OFF_END = 126464;
constexpr float L2E = 1.4426950408889634f;
__device__ __forceinline__ bf16x8 ldfrag(const char* base, int row, int pitch, int koff) { return *(const bf16x8*)(base + row * pitch + koff * 2); }
__device__ __forceinline__ void hgrn_phase(const Params& p, int e, char* lds) {
  int tid_ = threadIdx.x; asm volatile("" : "+v"(tid_));
  const int tid = tid_, wave = tid >> 6, lane = tid & 63, fr = lane & 15, fq_ = lane >> 4;
  const char* bigc = (const char*)(p.ws + WS_BIG);
  char* ohgc = (char*)p.out;
  char* QD = lds + OFF_QD; char* QA = lds + OFF_QA; char* KB = lds + OFF_KB; char* KS = lds + OFF_KS; char* VT = lds + OFF_VT; char* PP = lds + OFF_P; char* ST = lds + OFF_ST;
  char* RQ = QD; char* RZ = QA; char* RV = KB;
  float* TOT = (float*)(lds + OFF_TOT); float* DD = (float*)(lds + OFF_D);
  const int k = tid & 127, rq = tid >> 7;
  const int vv = tid & 63, jg = tid >> 6;
  const int lr0 = tid >> 4, lc8 = (tid & 15) * 8;
  const int vr = tid >> 3, vc8 = (tid & 7) * 8;
  for (int u = blockIdx.x; u < 256; u += gridDim.x) {
    const int vh = u & 1, dir = (u >> 1) & 1, h = (u >> 2) & 3, b = u >> 4;
    float lbk = 0.f;
    if (e != 0) { const float* lbsrc = dir ? p.lb_bwd : p.lb_fwd; const float a0 = lbsrc[h * 128 + k], a1 = lbsrc[512 + h * 128 + k]; lbk = 1.0f / (1.0f + __expf(a0 - a1)); }
    const int rsb = dir ? -8192 : 8192;
    const int base0 = (b * SEQ + (dir ? (SEQ - 1) : 0)) * 8192;
    const int qcol = (1536 + h * 128 + lc8) * 2, zcol = ((dir ? 2560 : 2048) + h * 128 + lc8) * 2, vcol = (3072 + h * 128 + vh * 64 + vc8) * 2;
    const int osb = dir ? -1024 : 1024;
    const int obase = dir * (T * 1024) + (b * SEQ + (dir ? (SEQ - 1) : 0)) * 1024 + (h * 128 + vh * 64) * 2;
    f32x4 Sacc[4];
#pragma unroll
    for (int i = 0; i < 4; ++i) Sacc[i] = (f32x4){0.f, 0.f, 0.f, 0.f};
    for (int i = tid; i < 64 * PQ / 16; i += 512) *(u32x4*)(ST + i * 16) = (u32x4){0, 0, 0, 0};
    u32x4 gq0, gq1, gz0, gz1, gv;
    { const int o0 = base0 + rsb * lr0, o1 = base0 + rsb * (lr0 + 32);
      gq0 = *(const GAS u32x4*)(bigc + (size_t)(unsigned)(o0 + qcol)); gq1 = *(const GAS u32x4*)(bigc + (size_t)(unsigned)(o1 + qcol));
      gz0 = *(const GAS u32x4*)(bigc + (size_t)(unsigned)(o0 + zcol)); gz1 = *(const GAS u32x4*)(bigc + (size_t)(unsigned)(o1 + zcol));
      gv = *(const GAS u32x4*)(bigc + (size_t)(unsigned)(base0 + rsb * vr + vcol)); }
    for (int c = 0; c < SEQ / 64; ++c) {
      const int pb = c & 1;
      *(u32x4*)(RQ + lr0 * PQ + lc8 * 2) = gq0; *(u32x4*)(RQ + (lr0 + 32) * PQ + lc8 * 2) = gq1;
      *(u32x4*)(RZ + lr0 * PQ + lc8 * 2) = gz0; *(u32x4*)(RZ + (lr0 + 32) * PQ + lc8 * 2) = gz1;
      *(u32x4*)(RV + vr * PJ + vc8 * 2) = gv;
      __syncthreads();
      float qf[16], kk[16], cl[16]; float run = 0.f;
#pragma unroll
      for (int i = 0; i < 16; ++i) { const int t = 16 * rq + i; const float z = bf2f(*(const unsigned short*)(RZ + t * PQ + k * 2)); qf[i] = bf2f(*(const unsigned short*)(RQ + t * PQ + k * 2));
        const float sg = __builtin_amdgcn_rcpf(1.0f + __builtin_amdgcn_exp2f(-L2E * z)); const float f = lbk + (1.0f - lbk) * sg;
        run += __builtin_amdgcn_logf(f); cl[i] = run; kk[i] = 1.0f - f; }
      TOT[rq * 128 + k] = run;
      unsigned short rvv[8];
#pragma unroll
      for (int i = 0; i < 8; ++i) rvv[i] = *(const unsigned short*)(RV + (8 * jg + i) * PJ + vv * 2);
      u32x4 vpk; vpk.x = rvv[0] | ((unsigned)rvv[1] << 16); vpk.y = rvv[2] | ((unsigned)rvv[3] << 16); vpk.z = rvv[4] | ((unsigned)rvv[5] << 16); vpk.w = rvv[6] | ((unsigned)rvv[7] << 16);
      __syncthreads();
      { const float t0 = TOT[k], t1 = TOT[128 + k], t2 = TOT[256 + k], t3 = TOT[384 + k];
        const float mid = t0 + t1, last = (t0 + t1) + (t2 + t3);
        const float off = (rq == 0) ? 0.f : (rq == 1) ? t0 : (rq == 2) ? (t0 + t1) : (t0 + t1 + t2);
        const float el = __builtin_amdgcn_exp2f(last), em = __builtin_amdgcn_exp2f(fminf(-mid, 120.f)), emi = __builtin_amdgcn_exp2f(mid);
        if (rq == 0) DD[k] = el;
        unsigned ksw[8];
#pragma unroll
        for (int i = 0; i < 16; ++i) { const float cc = off + cl[i];
          const float e1 = __builtin_amdgcn_exp2f(cc), inv1 = __builtin_amdgcn_exp2f(fminf(-cc, 120.f));
          const float ea = fminf(e1 * em, 3.6e16f);
          const float eb = fminf(inv1 * emi, 3.6e16f);
          const float es = fminf(inv1 * el, 1.0f);
          const int t = 16 * rq + i;
          const unsigned w0 = cvtpk(qf[i] * e1, qf[i] * ea), w1 = cvtpk(kk[i] * eb, kk[i] * es);
          *(unsigned short*)(QD + t * PQ + k * 2) = (unsigned short)(w0 & 0xffffu);
          *(unsigned short*)(QA + t * PQ + k * 2) = (unsigned short)(w0 >> 16);
          *(unsigned short*)(KB + t * PQ + k * 2) = (unsigned short)(w1 & 0xffffu);
          if (i & 1) ksw[i >> 1] |= (w1 & 0xffff0000u); else ksw[i >> 1] = (w1 >> 16); }
        *(u32x4*)(KS + k * PJ + rq * 32) = (u32x4){ksw[0], ksw[1], ksw[2], ksw[3]};
        *(u32x4*)(KS + k * PJ + rq * 32 + 16) = (u32x4){ksw[4], ksw[5], ksw[6], ksw[7]};
        *(u32x4*)(VT + vv * PJ + jg * 16) = vpk; }
      __syncthreads();
      if (c + 1 < SEQ / 64) { const int bc = base0 + rsb * 64 * (c + 1); const int o0 = bc + rsb * lr0, o1 = bc + rsb * (lr0 + 32);
        gq0 = *(const GAS u32x4*)(bigc + (size_t)(unsigned)(o0 + qcol)); gq1 = *(const GAS u32x4*)(bigc + (size_t)(unsigned)(o1 + qcol));
        gz0 = *(const GAS u32x4*)(bigc + (size_t)(unsigned)(o0 + zcol)); gz1 = *(const GAS u32x4*)(bigc + (size_t)(unsigned)(o1 + zcol));
        gv = *(const GAS u32x4*)(bigc + (size_t)(unsigned)(bc + rsb * vr + vcol)); }
#define HWAIT() do { asm volatile("s_waitcnt lgkmcnt(0)" ::: "memory"); __builtin_amdgcn_sched_barrier(0); } while (0)
      f32x4 oacc[2];
      { const int jt = wave >> 1, ttA = 2 * (wave & 1), ttO = wave >> 1, vtO = 2 * (wave & 1); const char* STp = ST + pb * (64 * PQ);
        bf16x8 fa[4], fb0[4], fb1[4], fq[4], fs0[4], fs1[4];
#pragma unroll
        for (int ks = 0; ks < 4; ++ks) { fa[ks] = ldfrag(KB, 16 * jt + fr, PQ, ks * 32 + fq_ * 8); fb0[ks] = ldfrag(QA, 16 * ttA + fr, PQ, ks * 32 + fq_ * 8); fb1[ks] = ldfrag(QA, 16 * (ttA + 1) + fr, PQ, ks * 32 + fq_ * 8);
          fq[ks] = ldfrag(QD, 16 * ttO + fr, PQ, ks * 32 + fq_ * 8); fs0[ks] = ldfrag(STp, 16 * vtO + fr, PQ, ks * 32 + fq_ * 8); fs1[ks] = ldfrag(STp, 16 * (vtO + 1) + fr, PQ, ks * 32 + fq_ * 8); }
        HWAIT();
        f32x4 acc0 = (f32x4){0.f, 0.f, 0.f, 0.f}, acc1 = acc0; oacc[0] = acc0; oacc[1] = acc0;
#pragma unroll
        for (int ks = 0; ks < 4; ++ks) {
          if (jt <= ttA) acc0 = __builtin_amdgcn_mfma_f32_16x16x32_bf16(fa[ks], fb0[ks], acc0, 0, 0, 0);
          if (jt <= ttA + 1) acc1 = __builtin_amdgcn_mfma_f32_16x16x32_bf16(fa[ks], fb1[ks], acc1, 0, 0, 0);
          oacc[0] = __builtin_amdgcn_mfma_f32_16x16x32_bf16(fq[ks], fs0[ks], oacc[0], 0, 0, 0);
          oacc[1] = __builtin_amdgcn_mfma_f32_16x16x32_bf16(fq[ks], fs1[ks], oacc[1], 0, 0, 0); }
        { const int j0 = 16 * jt + 4 * fq_;
          { const int tcol = 16 * ttA + fr; u32x2 w; w.x = cvtpk_c(j0 + 0 <= tcol ? acc0[0] : 0.f, j0 + 1 <= tcol ? acc0[1] : 0.f); w.y = cvtpk_c(j0 + 2 <= tcol ? acc0[2] : 0.f, j0 + 3 <= tcol ? acc0[3] : 0.f);
            *(u32x2*)(PP + tcol * PJ + j0 * 2) = w; }
          { const int tcol = 16 * (ttA + 1) + fr; u32x2 w; w.x = cvtpk_c(j0 + 0 <= tcol ? acc1[0] : 0.f, j0 + 1 <= tcol ? acc1[1] : 0.f); w.y = cvtpk_c(j0 + 2 <= tcol ? acc1[2] : 0.f, j0 + 3 <= tcol ? acc1[3] : 0.f);
            *(u32x2*)(PP + tcol * PJ + j0 * 2) = w; } } }
      { const f32x4 d4 = *(const f32x4*)(DD + 16 * wave + 4 * fq_); char* STn = ST + (pb ^ 1) * (64 * PQ);
        const bf16x8 a0 = ldfrag(KS, 16 * wave + fr, PJ, fq_ * 8), a1 = ldfrag(KS, 16 * wave + fr, PJ, 32 + fq_ * 8);
        bf16x8 v0[4], v1[4];
#pragma unroll
        for (int vt = 0; vt < 4; ++vt) { v0[vt] = ldfrag(VT, 16 * vt + fr, PJ, fq_ * 8); v1[vt] = ldfrag(VT, 16 * vt + fr, PJ, 32 + fq_ * 8); }
        HWAIT();
#pragma unroll
        for (int vt = 0; vt < 4; ++vt) { Sacc[vt] = Sacc[vt] * d4;
          Sacc[vt] = __builtin_amdgcn_mfma_f32_16x16x32_bf16(a0, v0[vt], Sacc[vt], 0, 0, 0);
          Sacc[vt] = __builtin_amdgcn_mfma_f32_16x16x32_bf16(a1, v1[vt], Sacc[vt], 0, 0, 0); }
#pragma unroll
        for (int vt = 0; vt < 4; ++vt) { u32x2 w; w.x = cvtpk_c(Sacc[vt][0], Sacc[vt][1]); w.y = cvtpk_c(Sacc[vt][2], Sacc[vt][3]);
          *(u32x2*)(STn + (16 * vt + fr) * PQ + (16 * wave + 4 * fq_) * 2) = w; } }
      __syncthreads();
      { const int tt = wave >> 1, vt0 = 2 * (wave & 1);
        bf16x8 pf[2], vf0[2], vf1[2];
#pragma unroll
        for (int ks = 0; ks < 2; ++ks) { pf[ks] = ldfrag(PP, 16 * tt + fr, PJ, ks * 32 + fq_ * 8); vf0[ks] = ldfrag(VT, 16 * vt0 + fr, PJ, ks * 32 + fq_ * 8); vf1[ks] = ldfrag(VT, 16 * (vt0 + 1) + fr, PJ, ks * 32 + fq_ * 8); }
        HWAIT();
#pragma unroll
        for (int ks = 0; ks < 2; ++ks) { oacc[0] = __builtin_amdgcn_mfma_f32_16x16x32_bf16(pf[ks], vf0[ks], oacc[0], 0, 0, 0); oacc[1] = __builtin_amdgcn_mfma_f32_16x16x32_bf16(pf[ks], vf1[ks], oacc[1], 0, 0, 0); }
#pragma unroll
        for (int n = 0; n < 2; ++n) { const int oo = obase + osb * (64 * c + 16 * tt + 4 * fq_) + (16 * (vt0 + n) + fr) * 2;
#pragma unroll
          for (int i = 0; i < 4; ++i) *(GAS unsigned short*)(ohgc + (size_t)(unsigned)(oo + osb * i)) = (unsigned short)(cvtpk_c(oacc[n][i], 0.f) & 0xffffu); } }
#undef HWAIT
    }
    __syncthreads();
  }
}
}

namespace sgu {
constexpr int VT_PITCH = 272;
constexpr int OFF_VT = 0, OFF_RS = 128 * VT_PITCH, OFF_END = OFF_RS + 512;
__device__ __forceinline__ void sgu_phase(const Params& p, int o, char* lds) {
  int tid_ = threadIdx.x; asm volatile("" : "+v"(tid_));
  const int tid = tid_, wave = tid >> 6, lane = tid & 63, fr = lane & 15, quad = lane >> 4;
  const int wr = wave >> 1, wc = wave & 1;
  const bf16* big = (const bf16*)(p.ws + WS_BIG); bf16* mix = (bf16*)(p.ws + WS_MIX);
  const bf16* Wb = (const bf16*)(p.ws + WS_W) + W_SGW + (size_t)o * 8 * 128 * 128;
  const unsigned long long* vss = (const unsigned long long*)(p.ws + WS_SS) + (size_t)(9 + o) * T;
  float* rs = (float*)(lds + OFF_RS);
  const int NU = 512 * 8, G = gridDim.x;
  const bool gfix = (G & 7) == 0;
  u32x4 wraw[4][2]; f32x4 gainv[4]; float biasv[2]; int gcur = -1;
  const int sq0 = tid >> 4, sc8 = (tid & 15) * 8;
  u32x4 vst[4];
  int u = blockIdx.x;
  if (u < NU) { const int g = u & 7; const size_t T0 = (size_t)(u >> 3) * 128;
#pragma unroll
    for (int i = 0; i < 4; ++i) vst[i] = *(const GAS u32x4*)(big + (T0 + sq0 + 32 * i) * 2048 + 1024 + g * 128 + sc8); }
  for (; u < NU; u += G) {
    const int g = u & 7, n = u >> 3; const size_t T0 = (size_t)n * 128;
    if (g != gcur) { gcur = g;
#pragma unroll
      for (int kq = 0; kq < 4; ++kq)
#pragma unroll
        for (int nt = 0; nt < 2; ++nt) wraw[kq][nt] = *(const GAS u32x4*)(Wb + ((size_t)g * 128 + wr * 32 + nt * 16 + fr) * 128 + kq * 32 + quad * 8);
#pragma unroll
      for (int mt = 0; mt < 4; ++mt) gainv[mt] = *(const f32x4*)(p.sg_norm + o * 1024 + g * 128 + wc * 64 + mt * 16 + 4 * quad);
#pragma unroll
      for (int nt = 0; nt < 2; ++nt) biasv[nt] = p.sg_b[(o * 8 + g) * 128 + wr * 32 + nt * 16 + fr]; }
    u32x2 uw[2][4];
#pragma unroll
    for (int nt = 0; nt < 2; ++nt)
#pragma unroll
      for (int mt = 0; mt < 4; ++mt) uw[nt][mt] = *(const GAS u32x2*)(big + (T0 + wr * 32 + nt * 16 + fr) * 2048 + g * 128 + wc * 64 + mt * 16 + 4 * quad);
    __syncthreads();
#pragma unroll
    for (int i = 0; i < 4; ++i) { const int q = sq0 + 32 * i; const u32x4 w = vst[i];
      unsigned short* d = (unsigned short*)(lds + OFF_VT + (sc8) * VT_PITCH + q * 2);
      d[0 * (VT_PITCH / 2)] = (unsigned short)(w.x & 0xffffu); d[1 * (VT_PITCH / 2)] = (unsigned short)(w.x >> 16);
      d[2 * (VT_PITCH / 2)] = (unsigned short)(w.y & 0xffffu); d[3 * (VT_PITCH / 2)] = (unsigned short)(w.y >> 16);
      d[4 * (VT_PITCH / 2)] = (unsigned short)(w.z & 0xffffu); d[5 * (VT_PITCH / 2)] = (unsigned short)(w.z >> 16);
      d[6 * (VT_PITCH / 2)] = (unsigned short)(w.w & 0xffffu); d[7 * (VT_PITCH / 2)] = (unsigned short)(w.w >> 16); }
    if (tid < 128) rs[tid] = __builtin_amdgcn_rsqf(pg8::ss2f(vss[T0 + tid]) * (1.0f / 1024.0f) + EPS);
    __syncthreads();
    if (u + G < NU) { const int g2 = (u + G) & 7; const size_t T2 = (size_t)((u + G) >> 3) * 128;
#pragma unroll
      for (int i = 0; i < 4; ++i) vst[i] = *(const GAS u32x4*)(big + (T2 + sq0 + 32 * i) * 2048 + 1024 + g2 * 128 + sc8); }
    f32x4 acc[4][2];
#pragma unroll
    for (int mt = 0; mt < 4; ++mt)
#pragma unroll
      for (int nt = 0; nt < 2; ++nt) acc[mt][nt] = (f32x4){0.f, 0.f, 0.f, 0.f};
#pragma unroll
    for (int kq = 0; kq < 4; ++kq) {
      const f32x4 r0 = *(const f32x4*)(rs + kq * 32 + quad * 8), r1 = *(const f32x4*)(rs + kq * 32 + quad * 8 + 4);
      bf16x8 wf[2];
#pragma unroll
      for (int nt = 0; nt < 2; ++nt) { const u32x4 w = wraw[kq][nt];
        u32x4 s; s.x = cvtpk(bflo(w.x) * r0[0], bfhi(w.x) * r0[1]); s.y = cvtpk(bflo(w.y) * r0[2], bfhi(w.y) * r0[3]); s.z = cvtpk(bflo(w.z) * r1[0], bfhi(w.z) * r1[1]); s.w = cvtpk(bflo(w.w) * r1[2], bfhi(w.w) * r1[3]);
        wf[nt] = __builtin_bit_cast(bf16x8, s); }
#pragma unroll
      for (int mt = 0; mt < 4; ++mt) { const bf16x8 vf = *(const bf16x8*)(lds + OFF_VT + (wc * 64 + mt * 16 + fr) * VT_PITCH + (kq * 32 + quad * 8) * 2);
#pragma unroll
        for (int nt = 0; nt < 2; ++nt) acc[mt][nt] = __builtin_amdgcn_mfma_f32_16x16x32_bf16(vf, wf[nt], acc[mt][nt], 0, 0, 0); }
    }
#pragma unroll
    for (int nt = 0; nt < 2; ++nt) { const int pp = wr * 32 + nt * 16 + fr;
#pragma unroll
      for (int mt = 0; mt < 4; ++mt) { const int c = g * 128 + wc * 64 + mt * 16 + 4 * quad; const u32x2 uu = uw[nt][mt];
        const f32x4 v = (f32x4){bflo(uu.x), bfhi(uu.x), bflo(uu.y), bfhi(uu.y)} * (gainv[mt] * acc[mt][nt] + biasv[nt]);
        u32x2 ow; ow.x = cvtpk(v[0], v[1]); ow.y = cvtpk(v[2], v[3]);
        *(GAS u32x2*)(mix + (T0 + pp) * 1024 + c) = ow; } }
  }
  (void)gfix;
}
}

#define XB_TMO      128
#define XB_XCNT(j)  (256  + 64 * (j))
#define XB_XSUB(j)  (1280 + 64 * (j))
#define XB_XGEN(j)  (2304 + 64 * (j))
#define XB_TOP      3328
#define XB_TOPGEN   3392
#define XCD_BAR_WORDS 3456
#define XB_SPIN_CAP (1u << 18)

__device__ __forceinline__ unsigned xb_ld(unsigned* p)              { return __hip_atomic_load(p, __ATOMIC_RELAXED, __HIP_MEMORY_SCOPE_AGENT); }
__device__ __forceinline__ unsigned xb_add(unsigned* p, unsigned v) { return __hip_atomic_fetch_add(p, v, __ATOMIC_RELAXED, __HIP_MEMORY_SCOPE_AGENT); }
__device__ __forceinline__ unsigned xb_xcc_id() { return (unsigned)__builtin_amdgcn_s_getreg((3 << 11) | 20) & 0xFu; }
#define XB_SPIN(cond, bar) do { unsigned _sp = 0; while (cond) { __builtin_amdgcn_s_sleep(1); \
    if ((++_sp & 255u) == 0u) { if (xb_ld(&(bar)[XB_TMO])) break; if (_sp > XB_SPIN_CAP) { atomicAdd(&(bar)[XB_TMO], 1u); break; } } } } while (0)

struct XcdBarrier {
    unsigned* bar; unsigned x;
    volatile LAS unsigned* st;
};

__device__ __forceinline__ XcdBarrier xcd_barrier_post(unsigned* bar, volatile LAS unsigned* st) {
    XcdBarrier b; b.bar = bar; b.x = xb_xcc_id(); b.st = st;
    if (threadIdx.x == 0) (void)xb_add(&bar[XB_XCNT(b.x)], 1u);
    return b;
}
__device__ __forceinline__ void xcd_barrier_complete(unsigned* bar, unsigned x, unsigned& nloc, unsigned& nx) {
    const unsigned G = gridDim.x * gridDim.y * gridDim.z;
    unsigned sum, cnt, mine, sp = 0u;
    for (;;) {
        sum = 0u; cnt = 0u; mine = 0u;
#pragma unroll
        for (unsigned j = 0; j < 16; ++j) { const unsigned c = xb_ld(&bar[XB_XCNT(j)]); sum += c; cnt += (c > 0u) ? 1u : 0u; mine = (j == x) ? c : mine; }
        if (sum == G) break;
        __builtin_amdgcn_s_sleep(1);
        if ((++sp & 255u) == 0u) { if (xb_ld(&bar[XB_TMO])) break; if (sp > XB_SPIN_CAP) { atomicAdd(&bar[XB_TMO], 1u); break; } }
    }
    nloc = mine > 0u ? mine : 1u; nx = cnt > 0u ? cnt : 1u;
}

__device__ __forceinline__ void xcd_barrier(const XcdBarrier& b) {
    asm volatile("s_waitcnt vmcnt(0)" ::: "memory");
    __syncthreads();
    if (threadIdx.x == 0) {
        unsigned* bar = b.bar;
        __builtin_amdgcn_s_waitcnt(0);
        unsigned nloc = b.st[0], nx = b.st[1];
        if (nloc == 0u) { xcd_barrier_complete(bar, b.x, nloc, nx); b.st[0] = nloc; b.st[1] = nx; }
        const unsigned old = xb_add(&bar[XB_XSUB(b.x)], 1u);
        const unsigned gen = old / nloc;
        if (old + 1u == (gen + 1u) * nloc) {
            __builtin_amdgcn_fence(__ATOMIC_RELEASE, "agent");
            asm volatile("s_waitcnt vmcnt(0)" ::: "memory");
            const unsigned og = xb_add(&bar[XB_TOP], 1u);
            const unsigned tg = og / nx;
            if (og + 1u == (tg + 1u) * nx) xb_add(&bar[XB_TOPGEN], 1u);
            else XB_SPIN(xb_ld(&bar[XB_TOPGEN]) == tg, bar);
            __builtin_amdgcn_fence(__ATOMIC_ACQUIRE, "agent");
            xb_add(&bar[XB_XGEN(b.x)], 1u);
            asm volatile("s_waitcnt vmcnt(0)" ::: "memory");
        } else {
            XB_SPIN(xb_ld(&bar[XB_XGEN(b.x)]) == gen, bar);
            __builtin_amdgcn_fence(__ATOMIC_ACQUIRE, "agent");
            asm volatile("s_waitcnt vmcnt(0)" ::: "memory");
        }
    }
    __syncthreads();
}

constexpr int NPHASE = 24;
__global__ void __launch_bounds__(512, 2) mega_fwd(Params pin) {
    extern __shared__ __attribute__((aligned(16))) unsigned char lds_raw[];
    PG8_LAS unsigned char* lds = (PG8_LAS unsigned char*)lds_raw;
    const int G = gridDim.x, c = blockIdx.x;
    volatile LAS unsigned* bst = (volatile LAS unsigned*)(lds + (LDS_BYTES - 64));
    if (threadIdx.x < 2) bst[threadIdx.x] = 0u;
    __syncthreads();
    const XcdBarrier xbar = xcd_barrier_post((unsigned*)(pin.ws + WS_BAR), bst);
    for (int ph = pin.ph_lo; ph < pin.ph_hi; ++ph) {
        Params p = pin;
        { unsigned long long w = (unsigned long long)pin.ws, o = (unsigned long long)pin.out; asm volatile("" : "+s"(w), "+s"(o)); p.ws = (unsigned char*)w; p.out = (float*)o; }
        unsigned char* ws = p.ws;
        bf16* WB = (bf16*)(ws + WS_W);
        bf16* hb = (bf16*)(ws + WS_HB); bf16* mix = (bf16*)(ws + WS_MIX); bf16* big = (bf16*)(ws + WS_BIG);
        unsigned long long* SS = (unsigned long long*)(ws + WS_SS);
        if (ph == 0) prologue_phase(p, lds);
        else if (ph == 23) final_phase(p);
        else {
            const int li = (ph - 1) / 11, r = (ph - 1) % 11;
            const int l = (r < 6) ? 2 * li : 2 * li + 1;
            if (r == 0) { pg8::Gemm g{hb, WB + W_INE + (size_t)li * 4096 * 1024, T, 4096, 1024}; pg8::StaticOrder S; S.init(T, 4096, G, c);
                pg8::EpiEvenIn E{big, SS + (size_t)(2 * l) * T}; pg8::gemm_phase<pg8::EpiEvenIn, pg8::StaticOrder, true, true>(lds, g, S, E); }
            else if (r == 1) { hg2::hgrn_phase(p, li, (char*)lds_raw); att::attn_phase(p, li, (char*)lds_raw); }
            else if (r == 2) { hg::hgpost_phase(p, li); }
            else if (r == 3 || r == 8) { const bf16* Wt = (r == 3) ? WB + W_OUTE + (size_t)li * 1024 * 1024 : WB + W_OUTO + (size_t)li * 1024 * 1024;
                pg8::Gemm g{mix, Wt, T, 1024, 1024}; pg8::StaticOrder S; S.init(T, 1024, G, c);
                pg8::EpiRes E{hb, SS + (size_t)(2 * l + 1) * T}; pg8::gemm_phase<pg8::EpiRes, pg8::StaticOrder, true, true>(lds, g, S, E); }
            else if (r == 4 || r == 9) { pg8::Gemm g{hb, WB + W_FIN + (size_t)l * 5632 * 1024, T, 5632, 1024}; pg8::StaticOrder S; S.init(T, 5632, G, c);
                pg8::EpiFfnIn E{big, SS + (size_t)(2 * l + 1) * T}; pg8::gemm_phase<pg8::EpiFfnIn, pg8::StaticOrder, true, true>(lds, g, S, E); }
            else if (r == 5 || r == 10) { pg8::Gemm g{big, WB + W_FOUT + (size_t)l * 1024 * 2816, T, 1024, 2816}; pg8::StaticOrder S; S.init(T, 1024, G, c);
                pg8::EpiRes E{hb, SS + (size_t)(2 * l + 2) * T}; pg8::gemm_phase<pg8::EpiRes, pg8::StaticOrder, true, true>(lds, g, S, E); }
            else if (r == 6) { pg8::Gemm g{hb, WB + W_INO + (size_t)li * 2048 * 1024, T, 2048, 1024}; pg8::StaticOrder S; S.init(T, 2048, G, c);
                pg8::EpiOddIn E{big, SS + (size_t)(2 * l) * T, SS + (size_t)(9 + li) * T}; pg8::gemm_phase<pg8::EpiOddIn, pg8::StaticOrder, true, true>(lds, g, S, E); }
            else if (r == 7) { sgu::sgu_phase(p, li, (char*)lds_raw); }
        }
        if (ph + 1 < pin.ph_hi) { if (ph == 0) cg::this_grid().sync(); else xcd_barrier(xbar); }
    }
}

#ifndef MK_MULTI
#define MK_MULTI 0
#endif
extern "C" void kernel_launch(void* const* d_in, const int* in_sizes, int n_in, void* d_out, int out_size, void* d_ws, size_t ws_size, hipStream_t stream) {
    static int grid = 0;
    if (grid == 0) {
        if (n_in != 22 || in_sizes[0] != T * D_MODEL || out_size != T * D_MODEL || ws_size < WS_END) { fprintf(stderr, "kernel_launch: unexpected shapes / workspace (n_in %d, in0 %d, out %d, ws %zu need %zu)\n", n_in, n_in > 0 ? in_sizes[0] : -1, out_size, ws_size, (size_t)WS_END); grid = -1; return; }
        int dev = 0, cus = 0, per_cu = 0;
        if (hipGetDevice(&dev) != hipSuccess || hipDeviceGetAttribute(&cus, hipDeviceAttributeMultiprocessorCount, dev) != hipSuccess) { grid = -1; return; }
        if (hipFuncSetAttribute((const void*)mega_fwd, hipFuncAttributeMaxDynamicSharedMemorySize, LDS_BYTES) != hipSuccess) { fprintf(stderr, "kernel_launch: hipFuncSetAttribute failed\n"); grid = -1; return; }
        if (hipOccupancyMaxActiveBlocksPerMultiprocessor(&per_cu, (const void*)mega_fwd, 512, LDS_BYTES) != hipSuccess || per_cu < 1) { fprintf(stderr, "kernel_launch: occupancy query says %d\n", per_cu); per_cu = 1; }
        (void)hipGetLastError();
        grid = cus * 1;
    }
    if (grid < 0) return;
    Params p{};
    const float* const* in = (const float* const*)d_in;
    p.x = in[0]; p.rel_bias = in[1]; p.norm_mix = in[2]; p.norm_ffn = in[3]; p.norm_final = in[4]; p.w_in_even = in[5]; p.w_out_even = in[6];
    p.lq1 = in[7]; p.lk1 = in[8]; p.lq2 = in[9]; p.lk2 = in[10]; p.da_subln = in[11]; p.lb_fwd = in[12]; p.lb_bwd = in[13]; p.hg_norm = in[14];
    p.w_in_odd = in[15]; p.sg_norm = in[16]; p.sg_w = in[17]; p.sg_b = in[18]; p.w_out_odd = in[19]; p.w_ffn_in = in[20]; p.w_ffn_out = in[21];
    p.out = (float*)d_out; p.ws = (unsigned char*)d_ws;
#if MK_MULTI
    for (int ph = 0; ph < NPHASE; ++ph) { p.ph_lo = ph; p.ph_hi = ph + 1; hipLaunchKernelGGL(mega_fwd, dim3(grid), dim3(512), LDS_BYTES, stream, p); }
#else
    p.ph_lo = 0; p.ph_hi = NPHASE;
    if (hipMemsetAsync((char*)d_ws + WS_BAR, 0, XCD_BAR_WORDS * 4, stream) != hipSuccess) { fprintf(stderr, "kernel_launch: memset of the barrier words failed\n"); return; }
    void* args[] = {&p};
    hipError_t e = hipLaunchCooperativeKernel((const void*)mega_fwd, dim3(grid), dim3(512), args, LDS_BYTES, stream);
    if (e != hipSuccess) fprintf(stderr, "cooperative launch failed: %s (grid %d)\n", hipGetErrorString(e), grid);
#endif
}
```

```cpp
#include <hip/hip_runtime.h>
#include <hip/hip_cooperative_groups.h>
#include <cstdio>
#include <cstdint>
namespace cg = cooperative_groups;
namespace pg8 {
#define PG8_LAS __attribute__((address_space(3)))
typedef unsigned short bf16_t;
typedef short bf16x8 __attribute__((ext_vector_type(8)));
typedef float f32x4 __attribute__((ext_vector_type(4)));
typedef unsigned u32x4 __attribute__((ext_vector_type(4)));
constexpr int BM = 256, BK = 64, HALF = 128, HTB = HALF * BK * 2  , STAGE_BYTES = 8 * HTB, NXCD = 8, WGM = 8;

__host__ __device__ __forceinline__ int lds_byte(int r, int c) { const int st = (r >> 4) * 2 + (c >> 5), rr = r & 15, cc = c & 31, ob = rr * 64 + cc * 2; return st * 1024 + (ob ^ (((ob >> 9) & 1) << 5)); }
__host__ __device__ __forceinline__ void stage_rc(int b, int& R, int& C) { const int st = b / 1024, sb = b % 1024, swz = sb ^ (((sb >> 9) & 1) << 5); R = (st >> 1) * 16 + swz / 64; C = (st & 1) * 32 + (swz % 64) / 2; }
__host__ __device__ __forceinline__ int perm32(int rho) { const int n = rho >> 4, i = rho & 15; return 8 * (i >> 2) + 4 * n + (i & 3); }

struct Unit { int pm, pn; };
struct Gemm { const bf16_t* A; const bf16_t* Bt; int M, N, K; };

struct StaticOrder {
    int nM, nN, nwg, G, c;
    __host__ __device__ void init(int M, int N, int G_, int c_) { nM = M / BM; nN = N / BM; nwg = nM * nN; G = G_; c = c_; }
    __host__ __device__ bool next(int i, Unit& u) const {
        const long L = (long)i * G + c; if (L >= nwg) return false;
        int wgid = (int)L; { const int q = nwg / NXCD, r = nwg % NXCD, xcd = wgid % NXCD, off = wgid / NXCD; wgid = (xcd < r ? xcd * (q + 1) : r * (q + 1) + (xcd - r) * q) + off; }
        const int nig = WGM * nN, gid = wgid / nig, fm = gid * WGM, gsz = (nM - fm) < WGM ? (nM - fm) : WGM;
        u.pm = fm + ((wgid % nig) % gsz); u.pn = (wgid % nig) / gsz; return true;
    }
    __device__ __forceinline__ void a_ready(const Unit&) const {}
    __device__ __forceinline__ void done(const Unit&) const {}
};

__device__ __forceinline__ unsigned cvt_pk_bf16(float lo, float hi) { unsigned r; asm volatile("v_cvt_pk_bf16_f32 %0, %1, %2" : "=v"(r) : "v"(lo), "v"(hi)); return r; }
typedef float f32x2 __attribute__((ext_vector_type(2)));
__device__ __forceinline__ f32x2 gelu_pk(f32x2 v) {
    const f32x2 av = __builtin_elementwise_abs(v), d = av * 0.2316418882f + 1.0f;
    f32x2 t; t.x = __builtin_amdgcn_rcpf(d.x); t.y = __builtin_amdgcn_rcpf(d.y);
    f32x2 q = t * 0.5307027145f + (-0.7265760135f); q = q * t + 0.7107068705f; q = q * t + (-0.142248368f); q = q * t + 0.127414796f; q = q * t;
    const f32x2 s = (v * v) * (-0.72134752044f);
    f32x2 e; e.x = __builtin_amdgcn_exp2f(s.x); e.y = __builtin_amdgcn_exp2f(s.y);
    const f32x2 m = v * (q * e), r = v - m;
    f32x2 o; o.x = v.x < 0.f ? m.x : r.x; o.y = v.y < 0.f ? m.y : r.y; return o;
}

constexpr float RMS_EPS = 1e-6f;
__device__ __forceinline__ float ss2f(unsigned long long v) { return (float)v * (1.0f / 16777216.0f); }
__device__ __forceinline__ unsigned long long f2ss(float v) { return (unsigned long long)(v * 16777216.0f); }
struct PreSS { unsigned long long v0, v1; };
struct PreNone {};
__device__ __forceinline__ void prefetch_ss(PreSS& p, const unsigned long long* ss, const Unit& u, int wr, int fr, int fq) {
    const int k0 = 2 * fq, k1 = 2 * fq + 1, base = u.pm * BM + wr * 64 + fr;
    p.v0 = *(const __attribute__((address_space(1))) unsigned long long*)(ss + base + (k0 >> 2) * HALF + (k0 & 3) * 16);
    p.v1 = *(const __attribute__((address_space(1))) unsigned long long*)(ss + base + (k1 >> 2) * HALF + (k1 & 3) * 16);
}
__device__ __forceinline__ void rstd8(float (&r)[8], const PreSS& p, int fr) {
    const float a = __builtin_amdgcn_rsqf(ss2f(p.v0) * (1.0f / 1024.0f) + RMS_EPS), b = __builtin_amdgcn_rsqf(ss2f(p.v1) * (1.0f / 1024.0f) + RMS_EPS);
#pragma unroll
    for (int k = 0; k < 8; ++k) r[k] = __shfl((k & 1) ? b : a, fr + 16 * (k >> 1));
}
__device__ __forceinline__ float silu1(float v) { return v * __builtin_amdgcn_rcpf(1.0f + __builtin_amdgcn_exp2f(-1.4426950408889634f * v)); }
__device__ __forceinline__ f32x4 silu4(f32x4 v) { return (f32x4){silu1(v[0]), silu1(v[1]), silu1(v[2]), silu1(v[3])}; }
__device__ __forceinline__ u32x4 pack8(f32x4 v0, f32x4 v1) { u32x4 w; w.x = cvt_pk_bf16(v0[0], v0[1]); w.y = cvt_pk_bf16(v0[2], v0[3]); w.z = cvt_pk_bf16(v1[0], v1[1]); w.w = cvt_pk_bf16(v1[2], v1[3]); return w; }

struct EpiEvenIn {
    static constexpr bool PERM = true, AFTER_DRAIN = false;
    bf16_t* O; const unsigned long long* ss;
    typedef PreSS Pre;
    __device__ __forceinline__ void prefetch(Pre& p, const Unit& u, int wr, int fr, int fq) const { prefetch_ss(p, ss, u, wr, fr, fq); }
    __device__ __forceinline__ void operator()(const f32x4 (&acc)[2][2][4][2], const Unit& u, int wr, int wc, int fr, int fq, const Pre& pre) const {
        const int row0 = u.pm * BM + wr * 64 + fr, col0 = u.pn * BM + wc * 32 + 8 * fq;
        float rs8[8]; rstd8(rs8, pre, fr);
        const bool act = (u.pn == 6) || (u.pn == 7) || (u.pn == 14) || (u.pn == 15);
        const float sc = (u.pn < 2) ? 0.125f : 1.0f;
#pragma unroll
        for (int ai = 0; ai < 2; ++ai)
#pragma unroll
            for (int m = 0; m < 4; ++m) { const int row = row0 + ai * HALF + m * 16; const float r = rs8[ai * 4 + m] * sc;
                bf16_t* rowp = O + (size_t)row * 4096 + col0;
#pragma unroll
                for (int bj = 0; bj < 2; ++bj) { f32x4 v0 = acc[ai][bj][m][0] * r, v1 = acc[ai][bj][m][1] * r;
                    if (act) { v0 = silu4(v0); v1 = silu4(v1); }
                    *(u32x4*)(rowp + bj * HALF) = pack8(v0, v1); } }
    }
};
struct EpiOddIn {
    static constexpr bool PERM = true, AFTER_DRAIN = false;
    bf16_t* O; const unsigned long long* ss; unsigned long long* vss;
    typedef PreSS Pre;
    __device__ __forceinline__ void prefetch(Pre& p, const Unit& u, int wr, int fr, int fq) const { prefetch_ss(p, ss, u, wr, fr, fq); }
    __device__ __forceinline__ void operator()(const f32x4 (&acc)[2][2][4][2], const Unit& u, int wr, int wc, int fr, int fq, const Pre& pre) const {
        const int row0 = u.pm * BM + wr * 64 + fr, col0 = u.pn * BM + wc * 32 + 8 * fq;
        float rs8[8]; rstd8(rs8, pre, fr);
        const bool isv = u.pn >= 4;
#pragma unroll
        for (int ai = 0; ai < 2; ++ai)
#pragma unroll
            for (int m = 0; m < 4; ++m) { const int row = row0 + ai * HALF + m * 16; const float r = rs8[ai * 4 + m];
                bf16_t* rowp = O + (size_t)row * 2048 + col0; float sq = 0.f;
#pragma unroll
                for (int bj = 0; bj < 2; ++bj) { f32x4 v0 = acc[ai][bj][m][0] * r, v1 = acc[ai][bj][m][1] * r;
                    f32x2 a = gelu_pk((f32x2){v0[0], v0[1]}), b = gelu_pk((f32x2){v0[2], v0[3]}), c = gelu_pk((f32x2){v1[0], v1[1]}), d = gelu_pk((f32x2){v1[2], v1[3]});
                    v0 = (f32x4){a.x, a.y, b.x, b.y}; v1 = (f32x4){c.x, c.y, d.x, d.y};
                    sq += (v0[0] * v0[0] + v0[1] * v0[1]) + (v0[2] * v0[2] + v0[3] * v0[3]) + (v1[0] * v1[0] + v1[1] * v1[1]) + (v1[2] * v1[2] + v1[3] * v1[3]);
                    *(u32x4*)(rowp + bj * HALF) = pack8(v0, v1); }
                if (isv) { sq += __shfl_xor(sq, 16); sq += __shfl_xor(sq, 32); if (fq == 0) atomicAdd(vss + row, f2ss(sq)); } }
    }
};
struct EpiFfnIn {
    static constexpr bool PERM = true, AFTER_DRAIN = false;
    bf16_t* O; const unsigned long long* ss;
    typedef PreSS Pre;
    __device__ __forceinline__ void prefetch(Pre& p, const Unit& u, int wr, int fr, int fq) const { prefetch_ss(p, ss, u, wr, fr, fq); }
    __device__ __forceinline__ void operator()(const f32x4 (&acc)[2][2][4][2], const Unit& u, int wr, int wc, int fr, int fq, const Pre& pre) const {
        const int row0 = u.pm * BM + wr * 64 + fr, col0 = u.pn * HALF + wc * 32 + 8 * fq;
        float rs8[8]; rstd8(rs8, pre, fr);
#pragma unroll
        for (int ai = 0; ai < 2; ++ai)
#pragma unroll
            for (int m = 0; m < 4; ++m) { const int row = row0 + ai * HALF + m * 16; const float r = rs8[ai * 4 + m];
                const f32x4 g0 = silu4(acc[ai][0][m][0] * r), g1 = silu4(acc[ai][0][m][1] * r);
                const f32x4 v0 = g0 * (acc[ai][1][m][0] * r), v1 = g1 * (acc[ai][1][m][1] * r);
                *(u32x4*)(O + (size_t)row * 2816 + col0) = pack8(v0, v1); }
    }
};
struct EpiRes {
    static constexpr bool PERM = true, AFTER_DRAIN = false;
    bf16_t* hb; unsigned long long* ssn;
    typedef PreNone Pre;
    __device__ __forceinline__ void prefetch(Pre&, const Unit&, int, int, int) const {}
    __device__ __forceinline__ void operator()(const f32x4 (&acc)[2][2][4][2], const Unit& u, int wr, int wc, int fr, int fq, const Pre&) const {
        const int row0 = u.pm * BM + wr * 64 + fr, col0 = u.pn * BM + wc * 32 + 8 * fq;
        typedef __attribute__((address_space(1))) u32x4 gu32x4;
        u32x4 bwv[2][4][2];
#pragma unroll
        for (int ai = 0; ai < 2; ++ai)
#pragma unroll
            for (int m = 0; m < 4; ++m)
#pragma unroll
                for (int bj = 0; bj < 2; ++bj) bwv[ai][m][bj] = *(const gu32x4*)(hb + (size_t)(row0 + ai * HALF + m * 16) * 1024 + col0 + bj * HALF);
#pragma unroll
        for (int ai = 0; ai < 2; ++ai)
#pragma unroll
            for (int m = 0; m < 4; ++m) { const int row = row0 + ai * HALF + m * 16; const size_t off = (size_t)row * 1024 + col0; float sq = 0.f;
#pragma unroll
                for (int bj = 0; bj < 2; ++bj) { const u32x4 bw = bwv[ai][m][bj];
                    const f32x4 b0 = (f32x4){__uint_as_float(bw.x << 16), __uint_as_float(bw.x & 0xffff0000u), __uint_as_float(bw.y << 16), __uint_as_float(bw.y & 0xffff0000u)};
                    const f32x4 b1 = (f32x4){__uint_as_float(bw.z << 16), __uint_as_float(bw.z & 0xffff0000u), __uint_as_float(bw.w << 16), __uint_as_float(bw.w & 0xffff0000u)};
                    const f32x4 v0 = acc[ai][bj][m][0] + b0, v1 = acc[ai][bj][m][1] + b1;
                    *(gu32x4*)(hb + off + bj * HALF) = pack8(v0, v1);
                    sq += (v0[0] * v0[0] + v0[1] * v0[1]) + (v0[2] * v0[2] + v0[3] * v0[3]) + (v1[0] * v1[0] + v1[1] * v1[1]) + (v1[2] * v1[2] + v1[3] * v1[3]); }
                sq += __shfl_xor(sq, 16); sq += __shfl_xor(sq, 32); if (fq == 0) atomicAdd(ssn + row, f2ss(sq)); }
    }
};
template <class Epi, class Sched, bool ALIGN_EPI = false, bool SP2 = false>
__device__ __forceinline__ void gemm_phase(PG8_LAS unsigned char* lds, const Gemm g, const Sched& S, const Epi& E) {
    int tid_ = threadIdx.x; asm volatile("" : "+v"(tid_));
    const int tid = tid_, wid = __builtin_amdgcn_readfirstlane(tid >> 6), lane = tid & 63, wr = wid >> 2, wc = wid & 3, fr = lane & 15, fq = lane >> 4;
    const int K = g.K, nt = K / BK;
    unsigned voffA[2], voffB[2];
#pragma unroll
    for (int i = 0; i < 2; ++i) { int R, C; stage_rc(tid * 16 + i * 8192, R, C); const int Rb = Epi::PERM ? ((R & ~31) + perm32(R & 31)) : R;
        voffA[i] = (unsigned)(R * K + C) * 2u; voffB[i] = (unsigned)(Rb * K + C) * 2u; }
    const size_t kstep = (size_t)(BK * 2);
    const size_t hstep = (size_t)HALF * K * 2;
    const size_t tstep = 2 * hstep;
    const unsigned ldsw = (unsigned)wid * 1024u;
    const int aoff = lds_byte(wr * 64 + fr, fq * 8), boff = lds_byte(wc * 32 + fr, fq * 8);
#define PG8_SA(b, h) (((b) * 2 + (h)) * HTB)
#define PG8_SB(b, h) ((4 + (b) * 2 + (h)) * HTB)
#define PG8_STAGE(bufoff, gbase, voff) do { _Pragma("unroll") for (int _i = 0; _i < 2; ++_i) \
        __builtin_amdgcn_global_load_lds((const unsigned*)((const char*)(gbase) + (voff)[_i]), (PG8_LAS unsigned*)(lds + (bufoff) + ldsw + _i * 8192), 16, 0, 0); } while (0)
#define PG8_LDA(dst, b, h) do { _Pragma("unroll") for (int m = 0; m < 4; ++m) _Pragma("unroll") for (int k = 0; k < 2; ++k) dst[m][k] = *(const PG8_LAS bf16x8*)(lds + PG8_SA(b, h) + aoff + m * 2048 + k * 1024); } while (0)
#define PG8_LDB(dst, b, h) do { _Pragma("unroll") for (int n = 0; n < 2; ++n) _Pragma("unroll") for (int k = 0; k < 2; ++k) dst[n][k] = *(const PG8_LAS bf16x8*)(lds + PG8_SB(b, h) + boff + n * 2048 + k * 1024); } while (0)
#define PG8_MMA(ai, bj, At, Bt) do { __builtin_amdgcn_s_setprio(1); _Pragma("unroll") for (int m = 0; m < 4; ++m) _Pragma("unroll") for (int n = 0; n < 2; ++n) _Pragma("unroll") for (int k = 0; k < 2; ++k) \
        acc[ai][bj][m][n] = __builtin_amdgcn_mfma_f32_16x16x32_bf16(Bt[n][k], At[m][k], acc[ai][bj][m][n], 0, 0, 0); __builtin_amdgcn_s_setprio(0); } while (0)
#define PG8_WAIT_V(n) asm volatile("s_waitcnt vmcnt(" #n ")" ::: "memory")
#define PG8_WAIT_L(n) asm volatile("s_waitcnt lgkmcnt(" #n ")" ::: "memory")
#define PG8_BAR __builtin_amdgcn_s_barrier()
#define PG8_SCHED __builtin_amdgcn_sched_barrier(0)
    Unit cur, nxt; int ui = 0;
    if (!S.next(0, cur)) return;
    f32x4 acc[2][2][4][2];
#pragma unroll
    for (int a = 0; a < 2; ++a)
#pragma unroll
        for (int b = 0; b < 2; ++b)
#pragma unroll
            for (int m = 0; m < 4; ++m)
#pragma unroll
                for (int n = 0; n < 2; ++n) acc[a][b][m][n] = (f32x4){0.f, 0.f, 0.f, 0.f};
    bf16x8 At[4][2], B0[2][2], B1[2][2];
    const char* cA = (const char*)g.A + (size_t)cur.pm * tstep; const char* cB = (const char*)g.Bt + (size_t)cur.pn * tstep;
    S.a_ready(cur);
    if constexpr (SP2) {
        PG8_STAGE(PG8_SB(0, 0), cB, voffB); PG8_STAGE(PG8_SB(0, 1), cB + hstep, voffB); PG8_STAGE(PG8_SA(0, 0), cA, voffA); PG8_STAGE(PG8_SA(0, 1), cA + hstep, voffA);
        if (wr == 1) PG8_BAR;
        PG8_WAIT_V(2); PG8_BAR;
        PG8_STAGE(PG8_SB(1, 0), cB + kstep, voffB); PG8_STAGE(PG8_SA(1, 0), cA + kstep, voffA); PG8_STAGE(PG8_SB(1, 1), cB + hstep + kstep, voffB);
        PG8_WAIT_V(6); PG8_BAR;
    } else {
        PG8_STAGE(PG8_SB(0, 0), cB, voffB); PG8_STAGE(PG8_SA(0, 0), cA, voffA); PG8_STAGE(PG8_SB(0, 1), cB + hstep, voffB); PG8_STAGE(PG8_SA(0, 1), cA + hstep, voffA);
        if (wr == 1) PG8_BAR;
        PG8_WAIT_V(4); PG8_BAR;
        PG8_STAGE(PG8_SB(1, 0), cB + kstep, voffB); PG8_STAGE(PG8_SA(1, 0), cA + kstep, voffA); PG8_STAGE(PG8_SB(1, 1), cB + hstep + kstep, voffB);
        PG8_WAIT_V(6); PG8_BAR;
    }
    for (;;) {
        const bool has_next = S.next(ui + 1, nxt);
        typename Epi::Pre pre; E.prefetch(pre, cur, wr, fr, fq);
        const char* nA = has_next ? (const char*)g.A + (size_t)nxt.pm * tstep : cA; const char* nB = has_next ? (const char*)g.Bt + (size_t)nxt.pn * tstep : cB;
        for (int t = 0; t < nt; t += 2) {
            const bool last = (t == nt - 2);
            const char* a1 = cA + (size_t)(t + 1) * kstep;
            const char* a2 = last ? nA : cA + (size_t)(t + 2) * kstep; const char* b2 = last ? nB : cB + (size_t)(t + 2) * kstep;
            const char* a3 = a2 + kstep; const char* b3 = b2 + kstep;
            if (last && has_next) S.a_ready(nxt);
            if constexpr (SP2) {
            PG8_LDB(B0, 0, 0); PG8_LDB(B1, 0, 1); PG8_SCHED; PG8_LDA(At, 0, 0); PG8_STAGE(PG8_SA(1, 1), a1 + hstep, voffA);
            PG8_WAIT_V(8); PG8_WAIT_L(0); PG8_BAR; PG8_MMA(0, 0, At, B0); PG8_MMA(0, 1, At, B1); PG8_BAR; PG8_SCHED;
            PG8_LDA(At, 0, 1); PG8_STAGE(PG8_SB(0, 0), b2, voffB); PG8_STAGE(PG8_SB(0, 1), b2 + hstep, voffB); PG8_STAGE(PG8_SA(0, 0), a2, voffA);
            PG8_WAIT_V(8); PG8_WAIT_L(0); PG8_BAR; PG8_MMA(1, 0, At, B0); PG8_MMA(1, 1, At, B1); PG8_BAR; PG8_SCHED;
            PG8_LDB(B0, 1, 0); PG8_LDB(B1, 1, 1); PG8_SCHED; PG8_LDA(At, 1, 0); PG8_STAGE(PG8_SA(0, 1), a2 + hstep, voffA);
            PG8_WAIT_V(8); PG8_WAIT_L(0); PG8_BAR; PG8_MMA(0, 0, At, B0); PG8_MMA(0, 1, At, B1); PG8_BAR; PG8_SCHED;
            PG8_LDA(At, 1, 1); PG8_STAGE(PG8_SB(1, 0), b3, voffB); PG8_STAGE(PG8_SB(1, 1), b3 + hstep, voffB); PG8_STAGE(PG8_SA(1, 0), a3, voffA);
            PG8_WAIT_V(8); PG8_WAIT_L(0); PG8_BAR; PG8_MMA(1, 0, At, B0); PG8_MMA(1, 1, At, B1); PG8_BAR; PG8_SCHED;
            } else {
            PG8_LDB(B0, 0, 0); PG8_SCHED; PG8_LDA(At, 0, 0); PG8_STAGE(PG8_SA(1, 1), a1 + hstep, voffA);
            PG8_WAIT_L(8); PG8_BAR; PG8_WAIT_L(0); PG8_MMA(0, 0, At, B0); PG8_BAR; PG8_SCHED;
            PG8_LDB(B1, 0, 1); PG8_STAGE(PG8_SB(0, 0), b2, voffB);
            PG8_BAR; PG8_WAIT_L(0); PG8_MMA(0, 1, At, B1); PG8_BAR;
            PG8_LDA(At, 0, 1); PG8_STAGE(PG8_SA(0, 0), a2, voffA);
            PG8_BAR; PG8_WAIT_L(0); PG8_MMA(1, 0, At, B0); PG8_BAR; PG8_SCHED;
            PG8_STAGE(PG8_SB(0, 1), b2 + hstep, voffB);
            PG8_WAIT_V(6); PG8_BAR; PG8_MMA(1, 1, At, B1); PG8_BAR;
            PG8_LDB(B0, 1, 0); PG8_SCHED; PG8_LDA(At, 1, 0); PG8_STAGE(PG8_SA(0, 1), a2 + hstep, voffA);
            PG8_WAIT_L(8); PG8_BAR; PG8_WAIT_L(0); PG8_MMA(0, 0, At, B0); PG8_BAR; PG8_SCHED;
            PG8_LDB(B1, 1, 1); PG8_STAGE(PG8_SB(1, 0), b3, voffB);
            PG8_BAR; PG8_WAIT_L(0); PG8_MMA(0, 1, At, B1); PG8_BAR;
            PG8_LDA(At, 1, 1); PG8_STAGE(PG8_SA(1, 0), a3, voffA);
            PG8_BAR; PG8_WAIT_L(0); PG8_MMA(1, 0, At, B0); PG8_BAR; PG8_SCHED;
            PG8_STAGE(PG8_SB(1, 1), b3 + hstep, voffB);
            PG8_WAIT_V(6); PG8_BAR; PG8_MMA(1, 1, At, B1); PG8_BAR;
            }
        }
        if constexpr (ALIGN_EPI) { if (wr == 0) PG8_BAR; }
        if constexpr (!Epi::AFTER_DRAIN) { E(acc, cur, wr, wc, fr, fq, pre); S.done(cur); }
        if (!has_next) break;
#pragma unroll
        for (int a = 0; a < 2; ++a)
#pragma unroll
            for (int b = 0; b < 2; ++b)
#pragma unroll
                for (int m = 0; m < 4; ++m)
#pragma unroll
                    for (int n = 0; n < 2; ++n) acc[a][b][m][n] = (f32x4){0.f, 0.f, 0.f, 0.f};
        cur = nxt; cA = nA; cB = nB; ++ui;
        if constexpr (ALIGN_EPI) { if (wr == 1) PG8_BAR; }
    }
    PG8_WAIT_V(0);
    if constexpr (!ALIGN_EPI) { if (wr == 0) PG8_BAR; }
    PG8_BAR;
    if constexpr (Epi::AFTER_DRAIN) { E.fused(acc, cur, wr, wc, fr, fq, lds, wid, lane); S.done(cur); }
#undef PG8_SA
#undef PG8_SB
#undef PG8_STAGE
#undef PG8_LDA
#undef PG8_LDB
#undef PG8_MMA
#undef PG8_WAIT_V
#undef PG8_WAIT_L
#undef PG8_BAR
#undef PG8_SCHED
}
}

constexpr int D_MODEL = 1024, BATCH = 16, SEQ = 4096, T = BATCH * SEQ, DFF = 2816, DEPTH = 4;
constexpr int EVEN_IN = 4096, ODD_IN = 2048;
constexpr float EPS = 1e-6f;
typedef unsigned short bf16;
typedef unsigned u32x4 __attribute__((ext_vector_type(4)));
typedef unsigned u32x2 __attribute__((ext_vector_type(2)));
typedef float f32x4 __attribute__((ext_vector_type(4)));
typedef float f32x2 __attribute__((ext_vector_type(2)));
typedef float f32x8 __attribute__((ext_vector_type(8)));
typedef float f32x16 __attribute__((ext_vector_type(16)));
typedef short bf16x8 __attribute__((ext_vector_type(8)));
typedef short s16x4 __attribute__((ext_vector_type(4)));
#define LAS __attribute__((address_space(3)))
#define GAS __attribute__((address_space(1)))

constexpr size_t MiB = 1u << 20;
constexpr size_t WS_SS = 0;
constexpr size_t WS_BAR = 6 * MiB;
constexpr size_t WS_W = 8 * MiB;
constexpr size_t W_INE = 0, W_OUTE = W_INE + 2ull * 4096 * 1024, W_INO = W_OUTE + 2ull * 1024 * 1024, W_OUTO = W_INO + 2ull * 2048 * 1024,
                 W_FIN = W_OUTO + 2ull * 1024 * 1024, W_FOUT = W_FIN + 4ull * 5632 * 1024, W_SGW = W_FOUT + 4ull * 1024 * 2816, W_END = W_SGW + 2ull * 8 * 128 * 128;
static_assert(WS_W + W_END * 2 <= 108 * MiB, "weights");
constexpr size_t WS_ASCR = 108 * MiB;
constexpr size_t WS_HB = 140 * MiB;
constexpr size_t WS_MIX = 268 * MiB;
constexpr size_t WS_BIG = 396 * MiB;
constexpr size_t WS_END = 908 * MiB;
constexpr int LDS_BYTES = 147456;

struct Params {
    const float* x; const float* rel_bias; const float* norm_mix; const float* norm_ffn; const float* norm_final; const float* w_in_even; const float* w_out_even;
    const float* lq1; const float* lk1; const float* lq2; const float* lk2; const float* da_subln; const float* lb_fwd; const float* lb_bwd; const float* hg_norm;
    const float* w_in_odd; const float* sg_norm; const float* sg_w; const float* sg_b; const float* w_out_odd; const float* w_ffn_in; const float* w_ffn_out;
    float* out; unsigned char* ws; int ph_lo, ph_hi;
};

__device__ __forceinline__ unsigned cvtpk(float lo, float hi) { unsigned r; asm volatile("v_cvt_pk_bf16_f32 %0, %1, %2" : "=v"(r) : "v"(lo), "v"(hi)); return r; }
typedef __bf16 bf16v2 __attribute__((ext_vector_type(2)));
__device__ __forceinline__ unsigned cvtpk_c(float lo, float hi) { bf16v2 v; v.x = (__bf16)lo; v.y = (__bf16)hi; return __builtin_bit_cast(unsigned, v); }
__device__ __forceinline__ float bf2f(unsigned short b) { return __uint_as_float(((unsigned)b) << 16); }
__device__ __forceinline__ float bflo(unsigned w) { return __uint_as_float(w << 16); }
__device__ __forceinline__ float bfhi(unsigned w) { return __uint_as_float(w & 0xffff0000u); }
__device__ __forceinline__ float wave_sum(float v) {
#pragma unroll
    for (int o = 1; o < 64; o <<= 1) v += __shfl_xor(v, o);
    return v;
}

__device__ __forceinline__ void transpose_item(const float* W, int K, int N, bf16* WT, const float* gain, int ffn_perm, LAS float* scr, int item, int lane) {
    const int nblk = N / 32, kb = item / nblk, nb = item % nblk, k0 = 64 * kb, n0 = 32 * nb;
    float wv[32];
#pragma unroll
    for (int i = 0; i < 32; ++i) { const int kk = 2 * i + (lane >> 5); wv[i] = W[(size_t)(k0 + kk) * N + n0 + (lane & 31)]; }
#pragma unroll
    for (int i = 0; i < 32; ++i) { const int kk = 2 * i + (lane >> 5); const float g = gain ? gain[k0 + kk] : 1.0f; scr[kk * 33 + (lane & 31)] = wv[i] * g; }
    asm volatile("s_waitcnt lgkmcnt(0)" ::: "memory");
    int r0 = n0;
    if (ffn_perm) { r0 = (n0 < DFF) ? ((n0 >> 7) * 256 + (n0 & 127)) : (((n0 - DFF) >> 7) * 256 + 128 + ((n0 - DFF) & 127)); }
    const int c = lane & 7;
#pragma unroll
    for (int j = 0; j < 4; ++j) { const int n = (lane >> 3) + 8 * j; const LAS float* s = scr + (8 * c) * 33 + n;
        u32x4 o; o.x = cvtpk(s[0 * 33], s[1 * 33]); o.y = cvtpk(s[2 * 33], s[3 * 33]); o.z = cvtpk(s[4 * 33], s[5 * 33]); o.w = cvtpk(s[6 * 33], s[7 * 33]);
        *(u32x4*)(WT + (size_t)(r0 + n) * K + k0 + 8 * c) = o; }
    asm volatile("s_waitcnt lgkmcnt(0)" ::: "memory");
}

__device__ __forceinline__ void prologue_phase(const Params& p, LAS unsigned char* lds) {
    int tid_ = threadIdx.x; asm volatile("" : "+v"(tid_));
    const int tid = tid_, lane = tid & 63, wave = tid >> 6;
    const int gw = blockIdx.x * 8 + wave, NGW = gridDim.x * 8;
    const int gt = blockIdx.x * 512 + tid, NGT = gridDim.x * 512;
    { f32x4* z = (f32x4*)(p.ws + WS_SS); for (int i = T / 2 + gt; i < 11 * T / 2; i += NGT) z[i] = (f32x4){0.f, 0.f, 0.f, 0.f}; }
    bf16* WB = (bf16*)(p.ws + WS_W);
    LAS float* scr = (LAS float*)(lds + wave * 16384);
    constexpr int I_INE = 16 * 128, I_OUT = 16 * 32, I_INO = 16 * 64, I_FIN = 16 * 176, I_FOUT = 44 * 32;
    constexpr int NITEMS = 2 * I_INE + 2 * I_OUT + 2 * I_INO + 2 * I_OUT + 4 * I_FIN + 4 * I_FOUT;
    for (int it = gw; it < NITEMS; it += NGW) {
        int r = it;
        if (r < 2 * I_INE) { const int e = r / I_INE; transpose_item(p.w_in_even + (size_t)e * 1024 * 4096, 1024, 4096, WB + W_INE + (size_t)e * 4096 * 1024, p.norm_mix + (2 * e) * 1024, 0, scr, r % I_INE, lane); continue; } r -= 2 * I_INE;
        if (r < 2 * I_OUT) { const int e = r / I_OUT; transpose_item(p.w_out_even + (size_t)e * 1024 * 1024, 1024, 1024, WB + W_OUTE + (size_t)e * 1024 * 1024, nullptr, 0, scr, r % I_OUT, lane); continue; } r -= 2 * I_OUT;
        if (r < 2 * I_INO) { const int e = r / I_INO; transpose_item(p.w_in_odd + (size_t)e * 1024 * 2048, 1024, 2048, WB + W_INO + (size_t)e * 2048 * 1024, p.norm_mix + (2 * e + 1) * 1024, 0, scr, r % I_INO, lane); continue; } r -= 2 * I_INO;
        if (r < 2 * I_OUT) { const int e = r / I_OUT; transpose_item(p.w_out_odd + (size_t)e * 1024 * 1024, 1024, 1024, WB + W_OUTO + (size_t)e * 1024 * 1024, nullptr, 0, scr, r % I_OUT, lane); continue; } r -= 2 * I_OUT;
        if (r < 4 * I_FIN) { const int l = r / I_FIN; transpose_item(p.w_ffn_in + (size_t)l * 1024 * 5632, 1024, 5632, WB + W_FIN + (size_t)l * 5632 * 1024, p.norm_ffn + l * 1024, 1, scr, r % I_FIN, lane); continue; } r -= 4 * I_FIN;
        { const int l = r / I_FOUT; transpose_item(p.w_ffn_out + (size_t)l * 2816 * 1024, 2816, 1024, WB + W_FOUT + (size_t)l * 1024 * 2816, nullptr, 0, scr, r % I_FOUT, lane); }
    }
    { const f32x4* s = (const f32x4*)p.sg_w; u32x2* d = (u32x2*)(WB + W_SGW);
      for (int i = gt; i < 2 * 8 * 128 * 128 / 4; i += NGT) { const f32x4 v = s[i]; u32x2 o; o.x = cvtpk(v[0], v[1]); o.y = cvtpk(v[2], v[3]); d[i] = o; } }
    { unsigned long long* ss0 = (unsigned long long*)(p.ws + WS_SS); bf16* hb = (bf16*)(p.ws + WS_HB);
      for (int m = gw; m < T; m += 2 * NGW) {
        const int m1 = m + NGW; const bool has1 = m1 < T;
        const f32x4* xr0 = (const f32x4*)(p.x + (size_t)m * 1024) + lane; const f32x4* xr1 = (const f32x4*)(p.x + (size_t)(has1 ? m1 : m) * 1024) + lane;
        f32x4 a[4], b[4];
#pragma unroll
        for (int j = 0; j < 4; ++j) { a[j] = xr0[64 * j]; b[j] = xr1[64 * j]; }
        float s0 = 0.f, s1 = 0.f;
        u32x2* o0 = (u32x2*)(hb + (size_t)m * 1024) + lane; u32x2* o1 = (u32x2*)(hb + (size_t)m1 * 1024) + lane;
#pragma unroll
        for (int j = 0; j < 4; ++j) { const f32x4 v = a[j]; s0 += (v[0] * v[0] + v[1] * v[1]) + (v[2] * v[2] + v[3] * v[3]); u32x2 w; w.x = cvtpk(v[0], v[1]); w.y = cvtpk(v[2], v[3]); o0[64 * j] = w; }
        if (has1) {
#pragma unroll
          for (int j = 0; j < 4; ++j) { const f32x4 v = b[j]; s1 += (v[0] * v[0] + v[1] * v[1]) + (v[2] * v[2] + v[3] * v[3]); u32x2 w; w.x = cvtpk(v[0], v[1]); w.y = cvtpk(v[2], v[3]); o1[64 * j] = w; } }
        s0 = wave_sum(s0); s1 = wave_sum(s1);
        if (lane == 0) { ss0[m] = pg8::f2ss(s0); if (has1) ss0[m1] = pg8::f2ss(s1); } } }
}

__device__ __forceinline__ void final_phase(const Params& p) {
    int tid_ = threadIdx.x; asm volatile("" : "+v"(tid_));
    const int tid = tid_, lane = tid & 63, wave = tid >> 6;
    const int gw = blockIdx.x * 8 + wave, NGW = gridDim.x * 8;
    const unsigned long long* ss = (const unsigned long long*)(p.ws + WS_SS) + (size_t)8 * T;
    const bf16* hb = (const bf16*)(p.ws + WS_HB);
    f32x4 g0[2], g1[2];
#pragma unroll
    for (int j = 0; j < 2; ++j) { const int c = j * 512 + lane * 8; g0[j] = *(const f32x4*)(p.norm_final + c); g1[j] = *(const f32x4*)(p.norm_final + c + 4); }
    for (int m0 = gw; m0 < T; m0 += 4 * NGW) {
        u32x4 w[4][2]; unsigned long long sv[4];
#pragma unroll
        for (int q = 0; q < 4; ++q) { const int m = m0 + q * NGW; const int mc = m < T ? m : m0; sv[q] = ss[mc];
#pragma unroll
            for (int j = 0; j < 2; ++j) w[q][j] = *(const u32x4*)(hb + (size_t)mc * 1024 + j * 512 + lane * 8); }
#pragma unroll
        for (int q = 0; q < 4; ++q) { const int m = m0 + q * NGW; if (m < T) { const float r = __builtin_amdgcn_rsqf(pg8::ss2f(sv[q]) * (1.0f / 1024.0f) + EPS);
#pragma unroll
            for (int j = 0; j < 2; ++j) { const int c = j * 512 + lane * 8; const u32x4 x = w[q][j];
                const f32x4 v0 = (f32x4){bflo(x.x), bfhi(x.x), bflo(x.y), bfhi(x.y)}, v1 = (f32x4){bflo(x.z), bfhi(x.z), bflo(x.w), bfhi(x.w)};
                *(f32x4*)(p.out + (size_t)m * 1024 + c) = v0 * r * g0[j]; *(f32x4*)(p.out + (size_t)m * 1024 + c + 4) = v1 * r * g1[j]; } } } }
}

namespace att {
constexpr int KVBLK = 64, LDK = 4096;
constexpr int SHM_V = 64 * 128 * 2, SHM_K = 64 * 64 * 2;
constexpr int OFF_V = 0, OFF_K = 3 * SHM_V, OFF_WS = OFF_K + 3 * SHM_K, OFF_TB = OFF_WS + 8 * 64 * 4, OFF_OST = OFF_TB + 1552, OST_PITCH = 272, OFF_END = OFF_OST + 8 * 32 * OST_PITCH;
constexpr float LOG2E = 1.4426950408889634f;
constexpr float C1 = LOG2E;
constexpr float THR2 = 8.0f * LOG2E;
#define KSWZ64(row, colB) ((row) * 128 + ((colB) ^ ((((row) >> 1) & 7) << 4)))
#define SBAR() __builtin_amdgcn_sched_barrier(0)
__device__ __forceinline__ int crow(int r, int hi) { return (r & 3) + 8 * (r >> 2) + 4 * hi; }

__device__ __forceinline__ void partialSM(f32x16& p0, f32x16& p1, float& m_reg, float& mn, float& alpha, int kt0, int qpos, int qw, int hi, const float* tb2, float cL, float cR) {
  const int rel_hi = kt0 + 63 - qw, rel_lo = kt0 - (qw + 31);
  if (rel_hi <= -91 || rel_lo >= 91) {
    const float c = (rel_hi <= -91) ? cL : cR;
    float pmax = p0[0];
#pragma unroll
    for (int r = 1; r < 16; ++r) pmax = fmaxf(pmax, p0[r]);
#pragma unroll
    for (int r = 0; r < 16; ++r) pmax = fmaxf(pmax, p1[r]);
    pmax = fmaf(pmax, C1, c);
    { auto rr = __builtin_amdgcn_permlane32_swap(__float_as_uint(pmax), __float_as_uint(pmax), false, false);
      pmax = fmaxf(__uint_as_float(rr[0]), __uint_as_float(rr[1])); }
    if (__builtin_expect(__all(pmax - m_reg <= THR2), 1)) { mn = m_reg; alpha = 1.f; }
    else { mn = fmaxf(m_reg, pmax); alpha = __builtin_amdgcn_exp2f(m_reg - mn); m_reg = mn; }
    const float cm = c - mn;
#pragma unroll
    for (int r = 0; r < 16; ++r) { p0[r] = fmaf(p0[r], C1, cm); p1[r] = fmaf(p1[r], C1, cm); }
#pragma unroll
    for (int r = 0; r < 16; ++r) p0[r] = __builtin_amdgcn_exp2f(p0[r]);
    return;
  }
  {
    const float* tp = tb2 + (kt0 - qpos + 192 + 4 * hi);
#pragma unroll
    for (int r4 = 0; r4 < 4; ++r4) {
      float ta[4], tb[4];
#pragma unroll
      for (int i = 0; i < 4; ++i) { ta[i] = tp[8 * r4 + i]; tb[i] = tp[32 + 8 * r4 + i]; }
#pragma unroll
      for (int i = 0; i < 4; ++i) { p0[4 * r4 + i] = fmaf(p0[4 * r4 + i], C1, ta[i]); p1[4 * r4 + i] = fmaf(p1[4 * r4 + i], C1, tb[i]); }
      asm volatile("" ::: "memory");
    }
  }
  float pmax = p0[0];
#pragma unroll
  for (int r = 1; r < 16; ++r) pmax = fmaxf(pmax, p0[r]);
#pragma unroll
  for (int r = 0; r < 16; ++r) pmax = fmaxf(pmax, p1[r]);
  { auto rr = __builtin_amdgcn_permlane32_swap(__float_as_uint(pmax), __float_as_uint(pmax), false, false);
    pmax = fmaxf(__uint_as_float(rr[0]), __uint_as_float(rr[1])); }
  if (__builtin_expect(__all(pmax - m_reg <= THR2), 1)) { mn = m_reg; alpha = 1.f; }
  else { mn = fmaxf(m_reg, pmax); alpha = __builtin_amdgcn_exp2f(m_reg - mn); m_reg = mn; }
#pragma unroll
  for (int r = 0; r < 16; ++r) { p0[r] = p0[r] - mn; p1[r] = p1[r] - mn; }
#pragma unroll
  for (int r = 0; r < 16; ++r) p0[r] = __builtin_amdgcn_exp2f(p0[r]);
}
__device__ __forceinline__ void finishSM(f32x16& p0, f32x16& p1, float alpha, float& l_reg, bf16x8& pa0, bf16x8& pa1, bf16x8& pa2, bf16x8& pa3) {
#pragma unroll
  for (int r = 0; r < 16; ++r) p1[r] = __builtin_amdgcn_exp2f(p1[r]);
  float ps = 0;
#pragma unroll
  for (int r = 0; r < 16; ++r) ps += p0[r];
#pragma unroll
  for (int r = 0; r < 16; ++r) ps += p1[r];
  { auto rr = __builtin_amdgcn_permlane32_swap(__float_as_uint(ps), __float_as_uint(ps), false, false);
    ps = __uint_as_float(rr[0]) + __uint_as_float(rr[1]); }
  l_reg = l_reg * alpha + ps;
#define PK4(P, BASE, OUT) do { unsigned a0 = cvtpk(P[BASE + 0], P[BASE + 1]), a1 = cvtpk(P[BASE + 2], P[BASE + 3]);   \
    unsigned b0 = cvtpk(P[BASE + 4], P[BASE + 5]), b1 = cvtpk(P[BASE + 6], P[BASE + 7]);                              \
    auto r0 = __builtin_amdgcn_permlane32_swap(a0, b0, false, false); auto r1 = __builtin_amdgcn_permlane32_swap(a1, b1, false, false); \
    u32x4 w = {r0[0], r1[0], r0[1], r1[1]}; OUT = *reinterpret_cast<bf16x8*>(&w); } while (0)
  PK4(p0, 0, pa0); PK4(p0, 8, pa1); PK4(p1, 0, pa2); PK4(p1, 8, pa3);
#undef PK4
}
__device__ __forceinline__ void qkt(f32x16& p0, f32x16& p1, const char* Ks, const bf16x8* qr, int r32, int hi) {
  bf16x8 ka[4], kb[4];
#pragma unroll
  for (int d0 = 0; d0 < 4; ++d0) { const int cb = (d0 * 16 + hi * 8) * 2;
    ka[d0] = *reinterpret_cast<const bf16x8*>(Ks + KSWZ64(r32, cb)); kb[d0] = *reinterpret_cast<const bf16x8*>(Ks + KSWZ64(32 + r32, cb)); }
  asm volatile("s_waitcnt lgkmcnt(0)" ::: "memory"); SBAR();
  p0 = f32x16{}; p1 = f32x16{};
#pragma unroll
  for (int d0 = 0; d0 < 4; ++d0) {
    p0 = __builtin_amdgcn_mfma_f32_32x32x16_bf16(ka[d0], qr[d0], p0, 0, 0, 0);
    p1 = __builtin_amdgcn_mfma_f32_32x32x16_bf16(kb[d0], qr[d0], p1, 0, 0, 0); }
}
__device__ __forceinline__ int v_st(int k, int c) { const int kk = (k & ~0xC) | ((k & 4) << 1) | ((k & 8) >> 1); return ((kk >> 3) * 4 + (c >> 5)) * 512 + ((kk & 7) * 32 + (c & 31)) * 2; }
__device__ __forceinline__ int v_rd_base(int lane) { return ((lane & 3) << 3) | (((lane >> 2) & 3) << 6) | (((lane >> 4) & 1) << 5) | (((lane >> 5) & 1) << 8); }
constexpr int v_rd_off(int d0, int ks, int half) { return d0 * 512 + ks * 4096 + half * 2048; }
template <int OFF> __device__ __forceinline__ s16x4 tr_read(int vb) {
  s16x4 r; asm volatile("ds_read_b64_tr_b16 %0, %1 offset:%2" : "=&v"(r) : "v"(vb), "i"(OFF) : "memory"); return r;
}
template <int D0> __device__ __forceinline__ void pv_one(f32x16& od, int vb, bf16x8 pa0, bf16x8 pa1, bf16x8 pa2, bf16x8 pa3) {
  const s16x4 l0 = tr_read<v_rd_off(D0, 0, 0)>(vb), h0 = tr_read<v_rd_off(D0, 0, 1)>(vb), l1 = tr_read<v_rd_off(D0, 1, 0)>(vb), h1 = tr_read<v_rd_off(D0, 1, 1)>(vb);
  const s16x4 l2 = tr_read<v_rd_off(D0, 2, 0)>(vb), h2 = tr_read<v_rd_off(D0, 2, 1)>(vb), l3 = tr_read<v_rd_off(D0, 3, 0)>(vb), h3 = tr_read<v_rd_off(D0, 3, 1)>(vb);
  asm volatile("s_waitcnt lgkmcnt(0)" ::: "memory"); SBAR();
#define PK(L, H) (bf16x8){L[0], L[1], L[2], L[3], H[0], H[1], H[2], H[3]}
  od = __builtin_amdgcn_mfma_f32_32x32x16_bf16(pa0, PK(l0, h0), od, 0, 0, 0);
  od = __builtin_amdgcn_mfma_f32_32x32x16_bf16(pa1, PK(l1, h1), od, 0, 0, 0);
  od = __builtin_amdgcn_mfma_f32_32x32x16_bf16(pa2, PK(l2, h2), od, 0, 0, 0);
  od = __builtin_amdgcn_mfma_f32_32x32x16_bf16(pa3, PK(l3, h3), od, 0, 0, 0);
#undef PK
}
__device__ __forceinline__ void pv_d0(f32x16* o, int vb, bf16x8 pa0, bf16x8 pa1, bf16x8 pa2, bf16x8 pa3) {
  pv_one<0>(o[0], vb, pa0, pa1, pa2, pa3); pv_one<1>(o[1], vb, pa0, pa1, pa2, pa3); pv_one<2>(o[2], vb, pa0, pa1, pa2, pa3); pv_one<3>(o[3], vb, pa0, pa1, pa2, pa3);
}

template <bool GRPB> __device__ __forceinline__ void attn_pass(const int pass, float* __restrict__ scr, bf16* __restrict__ mixrow, const float lam, const float* __restrict__ gsub, const float one_m_li,
                                          const bf16* __restrict__ Qb, const bf16* __restrict__ Kh, const bf16* __restrict__ Vh, int q0seq, char* lds, const float* tb2) {
  int tid_ = threadIdx.x; asm volatile("" : "+v"(tid_));
  const int tid = tid_, wid = tid >> 6, lane = tid & 63, r32 = lane & 31, hi = lane >> 5;
  char* V_lds = lds + OFF_V; char* K_lds = lds + OFF_K;
  float* ws = (float*)(lds + OFF_WS) + wid * 64; float* li_l = ws; float* al_l = ws + 32; char* ost = lds + OFF_OST + wid * (32 * OST_PITCH);
  const float cL = __uint_as_float(__builtin_amdgcn_readfirstlane(__float_as_uint(tb2[0]))), cR = __uint_as_float(__builtin_amdgcn_readfirstlane(__float_as_uint(tb2[384])));
  const int qw = __builtin_amdgcn_readfirstlane(q0seq + wid * 32), qpos = qw + r32;
  float m_reg = -1e30f, l_reg = 0; bf16x8 qr[4]; f32x16 o[4];
#pragma unroll
  for (int d = 0; d < 4; ++d) o[d] = f32x16{};
  const bf16* Qw = Qb + (long)(wid * 32 + r32) * LDK + hi * 8;
#pragma unroll
  for (int d0 = 0; d0 < 4; ++d0) qr[d0] = *(const GAS bf16x8*)(Qw + d0 * 16);
  const int sr = tid >> 4, sc = (tid & 15) * 8, vst0 = v_st(sr, sc), vst1 = v_st(32 + sr, sc);
  const int kr = tid >> 3, kc = (tid & 7) * 8, kst = KSWZ64(kr, kc * 2);
  const int vb0 = (int)(uintptr_t)V_lds + v_rd_base(lane);
  struct { bf16x8 vs0, vs1, ks0; } sr_[2];
#define SLOAD(i, k0) do { sr_[i].vs0 = *(const GAS bf16x8*)(&Vh[(long)((k0) + sr) * LDK + sc]); sr_[i].vs1 = *(const GAS bf16x8*)(&Vh[(long)((k0) + 32 + sr) * LDK + sc]); \
    sr_[i].ks0 = *(const GAS bf16x8*)(&Kh[(long)((k0) + kr) * LDK + kc]); } while (0)
#define SWRITE(b, i) do { *(bf16x8*)(V_lds + (b) * SHM_V + vst0) = sr_[i].vs0; *(bf16x8*)(V_lds + (b) * SHM_V + vst1) = sr_[i].vs1; \
    *(bf16x8*)(K_lds + (b) * SHM_K + kst) = sr_[i].ks0; } while (0)
#define SWAIT() asm volatile("s_waitcnt vmcnt(3)" ::: "memory")
#define RESC(a) do { if (__any((a) < 1.f)) { if (hi == 0) al_l[r32] = (a); asm volatile("s_waitcnt lgkmcnt(0)" ::: "memory"); \
    _Pragma("unroll") for (int d = 0; d < 4; ++d) _Pragma("unroll") for (int r = 0; r < 16; ++r) o[d][r] *= al_l[crow(r, hi)]; } } while (0)
  f32x16 pA0, pA1, pB0, pB1; float mnA, mnB, alA, alB; bf16x8 pa0, pa1, pa2, pa3; constexpr int NT = SEQ / KVBLK;
  __syncthreads();
  SLOAD(0, 0); SLOAD(1, KVBLK); asm volatile("s_waitcnt vmcnt(0)" ::: "memory"); SWRITE(0, 0); SWRITE(1, 1);
  SLOAD(0, 2 * KVBLK); asm volatile("s_waitcnt vmcnt(0)" ::: "memory"); SWRITE(2, 0); __syncthreads();
  qkt(pA0, pA1, K_lds, qr, r32, hi); partialSM(pA0, pA1, m_reg, mnA, alA, 0, qpos, qw, hi, tb2, cL, cR);
  int bm1 = 0, b0 = 1, bp1 = 2;
#define HSTEP(N0, N1, MN, AL, C0, C1, ALC, TPOS, LOADSTMT) do { \
    if constexpr (GRPB) { SBAR(); finishSM(C0, C1, ALC, l_reg, pa0, pa1, pa2, pa3); SBAR(); qkt(N0, N1, K_lds + b0 * SHM_K, qr, r32, hi); SBAR(); LOADSTMT; SBAR(); \
                partialSM(N0, N1, m_reg, MN, AL, (TPOS), qpos, qw, hi, tb2, cL, cR); SBAR(); pv_d0(o, vb0 + bm1 * SHM_V, pa0, pa1, pa2, pa3); } \
    else      { SBAR(); qkt(N0, N1, K_lds + b0 * SHM_K, qr, r32, hi); finishSM(C0, C1, ALC, l_reg, pa0, pa1, pa2, pa3); SBAR(); LOADSTMT; SBAR(); \
                pv_d0(o, vb0 + bm1 * SHM_V, pa0, pa1, pa2, pa3); partialSM(N0, N1, m_reg, MN, AL, (TPOS), qpos, qw, hi, tb2, cL, cR); } } while (0)
  for (int t = 1; t + 1 < NT; t += 2) {
    HSTEP(pB0, pB1, mnB, alB, pA0, pA1, alA, t * KVBLK, SLOAD(0, (t + 2) * KVBLK));
    __syncthreads(); SWRITE(bm1, 0);
    RESC(alB);
    { const int tmp = bm1; bm1 = b0; b0 = bp1; bp1 = tmp; }
    HSTEP(pA0, pA1, mnA, alA, pB0, pB1, alB, (t + 1) * KVBLK, if (t + 3 < NT) SLOAD(0, (t + 3) * KVBLK));
    __syncthreads(); if (t + 3 < NT) SWRITE(bm1, 0);
    RESC(alA);
    { const int tmp = bm1; bm1 = b0; b0 = bp1; bp1 = tmp; }
  }
#undef HSTEP
  SBAR(); qkt(pB0, pB1, K_lds + b0 * SHM_K, qr, r32, hi);
  finishSM(pA0, pA1, alA, l_reg, pa0, pa1, pa2, pa3); SBAR();
  pv_d0(o, vb0 + bm1 * SHM_V, pa0, pa1, pa2, pa3); partialSM(pB0, pB1, m_reg, mnB, alB, (NT - 1) * KVBLK, qpos, qw, hi, tb2, cL, cR);
  RESC(alB);
  finishSM(pB0, pB1, alB, l_reg, pa0, pa1, pa2, pa3); SBAR();
  pv_d0(o, vb0 + b0 * SHM_V, pa0, pa1, pa2, pa3);
  if (hi == 0) li_l[r32] = l_reg; asm volatile("s_waitcnt lgkmcnt(0)" ::: "memory");
  GAS f32x4* scr4 = (GAS f32x4*)(scr + (size_t)tid * 64);
  if (pass == 0) {
#pragma unroll
    for (int r4 = 0; r4 < 4; ++r4) { const f32x4 lv = *(const f32x4*)(li_l + 8 * r4 + 4 * hi);
      const f32x4 rl = (f32x4){__builtin_amdgcn_rcpf(lv[0]), __builtin_amdgcn_rcpf(lv[1]), __builtin_amdgcn_rcpf(lv[2]), __builtin_amdgcn_rcpf(lv[3])};
#pragma unroll
      for (int d0 = 0; d0 < 4; ++d0) scr4[d0 * 4 + r4] = (f32x4){o[d0][4 * r4 + 0] * rl[0], o[d0][4 * r4 + 1] * rl[1], o[d0][4 * r4 + 2] * rl[2], o[d0][4 * r4 + 3] * rl[3]}; }
  } else {
    float g[4];
#pragma unroll
    for (int d0 = 0; d0 < 4; ++d0) g[d0] = gsub[d0 * 32 + r32] * one_m_li;
#pragma unroll
    for (int r4 = 0; r4 < 4; ++r4) { const f32x4 lv = *(const f32x4*)(li_l + 8 * r4 + 4 * hi);
      f32x4 av[4];
#pragma unroll
      for (int d0 = 0; d0 < 4; ++d0) av[d0] = scr4[d0 * 4 + r4];
#pragma unroll
      for (int i = 0; i < 4; ++i) { const float rl = __builtin_amdgcn_rcpf(lv[i]) * lam; float dv[4]; float sq = 0.f;
#pragma unroll
        for (int d0 = 0; d0 < 4; ++d0) { dv[d0] = av[d0][i] - rl * o[d0][4 * r4 + i]; sq += dv[d0] * dv[d0]; }
        sq += __shfl_xor(sq, 1); sq += __shfl_xor(sq, 2); sq += __shfl_xor(sq, 4); sq += __shfl_xor(sq, 8); sq += __shfl_xor(sq, 16);
        const float rs = __builtin_amdgcn_rsqf(sq * (1.0f / 128.0f) + EPS);
        unsigned short* orow = (unsigned short*)(ost + (8 * r4 + 4 * hi + i) * OST_PITCH) + r32;
#pragma unroll
        for (int d0 = 0; d0 < 4; ++d0) orow[d0 * 32] = (unsigned short)(cvtpk(dv[d0] * rs * g[d0], 0.f) & 0xffffu); } }
    asm volatile("s_waitcnt lgkmcnt(0)" ::: "memory");
    { const int rr = lane >> 4, c16 = lane & 15; char* gdst = (char*)(mixrow + (size_t)(wid * 32 + rr) * 1024) + c16 * 16;
#pragma unroll
      for (int j = 0; j < 8; ++j) { const u32x4 w = *(const u32x4*)(ost + (4 * j + rr) * OST_PITCH + c16 * 16); *(GAS u32x4*)(gdst + (size_t)j * 8192) = w; } }
  }
#undef SLOAD
#undef SWRITE
#undef SWAIT
#undef RESC
}

__device__ __forceinline__ int rel_bucket(int rel) {
  const int ret = rel > 0 ? 16 : 0; const int n = rel < 0 ? -rel : rel;
  if (n < 8) return ret + n;
  int large = 2 + (31 - __clz(n * n)); if (large > 15) large = 15;
  return ret + large;
}

__device__ __forceinline__ void attn_phase(const Params& p, int e, char* lds) {
  int tid_ = threadIdx.x; asm volatile("" : "+v"(tid_));
  const int tid = tid_, wid = tid >> 6, lane = tid & 63, r32 = lane & 31, hi = lane >> 5;
  const bf16* big = (const bf16*)(p.ws + WS_BIG); bf16* mix = (bf16*)(p.ws + WS_MIX);
  float* scr = (float*)(p.ws + WS_ASCR) + (size_t)blockIdx.x * 32768;
  float* tb2 = (float*)(lds + OFF_TB);
  float lam, one_m_li;
  { const float a = p.lq1[e * 64 + lane] * p.lk1[e * 64 + lane], b = p.lq2[e * 64 + lane] * p.lk2[e * 64 + lane];
    const float s1 = wave_sum(a), s2 = wave_sum(b); const float li = 0.8f - 0.6f * __expf(-0.3f * (float)(2 * e));
    lam = __uint_as_float(__builtin_amdgcn_readfirstlane(__float_as_uint(__expf(s1) - __expf(s2) + li))); one_m_li = 1.0f - li; }
  int cur_h = -1;
  const bool xmap = (gridDim.x == 256);
  const int nrounds = xmap ? 4 : (BATCH * 4 * 16 + (int)gridDim.x - 1) / (int)gridDim.x;
  for (int k = 0; k < nrounds; ++k) {
    const int u = xmap ? ((((k * 16) + ((int)(blockIdx.x & 7) * 2) + (int)(blockIdx.x >> 7)) << 4) | (int)((blockIdx.x >> 3) & 15)) : ((int)blockIdx.x + k * (int)gridDim.x);
    if (u >= BATCH * 4 * 16) break;
    const int qb = u & 15, h = (u >> 4) & 3, b = u >> 6;
    if (h != cur_h) { __syncthreads(); for (int d = tid; d < 385; d += 512) tb2[d] = p.rel_bias[rel_bucket(d - 192) * 4 + h] * LOG2E; cur_h = h; __syncthreads(); }
    const long row0 = (long)b * SEQ + qb * 256;
    if (__builtin_amdgcn_readfirstlane(wid) & 1) {
      attn_pass<true>(0, scr, mix + (size_t)row0 * 1024 + h * 128, lam, p.da_subln + e * 128, one_m_li,
                big + row0 * LDK + h * 128, big + (long)b * SEQ * LDK + 512 + h * 128, big + (long)b * SEQ * LDK + 1024 + h * 128, qb * 256, lds, tb2);
      attn_pass<true>(1, scr, mix + (size_t)row0 * 1024 + h * 128, lam, p.da_subln + e * 128, one_m_li,
                big + row0 * LDK + h * 128 + 64, big + (long)b * SEQ * LDK + 512 + h * 128 + 64, big + (long)b * SEQ * LDK + 1024 + h * 128, qb * 256, lds, tb2);
    } else {
      attn_pass<false>(0, scr, mix + (size_t)row0 * 1024 + h * 128, lam, p.da_subln + e * 128, one_m_li,
                big + row0 * LDK + h * 128, big + (long)b * SEQ * LDK + 512 + h * 128, big + (long)b * SEQ * LDK + 1024 + h * 128, qb * 256, lds, tb2);
      attn_pass<false>(1, scr, mix + (size_t)row0 * 1024 + h * 128, lam, p.da_subln + e * 128, one_m_li,
                big + row0 * LDK + h * 128 + 64, big + (long)b * SEQ * LDK + 512 + h * 128 + 64, big + (long)b * SEQ * LDK + 1024 + h * 128, qb * 256, lds, tb2);
    }
  }
}
}

namespace hg {
constexpr int TB = 32;
constexpr int OFF_F = 0, OFF_Q = 16384, OFF_V = 32768, OFF_OP = 40960, OFF_END = 40960 + 65536;
__device__ __forceinline__ void hgrn_phase(const Params& p, int e, char* lds) {
  int tid_ = threadIdx.x; asm volatile("" : "+v"(tid_));
  const int tid = tid_, wave = tid >> 6, lane = tid & 63;
  const bf16* big = (const bf16*)(p.ws + WS_BIG);
  bf16* ohg = (bf16*)(p.ws + WS_HB);
  float* F = (float*)(lds + OFF_F); float* Q = (float*)(lds + OFF_Q); float* Vv = (float*)(lds + OFF_V); float* OP = (float*)(lds + OFF_OP);
  const int lt = tid >> 4, lk8 = (tid & 15) * 8;
  const int vt = (tid & 255) >> 3, vv8 = (tid & 7) * 8;
  const int vg = lane & 15, kg = wave * 4 + (lane >> 4), k0 = kg * 4, v0 = vg * 4;
  const int st = tid >> 4, sv4 = (tid & 15) * 4;
  for (int u = blockIdx.x; u < 256; u += gridDim.x) {
    const int vh = u & 1, dir = (u >> 1) & 1, h = (u >> 2) & 3, b = u >> 4;
    const float* lbsrc = dir ? p.lb_bwd : p.lb_fwd;
    float lb[8];
#pragma unroll
    for (int i = 0; i < 8; ++i) { if (e == 0) lb[i] = 0.f; else { const float a0 = lbsrc[h * 128 + lk8 + i], a1 = lbsrc[512 + h * 128 + lk8 + i]; lb[i] = 1.0f / (1.0f + __expf(a0 - a1)); } }
    const bf16* qbase = big + (size_t)b * SEQ * 4096 + 1536 + h * 128 + lk8;
    const bf16* zbase = big + (size_t)b * SEQ * 4096 + (dir ? 2560 : 2048) + h * 128 + lk8;
    const bf16* vbase = big + (size_t)b * SEQ * 4096 + 3072 + h * 128 + vh * 64 + vv8;
    bf16* obase = ohg + (size_t)dir * T * 512 + (size_t)b * SEQ * 512 + h * 128 + vh * 64 + sv4;
    f32x2 S[4][2];
#pragma unroll
    for (int i = 0; i < 4; ++i) { S[i][0] = (f32x2){0.f, 0.f}; S[i][1] = (f32x2){0.f, 0.f}; }
    u32x4 rq, rz, rv;
    { const int pos = dir ? (SEQ - 1 - lt) : lt; rq = *(const u32x4*)(qbase + (size_t)pos * 4096); rz = *(const u32x4*)(zbase + (size_t)pos * 4096);
      const int pv = dir ? (SEQ - 1 - vt) : vt; rv = (tid < 256) ? *(const u32x4*)(vbase + (size_t)pv * 4096) : (u32x4){0, 0, 0, 0}; }
    for (int blk = 0; blk < SEQ / TB; ++blk) {
      { float zf[8], qf[8];
        zf[0] = bflo(rz.x); zf[1] = bfhi(rz.x); zf[2] = bflo(rz.y); zf[3] = bfhi(rz.y); zf[4] = bflo(rz.z); zf[5] = bfhi(rz.z); zf[6] = bflo(rz.w); zf[7] = bfhi(rz.w);
        qf[0] = bflo(rq.x); qf[1] = bfhi(rq.x); qf[2] = bflo(rq.y); qf[3] = bfhi(rq.y); qf[4] = bflo(rq.z); qf[5] = bfhi(rq.z); qf[6] = bflo(rq.w); qf[7] = bfhi(rq.w);
        float ff[8];
#pragma unroll
        for (int i = 0; i < 8; ++i) { const float sg = __builtin_amdgcn_rcpf(1.0f + __builtin_amdgcn_exp2f(-1.4426950408889634f * zf[i])); ff[i] = lb[i] + (1.0f - lb[i]) * sg; }
        *(f32x4*)(F + lt * 128 + lk8) = (f32x4){ff[0], ff[1], ff[2], ff[3]}; *(f32x4*)(F + lt * 128 + lk8 + 4) = (f32x4){ff[4], ff[5], ff[6], ff[7]};
        *(f32x4*)(Q + lt * 128 + lk8) = (f32x4){qf[0], qf[1], qf[2], qf[3]}; *(f32x4*)(Q + lt * 128 + lk8 + 4) = (f32x4){qf[4], qf[5], qf[6], qf[7]};
        if (tid < 256) { *(f32x4*)(Vv + vt * 64 + vv8) = (f32x4){bflo(rv.x), bfhi(rv.x), bflo(rv.y), bfhi(rv.y)}; *(f32x4*)(Vv + vt * 64 + vv8 + 4) = (f32x4){bflo(rv.z), bfhi(rv.z), bflo(rv.w), bfhi(rv.w)}; } }
      __syncthreads();
      if (blk + 1 < SEQ / TB) { const int t1 = (blk + 1) * TB;
        const int pos = dir ? (SEQ - 1 - (t1 + lt)) : (t1 + lt); rq = *(const u32x4*)(qbase + (size_t)pos * 4096); rz = *(const u32x4*)(zbase + (size_t)pos * 4096);
        const int pv = dir ? (SEQ - 1 - (t1 + vt)) : (t1 + vt); if (tid < 256) rv = *(const u32x4*)(vbase + (size_t)pv * 4096); }
#pragma unroll 4
      for (int t = 0; t < TB; ++t) {
        const f32x4 f4 = *(const f32x4*)(F + t * 128 + k0), q4 = *(const f32x4*)(Q + t * 128 + k0), v4 = *(const f32x4*)(Vv + t * 64 + v0);
        const f32x2 va = (f32x2){v4[0], v4[1]}, vb = (f32x2){v4[2], v4[3]};
        f32x2 oa = (f32x2){0.f, 0.f}, ob = (f32x2){0.f, 0.f};
#pragma unroll
        for (int i = 0; i < 4; ++i) { const f32x2 fi = (f32x2){f4[i], f4[i]}, qi = (f32x2){q4[i], q4[i]};
          S[i][0] = fi * (S[i][0] - va) + va; S[i][1] = fi * (S[i][1] - vb) + vb;
          oa += S[i][0] * qi; ob += S[i][1] * qi; }
        float o0 = oa.x, o1 = oa.y, o2 = ob.x, o3 = ob.y;
        o0 += __shfl_xor(o0, 16); o1 += __shfl_xor(o1, 16); o2 += __shfl_xor(o2, 16); o3 += __shfl_xor(o3, 16);
        o0 += __shfl_xor(o0, 32); o1 += __shfl_xor(o1, 32); o2 += __shfl_xor(o2, 32); o3 += __shfl_xor(o3, 32);
        if (lane < 16) *(f32x4*)(OP + (wave * TB + t) * 64 + v0) = (f32x4){o0, o1, o2, o3};
      }
      __syncthreads();
      { f32x4 s = *(const f32x4*)(OP + (0 * TB + st) * 64 + sv4);
#pragma unroll
        for (int w = 1; w < 8; ++w) s += *(const f32x4*)(OP + (w * TB + st) * 64 + sv4);
        const int tt = blk * TB + st; const int pos = dir ? (SEQ - 1 - tt) : tt;
        u32x2 o; o.x = cvtpk(s[0], s[1]); o.y = cvtpk(s[2], s[3]); *(u32x2*)(obase + (size_t)pos * 512) = o; }
    }
    __syncthreads();
  }
}
__device__ __forceinline__ void hgpost_phase(const Params& p, int e) {
  int tid_ = threadIdx.x; asm volatile("" : "+v"(tid_));
  const int tid = tid_, lane = tid & 63, wave = tid >> 6;
  const int gw = blockIdx.x * 8 + wave, NGW = gridDim.x * 8;
  const bf16* big = (const bf16*)(p.ws + WS_BIG); const bf16* ohg = (const bf16*)p.out; bf16* mix = (bf16*)(p.ws + WS_MIX);
  float gn[8];
#pragma unroll
  for (int i = 0; i < 8; ++i) gn[i] = p.hg_norm[e * 128 + (lane & 15) * 8 + i];
  for (int m0 = gw; m0 < T; m0 += 4 * NGW) {
    u32x4 av[4], bv[4], gv[4];
#pragma unroll
    for (int q = 0; q < 4; ++q) { const int m = m0 + q * NGW; const int mc = m < T ? m : m0;
      av[q] = *(const u32x4*)(ohg + (size_t)mc * 512 + lane * 8); bv[q] = *(const u32x4*)(ohg + (size_t)T * 512 + (size_t)mc * 512 + lane * 8); gv[q] = *(const u32x4*)(big + (size_t)mc * 4096 + 3584 + lane * 8); }
#pragma unroll
    for (int q = 0; q < 4; ++q) { const int m = m0 + q * NGW; const u32x4 a = av[q], b = bv[q], g = gv[q];
      float s[8];
      s[0] = bflo(a.x) + bflo(b.x); s[1] = bfhi(a.x) + bfhi(b.x); s[2] = bflo(a.y) + bflo(b.y); s[3] = bfhi(a.y) + bfhi(b.y);
      s[4] = bflo(a.z) + bflo(b.z); s[5] = bfhi(a.z) + bfhi(b.z); s[6] = bflo(a.w) + bflo(b.w); s[7] = bfhi(a.w) + bfhi(b.w);
      float sq = 0.f;
#pragma unroll
      for (int i = 0; i < 8; ++i) sq += s[i] * s[i];
      sq += __shfl_xor(sq, 1); sq += __shfl_xor(sq, 2); sq += __shfl_xor(sq, 4); sq += __shfl_xor(sq, 8);
      const float rs = __builtin_amdgcn_rsqf(sq * (1.0f / 128.0f) + EPS);
      float gg[8]; gg[0] = bflo(g.x); gg[1] = bfhi(g.x); gg[2] = bflo(g.y); gg[3] = bfhi(g.y); gg[4] = bflo(g.z); gg[5] = bfhi(g.z); gg[6] = bflo(g.w); gg[7] = bfhi(g.w);
      float o[8];
#pragma unroll
      for (int i = 0; i < 8; ++i) o[i] = s[i] * rs * gn[i] * gg[i];
      u32x4 w; w.x = cvtpk(o[0], o[1]); w.y = cvtpk(o[2], o[3]); w.z = cvtpk(o[4], o[5]); w.w = cvtpk(o[6], o[7]);
      if (m < T) *(u32x4*)(mix + (size_t)m * 1024 + 512 + lane * 8) = w; }
  }
}
}


namespace hg2 {
constexpr int PQ = 272, PJ = 144;
constexpr int OFF_QD = 0, OFF_QA = 17408, OFF_KB = 34816, OFF_KS = 52224, OFF_VT = 70656, OFF_P = 79872, OFF_ST = 89088, OFF_TOT = 123904, OFF_D = 125952, OFF_END = 126464;
constexpr float L2E = 1.4426950408889634f;
__device__ __forceinline__ bf16x8 ldfrag(const char* base, int row, int pitch, int koff) { return *(const bf16x8*)(base + row * pitch + koff * 2); }
__device__ __forceinline__ void hgrn_phase(const Params& p, int e, char* lds) {
  int tid_ = threadIdx.x; asm volatile("" : "+v"(tid_));
  const int tid = tid_, wave = tid >> 6, lane = tid & 63, fr = lane & 15, fq_ = lane >> 4;
  const char* bigc = (const char*)(p.ws + WS_BIG);
  char* ohgc = (char*)p.out;
  char* QD = lds + OFF_QD; char* QA = lds + OFF_QA; char* KB = lds + OFF_KB; char* KS = lds + OFF_KS; char* VT = lds + OFF_VT; char* PP = lds + OFF_P; char* ST = lds + OFF_ST;
  char* RQ = QD; char* RZ = QA; char* RV = KB;
  float* TOT = (float*)(lds + OFF_TOT); float* DD = (float*)(lds + OFF_D);
  const int k = tid & 127, rq = tid >> 7;
  const int vv = tid & 63, jg = tid >> 6;
  const int lr0 = tid >> 4, lc8 = (tid & 15) * 8;
  const int vr = tid >> 3, vc8 = (tid & 7) * 8;
  for (int u = blockIdx.x; u < 256; u += gridDim.x) {
    const int vh = u & 1, dir = (u >> 1) & 1, h = (u >> 2) & 3, b = u >> 4;
    float lbk = 0.f;
    if (e != 0) { const float* lbsrc = dir ? p.lb_bwd : p.lb_fwd; const float a0 = lbsrc[h * 128 + k], a1 = lbsrc[512 + h * 128 + k]; lbk = 1.0f / (1.0f + __expf(a0 - a1)); }
    const int rsb = dir ? -8192 : 8192;
    const int base0 = (b * SEQ + (dir ? (SEQ - 1) : 0)) * 8192;
    const int qcol = (1536 + h * 128 + lc8) * 2, zcol = ((dir ? 2560 : 2048) + h * 128 + lc8) * 2, vcol = (3072 + h * 128 + vh * 64 + vc8) * 2;
    const int osb = dir ? -1024 : 1024;
    const int obase = dir * (T * 1024) + (b * SEQ + (dir ? (SEQ - 1) : 0)) * 1024 + (h * 128 + vh * 64) * 2;
    f32x4 Sacc[4];
#pragma unroll
    for (int i = 0; i < 4; ++i) Sacc[i] = (f32x4){0.f, 0.f, 0.f, 0.f};
    for (int i = tid; i < 64 * PQ / 16; i += 512) *(u32x4*)(ST + i * 16) = (u32x4){0, 0, 0, 0};
    u32x4 gq0, gq1, gz0, gz1, gv;
    { const int o0 = base0 + rsb * lr0, o1 = base0 + rsb * (lr0 + 32);
      gq0 = *(const GAS u32x4*)(bigc + (size_t)(unsigned)(o0 + qcol)); gq1 = *(const GAS u32x4*)(bigc + (size_t)(unsigned)(o1 + qcol));
      gz0 = *(const GAS u32x4*)(bigc + (size_t)(unsigned)(o0 + zcol)); gz1 = *(const GAS u32x4*)(bigc + (size_t)(unsigned)(o1 + zcol));
      gv = *(const GAS u32x4*)(bigc + (size_t)(unsigned)(base0 + rsb * vr + vcol)); }
    for (int c = 0; c < SEQ / 64; ++c) {
      const int pb = c & 1;
      *(u32x4*)(RQ + lr0 * PQ + lc8 * 2) = gq0; *(u32x4*)(RQ + (lr0 + 32) * PQ + lc8 * 2) = gq1;
      *(u32x4*)(RZ + lr0 * PQ + lc8 * 2) = gz0; *(u32x4*)(RZ + (lr0 + 32) * PQ + lc8 * 2) = gz1;
      *(u32x4*)(RV + vr * PJ + vc8 * 2) = gv;
      __syncthreads();
      float qf[16], kk[16], cl[16]; float run = 0.f;
#pragma unroll
      for (int i = 0; i < 16; ++i) { const int t = 16 * rq + i; const float z = bf2f(*(const unsigned short*)(RZ + t * PQ + k * 2)); qf[i] = bf2f(*(const unsigned short*)(RQ + t * PQ + k * 2));
        const float sg = __builtin_amdgcn_rcpf(1.0f + __builtin_amdgcn_exp2f(-L2E * z)); const float f = lbk + (1.0f - lbk) * sg;
        run += __builtin_amdgcn_logf(f); cl[i] = run; kk[i] = 1.0f - f; }
      TOT[rq * 128 + k] = run;
      unsigned short rvv[8];
#pragma unroll
      for (int i = 0; i < 8; ++i) rvv[i] = *(const unsigned short*)(RV + (8 * jg + i) * PJ + vv * 2);
      u32x4 vpk; vpk.x = rvv[0] | ((unsigned)rvv[1] << 16); vpk.y = rvv[2] | ((unsigned)rvv[3] << 16); vpk.z = rvv[4] | ((unsigned)rvv[5] << 16); vpk.w = rvv[6] | ((unsigned)rvv[7] << 16);
      __syncthreads();
      { const float t0 = TOT[k], t1 = TOT[128 + k], t2 = TOT[256 + k], t3 = TOT[384 + k];
        const float mid = t0 + t1, last = (t0 + t1) + (t2 + t3);
        const float off = (rq == 0) ? 0.f : (rq == 1) ? t0 : (rq == 2) ? (t0 + t1) : (t0 + t1 + t2);
        const float el = __builtin_amdgcn_exp2f(last), em = __builtin_amdgcn_exp2f(fminf(-mid, 120.f)), emi = __builtin_amdgcn_exp2f(mid);
        if (rq == 0) DD[k] = el;
        unsigned ksw[8];
#pragma unroll
        for (int i = 0; i < 16; ++i) { const float cc = off + cl[i];
          const float e1 = __builtin_amdgcn_exp2f(cc), inv1 = __builtin_amdgcn_exp2f(fminf(-cc, 120.f));
          const float ea = fminf(e1 * em, 3.6e16f);
          const float eb = fminf(inv1 * emi, 3.6e16f);
          const float es = fminf(inv1 * el, 1.0f);
          const int t = 16 * rq + i;
          const unsigned w0 = cvtpk(qf[i] * e1, qf[i] * ea), w1 = cvtpk(kk[i] * eb, kk[i] * es);
          *(unsigned short*)(QD + t * PQ + k * 2) = (unsigned short)(w0 & 0xffffu);
          *(unsigned short*)(QA + t * PQ + k * 2) = (unsigned short)(w0 >> 16);
          *(unsigned short*)(KB + t * PQ + k * 2) = (unsigned short)(w1 & 0xffffu);
          if (i & 1) ksw[i >> 1] |= (w1 & 0xffff0000u); else ksw[i >> 1] = (w1 >> 16); }
        *(u32x4*)(KS + k * PJ + rq * 32) = (u32x4){ksw[0], ksw[1], ksw[2], ksw[3]};
        *(u32x4*)(KS + k * PJ + rq * 32 + 16) = (u32x4){ksw[4], ksw[5], ksw[6], ksw[7]};
        *(u32x4*)(VT + vv * PJ + jg * 16) = vpk; }
      __syncthreads();
      if (c + 1 < SEQ / 64) { const int bc = base0 + rsb * 64 * (c + 1); const int o0 = bc + rsb * lr0, o1 = bc + rsb * (lr0 + 32);
        gq0 = *(const GAS u32x4*)(bigc + (size_t)(unsigned)(o0 + qcol)); gq1 = *(const GAS u32x4*)(bigc + (size_t)(unsigned)(o1 + qcol));
        gz0 = *(const GAS u32x4*)(bigc + (size_t)(unsigned)(o0 + zcol)); gz1 = *(const GAS u32x4*)(bigc + (size_t)(unsigned)(o1 + zcol));
        gv = *(const GAS u32x4*)(bigc + (size_t)(unsigned)(bc + rsb * vr + vcol)); }
#define HWAIT() do { asm volatile("s_waitcnt lgkmcnt(0)" ::: "memory"); __builtin_amdgcn_sched_barrier(0); } while (0)
      f32x4 oacc[2];
      { const int jt = wave >> 1, ttA = 2 * (wave & 1), ttO = wave >> 1, vtO = 2 * (wave & 1); const char* STp = ST + pb * (64 * PQ);
        bf16x8 fa[4], fb0[4], fb1[4], fq[4], fs0[4], fs1[4];
#pragma unroll
        for (int ks = 0; ks < 4; ++ks) { fa[ks] = ldfrag(KB, 16 * jt + fr, PQ, ks * 32 + fq_ * 8); fb0[ks] = ldfrag(QA, 16 * ttA + fr, PQ, ks * 32 + fq_ * 8); fb1[ks] = ldfrag(QA, 16 * (ttA + 1) + fr, PQ, ks * 32 + fq_ * 8);
          fq[ks] = ldfrag(QD, 16 * ttO + fr, PQ, ks * 32 + fq_ * 8); fs0[ks] = ldfrag(STp, 16 * vtO + fr, PQ, ks * 32 + fq_ * 8); fs1[ks] = ldfrag(STp, 16 * (vtO + 1) + fr, PQ, ks * 32 + fq_ * 8); }
        HWAIT();
        f32x4 acc0 = (f32x4){0.f, 0.f, 0.f, 0.f}, acc1 = acc0; oacc[0] = acc0; oacc[1] = acc0;
#pragma unroll
        for (int ks = 0; ks < 4; ++ks) {
          if (jt <= ttA) acc0 = __builtin_amdgcn_mfma_f32_16x16x32_bf16(fa[ks], fb0[ks], acc0, 0, 0, 0);
          if (jt <= ttA + 1) acc1 = __builtin_amdgcn_mfma_f32_16x16x32_bf16(fa[ks], fb1[ks], acc1, 0, 0, 0);
          oacc[0] = __builtin_amdgcn_mfma_f32_16x16x32_bf16(fq[ks], fs0[ks], oacc[0], 0, 0, 0);
          oacc[1] = __builtin_amdgcn_mfma_f32_16x16x32_bf16(fq[ks], fs1[ks], oacc[1], 0, 0, 0); }
        { const int j0 = 16 * jt + 4 * fq_;
          { const int tcol = 16 * ttA + fr; u32x2 w; w.x = cvtpk_c(j0 + 0 <= tcol ? acc0[0] : 0.f, j0 + 1 <= tcol ? acc0[1] : 0.f); w.y = cvtpk_c(j0 + 2 <= tcol ? acc0[2] : 0.f, j0 + 3 <= tcol ? acc0[3] : 0.f);
            *(u32x2*)(PP + tcol * PJ + j0 * 2) = w; }
          { const int tcol = 16 * (ttA + 1) + fr; u32x2 w; w.x = cvtpk_c(j0 + 0 <= tcol ? acc1[0] : 0.f, j0 + 1 <= tcol ? acc1[1] : 0.f); w.y = cvtpk_c(j0 + 2 <= tcol ? acc1[2] : 0.f, j0 + 3 <= tcol ? acc1[3] : 0.f);
            *(u32x2*)(PP + tcol * PJ + j0 * 2) = w; } } }
      { const f32x4 d4 = *(const f32x4*)(DD + 16 * wave + 4 * fq_); char* STn = ST + (pb ^ 1) * (64 * PQ);
        const bf16x8 a0 = ldfrag(KS, 16 * wave + fr, PJ, fq_ * 8), a1 = ldfrag(KS, 16 * wave + fr, PJ, 32 + fq_ * 8);
        bf16x8 v0[4], v1[4];
#pragma unroll
        for (int vt = 0; vt < 4; ++vt) { v0[vt] = ldfrag(VT, 16 * vt + fr, PJ, fq_ * 8); v1[vt] = ldfrag(VT, 16 * vt + fr, PJ, 32 + fq_ * 8); }
        HWAIT();
#pragma unroll
        for (int vt = 0; vt < 4; ++vt) { Sacc[vt] = Sacc[vt] * d4;
          Sacc[vt] = __builtin_amdgcn_mfma_f32_16x16x32_bf16(a0, v0[vt], Sacc[vt], 0, 0, 0);
          Sacc[vt] = __builtin_amdgcn_mfma_f32_16x16x32_bf16(a1, v1[vt], Sacc[vt], 0, 0, 0); }
#pragma unroll
        for (int vt = 0; vt < 4; ++vt) { u32x2 w; w.x = cvtpk_c(Sacc[vt][0], Sacc[vt][1]); w.y = cvtpk_c(Sacc[vt][2], Sacc[vt][3]);
          *(u32x2*)(STn + (16 * vt + fr) * PQ + (16 * wave + 4 * fq_) * 2) = w; } }
      __syncthreads();
      { const int tt = wave >> 1, vt0 = 2 * (wave & 1);
        bf16x8 pf[2], vf0[2], vf1[2];
#pragma unroll
        for (int ks = 0; ks < 2; ++ks) { pf[ks] = ldfrag(PP, 16 * tt + fr, PJ, ks * 32 + fq_ * 8); vf0[ks] = ldfrag(VT, 16 * vt0 + fr, PJ, ks * 32 + fq_ * 8); vf1[ks] = ldfrag(VT, 16 * (vt0 + 1) + fr, PJ, ks * 32 + fq_ * 8); }
        HWAIT();
#pragma unroll
        for (int ks = 0; ks < 2; ++ks) { oacc[0] = __builtin_amdgcn_mfma_f32_16x16x32_bf16(pf[ks], vf0[ks], oacc[0], 0, 0, 0); oacc[1] = __builtin_amdgcn_mfma_f32_16x16x32_bf16(pf[ks], vf1[ks], oacc[1], 0, 0, 0); }
#pragma unroll
        for (int n = 0; n < 2; ++n) { const int oo = obase + osb * (64 * c + 16 * tt + 4 * fq_) + (16 * (vt0 + n) + fr) * 2;
#pragma unroll
          for (int i = 0; i < 4; ++i) *(GAS unsigned short*)(ohgc + (size_t)(unsigned)(oo + osb * i)) = (unsigned short)(cvtpk_c(oacc[n][i], 0.f) & 0xffffu); } }
#undef HWAIT
    }
    __syncthreads();
  }
}
}

namespace sgu {
constexpr int VT_PITCH = 272;
constexpr int OFF_VT = 0, OFF_RS = 128 * VT_PITCH, OFF_END = OFF_RS + 512;
__device__ __forceinline__ void sgu_phase(const Params& p, int o, char* lds) {
  int tid_ = threadIdx.x; asm volatile("" : "+v"(tid_));
  const int tid = tid_, wave = tid >> 6, lane = tid & 63, fr = lane & 15, quad = lane >> 4;
  const int wr = wave >> 1, wc = wave & 1;
  const bf16* big = (const bf16*)(p.ws + WS_BIG); bf16* mix = (bf16*)(p.ws + WS_MIX);
  const bf16* Wb = (const bf16*)(p.ws + WS_W) + W_SGW + (size_t)o * 8 * 128 * 128;
  const unsigned long long* vss = (const unsigned long long*)(p.ws + WS_SS) + (size_t)(9 + o) * T;
  float* rs = (float*)(lds + OFF_RS);
  const int NU = 512 * 8, G = gridDim.x;
  const bool gfix = (G & 7) == 0;
  u32x4 wraw[4][2]; f32x4 gainv[4]; float biasv[2]; int gcur = -1;
  const int sq0 = tid >> 4, sc8 = (tid & 15) * 8;
  u32x4 vst[4];
  int u = blockIdx.x;
  if (u < NU) { const int g = u & 7; const size_t T0 = (size_t)(u >> 3) * 128;
#pragma unroll
    for (int i = 0; i < 4; ++i) vst[i] = *(const GAS u32x4*)(big + (T0 + sq0 + 32 * i) * 2048 + 1024 + g * 128 + sc8); }
  for (; u < NU; u += G) {
    const int g = u & 7, n = u >> 3; const size_t T0 = (size_t)n * 128;
    if (g != gcur) { gcur = g;
#pragma unroll
      for (int kq = 0; kq < 4; ++kq)
#pragma unroll
        for (int nt = 0; nt < 2; ++nt) wraw[kq][nt] = *(const GAS u32x4*)(Wb + ((size_t)g * 128 + wr * 32 + nt * 16 + fr) * 128 + kq * 32 + quad * 8);
#pragma unroll
      for (int mt = 0; mt < 4; ++mt) gainv[mt] = *(const f32x4*)(p.sg_norm + o * 1024 + g * 128 + wc * 64 + mt * 16 + 4 * quad);
#pragma unroll
      for (int nt = 0; nt < 2; ++nt) biasv[nt] = p.sg_b[(o * 8 + g) * 128 + wr * 32 + nt * 16 + fr]; }
    u32x2 uw[2][4];
#pragma unroll
    for (int nt = 0; nt < 2; ++nt)
#pragma unroll
      for (int mt = 0; mt < 4; ++mt) uw[nt][mt] = *(const GAS u32x2*)(big + (T0 + wr * 32 + nt * 16 + fr) * 2048 + g * 128 + wc * 64 + mt * 16 + 4 * quad);
    __syncthreads();
#pragma unroll
    for (int i = 0; i < 4; ++i) { const int q = sq0 + 32 * i; const u32x4 w = vst[i];
      unsigned short* d = (unsigned short*)(lds + OFF_VT + (sc8) * VT_PITCH + q * 2);
      d[0 * (VT_PITCH / 2)] = (unsigned short)(w.x & 0xffffu); d[1 * (VT_PITCH / 2)] = (unsigned short)(w.x >> 16);
      d[2 * (VT_PITCH / 2)] = (unsigned short)(w.y & 0xffffu); d[3 * (VT_PITCH / 2)] = (unsigned short)(w.y >> 16);
      d[4 * (VT_PITCH / 2)] = (unsigned short)(w.z & 0xffffu); d[5 * (VT_PITCH / 2)] = (unsigned short)(w.z >> 16);
      d[6 * (VT_PITCH / 2)] = (unsigned short)(w.w & 0xffffu); d[7 * (VT_PITCH / 2)] = (unsigned short)(w.w >> 16); }
    if (tid < 128) rs[tid] = __builtin_amdgcn_rsqf(pg8::ss2f(vss[T0 + tid]) * (1.0f / 1024.0f) + EPS);
    __syncthreads();
    if (u + G < NU) { const int g2 = (u + G) & 7; const size_t T2 = (size_t)((u + G) >> 3) * 128;
#pragma unroll
      for (int i = 0; i < 4; ++i) vst[i] = *(const GAS u32x4*)(big + (T2 + sq0 + 32 * i) * 2048 + 1024 + g2 * 128 + sc8); }
    f32x4 acc[4][2];
#pragma unroll
    for (int mt = 0; mt < 4; ++mt)
#pragma unroll
      for (int nt = 0; nt < 2; ++nt) acc[mt][nt] = (f32x4){0.f, 0.f, 0.f, 0.f};
#pragma unroll
    for (int kq = 0; kq < 4; ++kq) {
      const f32x4 r0 = *(const f32x4*)(rs + kq * 32 + quad * 8), r1 = *(const f32x4*)(rs + kq * 32 + quad * 8 + 4);
      bf16x8 wf[2];
#pragma unroll
      for (int nt = 0; nt < 2; ++nt) { const u32x4 w = wraw[kq][nt];
        u32x4 s; s.x = cvtpk(bflo(w.x) * r0[0], bfhi(w.x) * r0[1]); s.y = cvtpk(bflo(w.y) * r0[2], bfhi(w.y) * r0[3]); s.z = cvtpk(bflo(w.z) * r1[0], bfhi(w.z) * r1[1]); s.w = cvtpk(bflo(w.w) * r1[2], bfhi(w.w) * r1[3]);
        wf[nt] = __builtin_bit_cast(bf16x8, s); }
#pragma unroll
      for (int mt = 0; mt < 4; ++mt) { const bf16x8 vf = *(const bf16x8*)(lds + OFF_VT + (wc * 64 + mt * 16 + fr) * VT_PITCH + (kq * 32 + quad * 8) * 2);
#pragma unroll
        for (int nt = 0; nt < 2; ++nt) acc[mt][nt] = __builtin_amdgcn_mfma_f32_16x16x32_bf16(vf, wf[nt], acc[mt][nt], 0, 0, 0); }
    }
#pragma unroll
    for (int nt = 0; nt < 2; ++nt) { const int pp = wr * 32 + nt * 16 + fr;
#pragma unroll
      for (int mt = 0; mt < 4; ++mt) { const int c = g * 128 + wc * 64 + mt * 16 + 4 * quad; const u32x2 uu = uw[nt][mt];
        const f32x4 v = (f32x4){bflo(uu.x), bfhi(uu.x), bflo(uu.y), bfhi(uu.y)} * (gainv[mt] * acc[mt][nt] + biasv[nt]);
        u32x2 ow; ow.x = cvtpk(v[0], v[1]); ow.y = cvtpk(v[2], v[3]);
        *(GAS u32x2*)(mix + (T0 + pp) * 1024 + c) = ow; } }
  }
  (void)gfix;
}
}

#define XB_TMO      128
#define XB_XCNT(j)  (256  + 64 * (j))
#define XB_XSUB(j)  (1280 + 64 * (j))
#define XB_XGEN(j)  (2304 + 64 * (j))
#define XB_TOP      3328
#define XB_TOPGEN   3392
#define XCD_BAR_WORDS 3456
#define XB_SPIN_CAP (1u << 18)

__device__ __forceinline__ unsigned xb_ld(unsigned* p)              { return __hip_atomic_load(p, __ATOMIC_RELAXED, __HIP_MEMORY_SCOPE_AGENT); }
__device__ __forceinline__ unsigned xb_add(unsigned* p, unsigned v) { return __hip_atomic_fetch_add(p, v, __ATOMIC_RELAXED, __HIP_MEMORY_SCOPE_AGENT); }
__device__ __forceinline__ unsigned xb_xcc_id() { return (unsigned)__builtin_amdgcn_s_getreg((3 << 11) | 20) & 0xFu; }
#define XB_SPIN(cond, bar) do { unsigned _sp = 0; while (cond) { __builtin_amdgcn_s_sleep(1); \
    if ((++_sp & 255u) == 0u) { if (xb_ld(&(bar)[XB_TMO])) break; if (_sp > XB_SPIN_CAP) { atomicAdd(&(bar)[XB_TMO], 1u); break; } } } } while (0)

struct XcdBarrier {
    unsigned* bar; unsigned x;
    volatile LAS unsigned* st;
};

__device__ __forceinline__ XcdBarrier xcd_barrier_post(unsigned* bar, volatile LAS unsigned* st) {
    XcdBarrier b; b.bar = bar; b.x = xb_xcc_id(); b.st = st;
    if (threadIdx.x == 0) (void)xb_add(&bar[XB_XCNT(b.x)], 1u);
    return b;
}
__device__ __forceinline__ void xcd_barrier_complete(unsigned* bar, unsigned x, unsigned& nloc, unsigned& nx) {
    const unsigned G = gridDim.x * gridDim.y * gridDim.z;
    unsigned sum, cnt, mine, sp = 0u;
    for (;;) {
        sum = 0u; cnt = 0u; mine = 0u;
#pragma unroll
        for (unsigned j = 0; j < 16; ++j) { const unsigned c = xb_ld(&bar[XB_XCNT(j)]); sum += c; cnt += (c > 0u) ? 1u : 0u; mine = (j == x) ? c : mine; }
        if (sum == G) break;
        __builtin_amdgcn_s_sleep(1);
        if ((++sp & 255u) == 0u) { if (xb_ld(&bar[XB_TMO])) break; if (sp > XB_SPIN_CAP) { atomicAdd(&bar[XB_TMO], 1u); break; } }
    }
    nloc = mine > 0u ? mine : 1u; nx = cnt > 0u ? cnt : 1u;
}

__device__ __forceinline__ void xcd_barrier(const XcdBarrier& b) {
    asm volatile("s_waitcnt vmcnt(0)" ::: "memory");
    __syncthreads();
    if (threadIdx.x == 0) {
        unsigned* bar = b.bar;
        __builtin_amdgcn_s_waitcnt(0);
        unsigned nloc = b.st[0], nx = b.st[1];
        if (nloc == 0u) { xcd_barrier_complete(bar, b.x, nloc, nx); b.st[0] = nloc; b.st[1] = nx; }
        const unsigned old = xb_add(&bar[XB_XSUB(b.x)], 1u);
        const unsigned gen = old / nloc;
        if (old + 1u == (gen + 1u) * nloc) {
            __builtin_amdgcn_fence(__ATOMIC_RELEASE, "agent");
            asm volatile("s_waitcnt vmcnt(0)" ::: "memory");
            const unsigned og = xb_add(&bar[XB_TOP], 1u);
            const unsigned tg = og / nx;
            if (og + 1u == (tg + 1u) * nx) xb_add(&bar[XB_TOPGEN], 1u);
            else XB_SPIN(xb_ld(&bar[XB_TOPGEN]) == tg, bar);
            __builtin_amdgcn_fence(__ATOMIC_ACQUIRE, "agent");
            xb_add(&bar[XB_XGEN(b.x)], 1u);
            asm volatile("s_waitcnt vmcnt(0)" ::: "memory");
        } else {
            XB_SPIN(xb_ld(&bar[XB_XGEN(b.x)]) == gen, bar);
            __builtin_amdgcn_fence(__ATOMIC_ACQUIRE, "agent");
            asm volatile("s_waitcnt vmcnt(0)" ::: "memory");
        }
    }
    __syncthreads();
}

constexpr int NPHASE = 24;
__global__ void __launch_bounds__(512, 2) mega_fwd(Params pin) {
    extern __shared__ __attribute__((aligned(16))) unsigned char lds_raw[];
    PG8_LAS unsigned char* lds = (PG8_LAS unsigned char*)lds_raw;
    const int G = gridDim.x, c = blockIdx.x;
    volatile LAS unsigned* bst = (volatile LAS unsigned*)(lds + (LDS_BYTES - 64));
    if (threadIdx.x < 2) bst[threadIdx.x] = 0u;
    __syncthreads();
    const XcdBarrier xbar = xcd_barrier_post((unsigned*)(pin.ws + WS_BAR), bst);
    for (int ph = pin.ph_lo; ph < pin.ph_hi; ++ph) {
        Params p = pin;
        { unsigned long long w = (unsigned long long)pin.ws, o = (unsigned long long)pin.out; asm volatile("" : "+s"(w), "+s"(o)); p.ws = (unsigned char*)w; p.out = (float*)o; }
        unsigned char* ws = p.ws;
        bf16* WB = (bf16*)(ws + WS_W);
        bf16* hb = (bf16*)(ws + WS_HB); bf16* mix = (bf16*)(ws + WS_MIX); bf16* big = (bf16*)(ws + WS_BIG);
        unsigned long long* SS = (unsigned long long*)(ws + WS_SS);
        if (ph == 0) prologue_phase(p, lds);
        else if (ph == 23) final_phase(p);
        else {
            const int li = (ph - 1) / 11, r = (ph - 1) % 11;
            const int l = (r < 6) ? 2 * li : 2 * li + 1;
            if (r == 0) { pg8::Gemm g{hb, WB + W_INE + (size_t)li * 4096 * 1024, T, 4096, 1024}; pg8::StaticOrder S; S.init(T, 4096, G, c);
                pg8::EpiEvenIn E{big, SS + (size_t)(2 * l) * T}; pg8::gemm_phase<pg8::EpiEvenIn, pg8::StaticOrder, true, true>(lds, g, S, E); }
            else if (r == 1) { hg2::hgrn_phase(p, li, (char*)lds_raw); att::attn_phase(p, li, (char*)lds_raw); }
            else if (r == 2) { hg::hgpost_phase(p, li); }
            else if (r == 3 || r == 8) { const bf16* Wt = (r == 3) ? WB + W_OUTE + (size_t)li * 1024 * 1024 : WB + W_OUTO + (size_t)li * 1024 * 1024;
                pg8::Gemm g{mix, Wt, T, 1024, 1024}; pg8::StaticOrder S; S.init(T, 1024, G, c);
                pg8::EpiRes E{hb, SS + (size_t)(2 * l + 1) * T}; pg8::gemm_phase<pg8::EpiRes, pg8::StaticOrder, true, true>(lds, g, S, E); }
            else if (r == 4 || r == 9) { pg8::Gemm g{hb, WB + W_FIN + (size_t)l * 5632 * 1024, T, 5632, 1024}; pg8::StaticOrder S; S.init(T, 5632, G, c);
                pg8::EpiFfnIn E{big, SS + (size_t)(2 * l + 1) * T}; pg8::gemm_phase<pg8::EpiFfnIn, pg8::StaticOrder, true, true>(lds, g, S, E); }
            else if (r == 5 || r == 10) { pg8::Gemm g{big, WB + W_FOUT + (size_t)l * 1024 * 2816, T, 1024, 2816}; pg8::StaticOrder S; S.init(T, 1024, G, c);
                pg8::EpiRes E{hb, SS + (size_t)(2 * l + 2) * T}; pg8::gemm_phase<pg8::EpiRes, pg8::StaticOrder, true, true>(lds, g, S, E); }
            else if (r == 6) { pg8::Gemm g{hb, WB + W_INO + (size_t)li * 2048 * 1024, T, 2048, 1024}; pg8::StaticOrder S; S.init(T, 2048, G, c);
                pg8::EpiOddIn E{big, SS + (size_t)(2 * l) * T, SS + (size_t)(9 + li) * T}; pg8::gemm_phase<pg8::EpiOddIn, pg8::StaticOrder, true, true>(lds, g, S, E); }
            else if (r == 7) { sgu::sgu_phase(p, li, (char*)lds_raw); }
        }
        if (ph + 1 < pin.ph_hi) { if (ph == 0) cg::this_grid().sync(); else xcd_barrier(xbar); }
    }
}

#ifndef MK_MULTI
#define MK_MULTI 0
#endif
extern "C" void kernel_launch(void* const* d_in, const int* in_sizes, int n_in, void* d_out, int out_size, void* d_ws, size_t ws_size, hipStream_t stream) {
    static int grid = 0;
    if (grid == 0) {
        if (n_in != 22 || in_sizes[0] != T * D_MODEL || out_size != T * D_MODEL || ws_size < WS_END) { fprintf(stderr, "kernel_launch: unexpected shapes / workspace (n_in %d, in0 %d, out %d, ws %zu need %zu)\n", n_in, n_in > 0 ? in_sizes[0] : -1, out_size, ws_size, (size_t)WS_END); grid = -1; return; }
        int dev = 0, cus = 0, per_cu = 0;
        if (hipGetDevice(&dev) != hipSuccess || hipDeviceGetAttribute(&cus, hipDeviceAttributeMultiprocessorCount, dev) != hipSuccess) { grid = -1; return; }
        if (hipFuncSetAttribute((const void*)mega_fwd, hipFuncAttributeMaxDynamicSharedMemorySize, LDS_BYTES) != hipSuccess) { fprintf(stderr, "kernel_launch: hipFuncSetAttribute failed\n"); grid = -1; return; }
        if (hipOccupancyMaxActiveBlocksPerMultiprocessor(&per_cu, (const void*)mega_fwd, 512, LDS_BYTES) != hipSuccess || per_cu < 1) { fprintf(stderr, "kernel_launch: occupancy query says %d\n", per_cu); per_cu = 1; }
        (void)hipGetLastError();
        grid = cus * 1;
    }
    if (grid < 0) return;
    Params p{};
    const float* const* in = (const float* const*)d_in;
    p.x = in[0]; p.rel_bias = in[1]; p.norm_mix = in[2]; p.norm_ffn = in[3]; p.norm_final = in[4]; p.w_in_even = in[5]; p.w_out_even = in[6];
    p.lq1 = in[7]; p.lk1 = in[8]; p.lq2 = in[9]; p.lk2 = in[10]; p.da_subln = in[11]; p.lb_fwd = in[12]; p.lb_bwd = in[13]; p.hg_norm = in[14];
    p.w_in_odd = in[15]; p.sg_norm = in[16]; p.sg_w = in[17]; p.sg_b = in[18]; p.w_out_odd = in[19]; p.w_ffn_in = in[20]; p.w_ffn_out = in[21];
    p.out = (float*)d_out; p.ws = (unsigned char*)d_ws;
#if MK_MULTI
    for (int ph = 0; ph < NPHASE; ++ph) { p.ph_lo = ph; p.ph_hi = ph + 1; hipLaunchKernelGGL(mega_fwd, dim3(grid), dim3(512), LDS_BYTES, stream, p); }
#else
    p.ph_lo = 0; p.ph_hi = NPHASE;
    if (hipMemsetAsync((char*)d_ws + WS_BAR, 0, XCD_BAR_WORDS * 4, stream) != hipSuccess) { fprintf(stderr, "kernel_launch: memset of the barrier words failed\n"); return; }
    void* args[] = {&p};
    hipError_t e = hipLaunchCooperativeKernel((const void*)mega_fwd, dim3(grid), dim3(512), args, LDS_BYTES, stream);
    if (e != hipSuccess) fprintf(stderr, "cooperative launch failed: %s (grid %d)\n", hipGetErrorString(e), grid);
#endif
}
```

```cpp
#include <hip/hip_runtime.h>
#include <hip/hip_cooperative_groups.h>
#include <cstdio>
#include <cstdint>
namespace cg = cooperative_groups;
namespace pg8 {
#define PG8_LAS __attribute__((address_space(3)))
typedef unsigned short bf16_t;
typedef short bf16x8 __attribute__((ext_vector_type(8)));
typedef float f32x4 __attribute__((ext_vector_type(4)));
typedef unsigned u32x4 __attribute__((ext_vector_type(4)));
constexpr int BM = 256, BK = 64, HALF = 128, HTB = HALF * BK * 2  , STAGE_BYTES = 8 * HTB, NXCD = 8, WGM = 8;

__host__ __device__ __forceinline__ int lds_byte(int r, int c) { const int st = (r >> 4) * 2 + (c >> 5), rr = r & 15, cc = c & 31, ob = rr * 64 + cc * 2; return st * 1024 + (ob ^ (((ob >> 9) & 1) << 5)); }
__host__ __device__ __forceinline__ void stage_rc(int b, int& R, int& C) { const int st = b / 1024, sb = b % 1024, swz = sb ^ (((sb >> 9) & 1) << 5); R = (st >> 1) * 16 + swz / 64; C = (st & 1) * 32 + (swz % 64) / 2; }
__host__ __device__ __forceinline__ int perm32(int rho) { const int n = rho >> 4, i = rho & 15; return 8 * (i >> 2) + 4 * n + (i & 3); }

struct Unit { int pm, pn; };
struct Gemm { const bf16_t* A; const bf16_t* Bt; int M, N, K; };

struct StaticOrder {
    int nM, nN, nwg, G, c;
    __host__ __device__ void init(int M, int N, int G_, int c_) { nM = M / BM; nN = N / BM; nwg = nM * nN; G = G_; c = c_; }
    __host__ __device__ bool next(int i, Unit& u) const {
        const long L = (long)i * G + c; if (L >= nwg) return false;
        int wgid = (int)L; { const int q = nwg / NXCD, r = nwg % NXCD, xcd = wgid % NXCD, off = wgid / NXCD; wgid = (xcd < r ? xcd * (q + 1) : r * (q + 1) + (xcd - r) * q) + off; }
        const int nig = WGM * nN, gid = wgid / nig, fm = gid * WGM, gsz = (nM - fm) < WGM ? (nM - fm) : WGM;
        u.pm = fm + ((wgid % nig) % gsz); u.pn = (wgid % nig) / gsz; return true;
    }
    __device__ __forceinline__ void a_ready(const Unit&) const {}
    __device__ __forceinline__ void done(const Unit&) const {}
};

__device__ __forceinline__ unsigned cvt_pk_bf16(float lo, float hi) { unsigned r; asm volatile("v_cvt_pk_bf16_f32 %0, %1, %2" : "=v"(r) : "v"(lo), "v"(hi)); return r; }
typedef float f32x2 __attribute__((ext_vector_type(2)));
__device__ __forceinline__ f32x2 gelu_pk(f32x2 v) {
    const f32x2 av = __builtin_elementwise_abs(v), d = av * 0.2316418882f + 1.0f;
    f32x2 t; t.x = __builtin_amdgcn_rcpf(d.x); t.y = __builtin_amdgcn_rcpf(d.y);
    f32x2 q = t * 0.5307027145f + (-0.7265760135f); q = q * t + 0.7107068705f; q = q * t + (-0.142248368f); q = q * t + 0.127414796f; q = q * t;
    const f32x2 s = (v * v) * (-0.72134752044f);
    f32x2 e; e.x = __builtin_amdgcn_exp2f(s.x); e.y = __builtin_amdgcn_exp2f(s.y);
    const f32x2 m = v * (q * e), r = v - m;
    f32x2 o; o.x = v.x < 0.f ? m.x : r.x; o.y = v.y < 0.f ? m.y : r.y; return o;
}

constexpr float RMS_EPS = 1e-6f;
__device__ __forceinline__ float ss2f(unsigned long long v) { return (float)v * (1.0f / 16777216.0f); }
__device__ __forceinline__ unsigned long long f2ss(float v) { return (unsigned long long)(v * 16777216.0f); }
struct PreSS { unsigned long long v0, v1; };
struct PreNone {};
__device__ __forceinline__ void prefetch_ss(PreSS& p, const unsigned long long* ss, const Unit& u, int wr, int fr, int fq) {
    const int k0 = 2 * fq, k1 = 2 * fq + 1, base = u.pm * BM + wr * 64 + fr;
    p.v0 = *(const __attribute__((address_space(1))) unsigned long long*)(ss + base + (k0 >> 2) * HALF + (k0 & 3) * 16);
    p.v1 = *(const __attribute__((address_space(1))) unsigned long long*)(ss + base + (k1 >> 2) * HALF + (k1 & 3) * 16);
}
__device__ __forceinline__ void rstd8(float (&r)[8], const PreSS& p, int fr) {
    const float a = __builtin_amdgcn_rsqf(ss2f(p.v0) * (1.0f / 1024.0f) + RMS_EPS), b = __builtin_amdgcn_rsqf(ss2f(p.v1) * (1.0f / 1024.0f) + RMS_EPS);
#pragma unroll
    for (int k = 0; k < 8; ++k) r[k] = __shfl((k & 1) ? b : a, fr + 16 * (k >> 1));
}
__device__ __forceinline__ float silu1(float v) { return v * __builtin_amdgcn_rcpf(1.0f + __builtin_amdgcn_exp2f(-1.4426950408889634f * v)); }
__device__ __forceinline__ f32x4 silu4(f32x4 v) { return (f32x4){silu1(v[0]), silu1(v[1]), silu1(v[2]), silu1(v[3])}; }
__device__ __forceinline__ u32x4 pack8(f32x4 v0, f32x4 v1) { u32x4 w; w.x = cvt_pk_bf16(v0[0], v0[1]); w.y = cvt_pk_bf16(v0[2], v0[3]); w.z = cvt_pk_bf16(v1[0], v1[1]); w.w = cvt_pk_bf16(v1[2], v1[3]); return w; }

struct EpiEvenIn {
    static constexpr bool PERM = true, AFTER_DRAIN = false;
    bf16_t* O; const unsigned long long* ss;
    typedef PreSS Pre;
    __device__ __forceinline__ void prefetch(Pre& p, const Unit& u, int wr, int fr, int fq) const { prefetch_ss(p, ss, u, wr, fr, fq); }
    __device__ __forceinline__ void operator()(const f32x4 (&acc)[2][2][4][2], const Unit& u, int wr, int wc, int fr, int fq, const Pre& pre) const {
        const int row0 = u.pm * BM + wr * 64 + fr, col0 = u.pn * BM + wc * 32 + 8 * fq;
        float rs8[8]; rstd8(rs8, pre, fr);
        const bool act = (u.pn == 6) || (u.pn == 7) || (u.pn == 14) || (u.pn == 15);
        const float sc = (u.pn < 2) ? 0.125f : 1.0f;
#pragma unroll
        for (int ai = 0; ai < 2; ++ai)
#pragma unroll
            for (int m = 0; m < 4; ++m) { const int row = row0 + ai * HALF + m * 16; const float r = rs8[ai * 4 + m] * sc;
                bf16_t* rowp = O + (size_t)row * 4096 + col0;
#pragma unroll
                for (int bj = 0; bj < 2; ++bj) { f32x4 v0 = acc[ai][bj][m][0] * r, v1 = acc[ai][bj][m][1] * r;
                    if (act) { v0 = silu4(v0); v1 = silu4(v1); }
                    *(u32x4*)(rowp + bj * HALF) = pack8(v0, v1); } }
    }
};
struct EpiOddIn {
    static constexpr bool PERM = true, AFTER_DRAIN = false;
    bf16_t* O; const unsigned long long* ss; unsigned long long* vss;
    typedef PreSS Pre;
    __device__ __forceinline__ void prefetch(Pre& p, const Unit& u, int wr, int fr, int fq) const { prefetch_ss(p, ss, u, wr, fr, fq); }
    __device__ __forceinline__ void operator()(const f32x4 (&acc)[2][2][4][2], const Unit& u, int wr, int wc, int fr, int fq, const Pre& pre) const {
        const int row0 = u.pm * BM + wr * 64 + fr, col0 = u.pn * BM + wc * 32 + 8 * fq;
        float rs8[8]; rstd8(rs8, pre, fr);
        const bool isv = u.pn >= 4;
#pragma unroll
        for (int ai = 0; ai < 2; ++ai)
#pragma unroll
            for (int m = 0; m < 4; ++m) { const int row = row0 + ai * HALF + m * 16; const float r = rs8[ai * 4 + m];
                bf16_t* rowp = O + (size_t)row * 2048 + col0; float sq = 0.f;
#pragma unroll
                for (int bj = 0; bj < 2; ++bj) { f32x4 v0 = acc[ai][bj][m][0] * r, v1 = acc[ai][bj][m][1] * r;
                    f32x2 a = gelu_pk((f32x2){v0[0], v0[1]}), b = gelu_pk((f32x2){v0[2], v0[3]}), c = gelu_pk((f32x2){v1[0], v1[1]}), d = gelu_pk((f32x2){v1[2], v1[3]});
                    v0 = (f32x4){a.x, a.y, b.x, b.y}; v1 = (f32x4){c.x, c.y, d.x, d.y};
                    sq += (v0[0] * v0[0] + v0[1] * v0[1]) + (v0[2] * v0[2] + v0[3] * v0[3]) + (v1[0] * v1[0] + v1[1] * v1[1]) + (v1[2] * v1[2] + v1[3] * v1[3]);
                    *(u32x4*)(rowp + bj * HALF) = pack8(v0, v1); }
                if (isv) { sq += __shfl_xor(sq, 16); sq += __shfl_xor(sq, 32); if (fq == 0) atomicAdd(vss + row, f2ss(sq)); } }
    }
};
struct EpiFfnIn {
    static constexpr bool PERM = true, AFTER_DRAIN = false;
    bf16_t* O; const unsigned long long* ss;
    typedef PreSS Pre;
    __device__ __forceinline__ void prefetch(Pre& p, const Unit& u, int wr, int fr, int fq) const { prefetch_ss(p, ss, u, wr, fr, fq); }
    __device__ __forceinline__ void operator()(const f32x4 (&acc)[2][2][4][2], const Unit& u, int wr, int wc, int fr, int fq, const Pre& pre) const {
        const int row0 = u.pm * BM + wr * 64 + fr, col0 = u.pn * HALF + wc * 32 + 8 * fq;
        float rs8[8]; rstd8(rs8, pre, fr);
#pragma unroll
        for (int ai = 0; ai < 2; ++ai)
#pragma unroll
            for (int m = 0; m < 4; ++m) { const int row = row0 + ai * HALF + m * 16; const float r = rs8[ai * 4 + m];
                const f32x4 g0 = silu4(acc[ai][0][m][0] * r), g1 = silu4(acc[ai][0][m][1] * r);
                const f32x4 v0 = g0 * (acc[ai][1][m][0] * r), v1 = g1 * (acc[ai][1][m][1] * r);
                *(u32x4*)(O + (size_t)row * 2816 + col0) = pack8(v0, v1); }
    }
};
struct EpiRes {
    static constexpr bool PERM = true, AFTER_DRAIN = false;
    bf16_t* hb; unsigned long long* ssn;
    typedef PreNone Pre;
    __device__ __forceinline__ void prefetch(Pre&, const Unit&, int, int, int) const {}
    __device__ __forceinline__ void operator()(const f32x4 (&acc)[2][2][4][2], const Unit& u, int wr, int wc, int fr, int fq, const Pre&) const {
        const int row0 = u.pm * BM + wr * 64 + fr, col0 = u.pn * BM + wc * 32 + 8 * fq;
        typedef __attribute__((address_space(1))) u32x4 gu32x4;
        u32x4 bwv[2][4][2];
#pragma unroll
        for (int ai = 0; ai < 2; ++ai)
#pragma unroll
            for (int m = 0; m < 4; ++m)
#pragma unroll
                for (int bj = 0; bj < 2; ++bj) bwv[ai][m][bj] = *(const gu32x4*)(hb + (size_t)(row0 + ai * HALF + m * 16) * 1024 + col0 + bj * HALF);
#pragma unroll
        for (int ai = 0; ai < 2; ++ai)
#pragma unroll
            for (int m = 0; m < 4; ++m) { const int row = row0 + ai * HALF + m * 16; const size_t off = (size_t)row * 1024 + col0; float sq = 0.f;
#pragma unroll
                for (int bj = 0; bj < 2; ++bj) { const u32x4 bw = bwv[ai][m][bj];
                    const f32x4 b0 = (f32x4){__uint_as_float(bw.x << 16), __uint_as_float(bw.x & 0xffff0000u), __uint_as_float(bw.y << 16), __uint_as_float(bw.y & 0xffff0000u)};
                    const f32x4 b1 = (f32x4){__uint_as_float(bw.z << 16), __uint_as_float(bw.z & 0xffff0000u), __uint_as_float(bw.w << 16), __uint_as_float(bw.w & 0xffff0000u)};
                    const f32x4 v0 = acc[ai][bj][m][0] + b0, v1 = acc[ai][bj][m][1] + b1;
                    *(gu32x4*)(hb + off + bj * HALF) = pack8(v0, v1);
                    sq += (v0[0] * v0[0] + v0[1] * v0[1]) + (v0[2] * v0[2] + v0[3] * v0[3]) + (v1[0] * v1[0] + v1[1] * v1[1]) + (v1[2] * v1[2] + v1[3] * v1[3]); }
                sq += __shfl_xor(sq, 16); sq += __shfl_xor(sq, 32); if (fq == 0) atomicAdd(ssn + row, f2ss(sq)); }
    }
};
template <class Epi, class Sched, bool ALIGN_EPI = false, bool SP2 = false>
__device__ __forceinline__ void gemm_phase(PG8_LAS unsigned char* lds, const Gemm g, const Sched& S, const Epi& E) {
    int tid_ = threadIdx.x; asm volatile("" : "+v"(tid_));
    const int tid = tid_, wid = __builtin_amdgcn_readfirstlane(tid >> 6), lane = tid & 63, wr = wid >> 2, wc = wid & 3, fr = lane & 15, fq = lane >> 4;
    const int K = g.K, nt = K / BK;
    unsigned voffA[2], voffB[2];
#pragma unroll
    for (int i = 0; i < 2; ++i) { int R, C; stage_rc(tid * 16 + i * 8192, R, C); const int Rb = Epi::PERM ? ((R & ~31) + perm32(R & 31)) : R;
        voffA[i] = (unsigned)(R * K + C) * 2u; voffB[i] = (unsigned)(Rb * K + C) * 2u; }
    const size_t kstep = (size_t)(BK * 2);
    const size_t hstep = (size_t)HALF * K * 2;
    const size_t tstep = 2 * hstep;
    const unsigned ldsw = (unsigned)wid * 1024u;
    const int aoff = lds_byte(wr * 64 + fr, fq * 8), boff = lds_byte(wc * 32 + fr, fq * 8);
#define PG8_SA(b, h) (((b) * 2 + (h)) * HTB)
#define PG8_SB(b, h) ((4 + (b) * 2 + (h)) * HTB)
#define PG8_STAGE(bufoff, gbase, voff) do { _Pragma("unroll") for (int _i = 0; _i < 2; ++_i) \
        __builtin_amdgcn_global_load_lds((const unsigned*)((const char*)(gbase) + (voff)[_i]), (PG8_LAS unsigned*)(lds + (bufoff) + ldsw + _i * 8192), 16, 0, 0); } while (0)
#define PG8_LDA(dst, b, h) do { _Pragma("unroll") for (int m = 0; m < 4; ++m) _Pragma("unroll") for (int k = 0; k < 2; ++k) dst[m][k] = *(const PG8_LAS bf16x8*)(lds + PG8_SA(b, h) + aoff + m * 2048 + k * 1024); } while (0)
#define PG8_LDB(dst, b, h) do { _Pragma("unroll") for (int n = 0; n < 2; ++n) _Pragma("unroll") for (int k = 0; k < 2; ++k) dst[n][k] = *(const PG8_LAS bf16x8*)(lds + PG8_SB(b, h) + boff + n * 2048 + k * 1024); } while (0)
#define PG8_MMA(ai, bj, At, Bt) do { __builtin_amdgcn_s_setprio(1); _Pragma("unroll") for (int m = 0; m < 4; ++m) _Pragma("unroll") for (int n = 0; n < 2; ++n) _Pragma("unroll") for (int k = 0; k < 2; ++k) \
        acc[ai][bj][m][n] = __builtin_amdgcn_mfma_f32_16x16x32_bf16(Bt[n][k], At[m][k], acc[ai][bj][m][n], 0, 0, 0); __builtin_amdgcn_s_setprio(0); } while (0)
#define PG8_WAIT_V(n) asm volatile("s_waitcnt vmcnt(" #n ")" ::: "memory")
#define PG8_WAIT_L(n) asm volatile("s_waitcnt lgkmcnt(" #n ")" ::: "memory")
#define PG8_BAR __builtin_amdgcn_s_barrier()
#define PG8_SCHED __builtin_amdgcn_sched_barrier(0)
    Unit cur, nxt; int ui = 0;
    if (!S.next(0, cur)) return;
    f32x4 acc[2][2][4][2];
#pragma unroll
    for (int a = 0; a < 2; ++a)
#pragma unroll
        for (int b = 0; b < 2; ++b)
#pragma unroll
            for (int m = 0; m < 4; ++m)
#pragma unroll
                for (int n = 0; n < 2; ++n) acc[a][b][m][n] = (f32x4){0.f, 0.f, 0.f, 0.f};
    bf16x8 At[4][2], B0[2][2], B1[2][2];
    const char* cA = (const char*)g.A + (size_t)cur.pm * tstep; const char* cB = (const char*)g.Bt + (size_t)cur.pn * tstep;
    S.a_ready(cur);
    if constexpr (SP2) {
        PG8_STAGE(PG8_SB(0, 0), cB, voffB); PG8_STAGE(PG8_SB(0, 1), cB + hstep, voffB); PG8_STAGE(PG8_SA(0, 0), cA, voffA); PG8_STAGE(PG8_SA(0, 1), cA + hstep, voffA);
        if (wr == 1) PG8_BAR;
        PG8_WAIT_V(2); PG8_BAR;
        PG8_STAGE(PG8_SB(1, 0), cB + kstep, voffB); PG8_STAGE(PG8_SA(1, 0), cA + kstep, voffA); PG8_STAGE(PG8_SB(1, 1), cB + hstep + kstep, voffB);
        PG8_WAIT_V(6); PG8_BAR;
    } else {
        PG8_STAGE(PG8_SB(0, 0), cB, voffB); PG8_STAGE(PG8_SA(0, 0), cA, voffA); PG8_STAGE(PG8_SB(0, 1), cB + hstep, voffB); PG8_STAGE(PG8_SA(0, 1), cA + hstep, voffA);
        if (wr == 1) PG8_BAR;
        PG8_WAIT_V(4); PG8_BAR;
        PG8_STAGE(PG8_SB(1, 0), cB + kstep, voffB); PG8_STAGE(PG8_SA(1, 0), cA + kstep, voffA); PG8_STAGE(PG8_SB(1, 1), cB + hstep + kstep, voffB);
        PG8_WAIT_V(6); PG8_BAR;
    }
    for (;;) {
        const bool has_next = S.next(ui + 1, nxt);
        typename Epi::Pre pre; E.prefetch(pre, cur, wr, fr, fq);
        const char* nA = has_next ? (const char*)g.A + (size_t)nxt.pm * tstep : cA; const char* nB = has_next ? (const char*)g.Bt + (size_t)nxt.pn * tstep : cB;
        for (int t = 0; t < nt; t += 2) {
            const bool last = (t == nt - 2);
            const char* a1 = cA + (size_t)(t + 1) * kstep;
            const char* a2 = last ? nA : cA + (size_t)(t + 2) * kstep; const char* b2 = last ? nB : cB + (size_t)(t + 2) * kstep;
            const char* a3 = a2 + kstep; const char* b3 = b2 + kstep;
            if (last && has_next) S.a_ready(nxt);
            if constexpr (SP2) {
            PG8_LDB(B0, 0, 0); PG8_LDB(B1, 0, 1); PG8_SCHED; PG8_LDA(At, 0, 0); PG8_STAGE(PG8_SA(1, 1), a1 + hstep, voffA);
            PG8_WAIT_V(8); PG8_WAIT_L(0); PG8_BAR; PG8_MMA(0, 0, At, B0); PG8_MMA(0, 1, At, B1); PG8_BAR; PG8_SCHED;
            PG8_LDA(At, 0, 1); PG8_STAGE(PG8_SB(0, 0), b2, voffB); PG8_STAGE(PG8_SB(0, 1), b2 + hstep, voffB); PG8_STAGE(PG8_SA(0, 0), a2, voffA);
            PG8_WAIT_V(8); PG8_WAIT_L(0); PG8_BAR; PG8_MMA(1, 0, At, B0); PG8_MMA(1, 1, At, B1); PG8_BAR; PG8_SCHED;
            PG8_LDB(B0, 1, 0); PG8_LDB(B1, 1, 1); PG8_SCHED; PG8_LDA(At, 1, 0); PG8_STAGE(PG8_SA(0, 1), a2 + hstep, voffA);
            PG8_WAIT_V(8); PG8_WAIT_L(0); PG8_BAR; PG8_MMA(0, 0, At, B0); PG8_MMA(0, 1, At, B1); PG8_BAR; PG8_SCHED;
            PG8_LDA(At, 1, 1); PG8_STAGE(PG8_SB(1, 0), b3, voffB); PG8_STAGE(PG8_SB(1, 1), b3 + hstep, voffB); PG8_STAGE(PG8_SA(1, 0), a3, voffA);
            PG8_WAIT_V(8); PG8_WAIT_L(0); PG8_BAR; PG8_MMA(1, 0, At, B0); PG8_MMA(1, 1, At, B1); PG8_BAR; PG8_SCHED;
            } else {
            PG8_LDB(B0, 0, 0); PG8_SCHED; PG8_LDA(At, 0, 0); PG8_STAGE(PG8_SA(1, 1), a1 + hstep, voffA);
            PG8_WAIT_L(8); PG8_BAR; PG8_WAIT_L(0); PG8_MMA(0, 0, At, B0); PG8_BAR; PG8_SCHED;
            PG8_LDB(B1, 0, 1); PG8_STAGE(PG8_SB(0, 0), b2, voffB);
            PG8_BAR; PG8_WAIT_L(0); PG8_MMA(0, 1, At, B1); PG8_BAR;
            PG8_LDA(At, 0, 1); PG8_STAGE(PG8_SA(0, 0), a2, voffA);
            PG8_BAR; PG8_WAIT_L(0); PG8_MMA(1, 0, At, B0); PG8_BAR; PG8_SCHED;
            PG8_STAGE(PG8_SB(0, 1), b2 + hstep, voffB);
            PG8_WAIT_V(6); PG8_BAR; PG8_MMA(1, 1, At, B1); PG8_BAR;
            PG8_LDB(B0, 1, 0); PG8_SCHED; PG8_LDA(At, 1, 0); PG8_STAGE(PG8_SA(0, 1), a2 + hstep, voffA);
            PG8_WAIT_L(8); PG8_BAR; PG8_WAIT_L(0); PG8_MMA(0, 0, At, B0); PG8_BAR; PG8_SCHED;
            PG8_LDB(B1, 1, 1); PG8_STAGE(PG8_SB(1, 0), b3, voffB);
            PG8_BAR; PG8_WAIT_L(0); PG8_MMA(0, 1, At, B1); PG8_BAR;
            PG8_LDA(At, 1, 1); PG8_STAGE(PG8_SA(1, 0), a3, voffA);
            PG8_BAR; PG8_WAIT_L(0); PG8_MMA(1, 0, At, B0); PG8_BAR; PG8_SCHED;
            PG8_STAGE(PG8_SB(1, 1), b3 + hstep, voffB);
            PG8_WAIT_V(6); PG8_BAR; PG8_MMA(1, 1, At, B1); PG8_BAR;
            }
        }
        if constexpr (ALIGN_EPI) { if (wr == 0) PG8_BAR; }
        if constexpr (!Epi::AFTER_DRAIN) { E(acc, cur, wr, wc, fr, fq, pre); S.done(cur); }
        if (!has_next) break;
#pragma unroll
        for (int a = 0; a < 2; ++a)
#pragma unroll
            for (int b = 0; b < 2; ++b)
#pragma unroll
                for (int m = 0; m < 4; ++m)
#pragma unroll
                    for (int n = 0; n < 2; ++n) acc[a][b][m][n] = (f32x4){0.f, 0.f, 0.f, 0.f};
        cur = nxt; cA = nA; cB = nB; ++ui;
        if constexpr (ALIGN_EPI) { if (wr == 1) PG8_BAR; }
    }
    PG8_WAIT_V(0);
    if constexpr (!ALIGN_EPI) { if (wr == 0) PG8_BAR; }
    PG8_BAR;
    if constexpr (Epi::AFTER_DRAIN) { E.fused(acc, cur, wr, wc, fr, fq, lds, wid, lane); S.done(cur); }
#undef PG8_SA
#undef PG8_SB
#undef PG8_STAGE
#undef PG8_LDA
#undef PG8_LDB
#undef PG8_MMA
#undef PG8_WAIT_V
#undef PG8_WAIT_L
#undef PG8_BAR
#undef PG8_SCHED
}
}

constexpr int D_MODEL = 1024, BATCH = 16, SEQ = 4096, T = BATCH * SEQ, DFF = 2816, DEPTH = 4;
constexpr int EVEN_IN = 4096, ODD_IN = 2048;
constexpr float EPS = 1e-6f;
typedef unsigned short bf16;
typedef unsigned u32x4 __attribute__((ext_vector_type(4)));
typedef unsigned u32x2 __attribute__((ext_vector_type(2)));
typedef float f32x4 __attribute__((ext_vector_type(4)));
typedef float f32x2 __attribute__((ext_vector_type(2)));
typedef float f32x8 __attribute__((ext_vector_type(8)));
typedef float f32x16 __attribute__((ext_vector_type(16)));
typedef short bf16x8 __attribute__((ext_vector_type(8)));
typedef short s16x4 __attribute__((ext_vector_type(4)));
#define LAS __attribute__((address_space(3)))
#define GAS __attribute__((address_space(1)))

constexpr size_t MiB = 1u << 20;
constexpr size_t WS_SS = 0;
constexpr size_t WS_BAR = 6 * MiB;
constexpr size_t WS_W = 8 * MiB;
constexpr size_t W_INE = 0, W_OUTE = W_INE + 2ull * 4096 * 1024, W_INO = W_OUTE + 2ull * 1024 * 1024, W_OUTO = W_INO + 2ull * 2048 * 1024,
                 W_FIN = W_OUTO + 2ull * 1024 * 1024, W_FOUT = W_FIN + 4ull * 5632 * 1024, W_SGW = W_FOUT + 4ull * 1024 * 2816, W_END = W_SGW + 2ull * 8 * 128 * 128;
static_assert(WS_W + W_END * 2 <= 108 * MiB, "weights");
constexpr size_t WS_ASCR = 108 * MiB;
constexpr size_t WS_HB = 140 * MiB;
constexpr size_t WS_MIX = 268 * MiB;
constexpr size_t WS_BIG = 396 * MiB;
constexpr size_t WS_END = 908 * MiB;
constexpr int LDS_BYTES = 147456;

struct Params {
    const float* x; const float* rel_bias; const float* norm_mix; const float* norm_ffn; const float* norm_final; const float* w_in_even; const float* w_out_even;
    const float* lq1; const float* lk1; const float* lq2; const float* lk2; const float* da_subln; const float* lb_fwd; const float* lb_bwd; const float* hg_norm;
    const float* w_in_odd; const float* sg_norm; const float* sg_w; const float* sg_b; const float* w_out_odd; const float* w_ffn_in; const float* w_ffn_out;
    float* out; unsigned char* ws; int ph_lo, ph_hi;
};

__device__ __forceinline__ unsigned cvtpk(float lo, float hi) { unsigned r; asm volatile("v_cvt_pk_bf16_f32 %0, %1, %2" : "=v"(r) : "v"(lo), "v"(hi)); return r; }
typedef __bf16 bf16v2 __attribute__((ext_vector_type(2)));
__device__ __forceinline__ unsigned cvtpk_c(float lo, float hi) { bf16v2 v; v.x = (__bf16)lo; v.y = (__bf16)hi; return __builtin_bit_cast(unsigned, v); }
__device__ __forceinline__ float bf2f(unsigned short b) { return __uint_as_float(((unsigned)b) << 16); }
__device__ __forceinline__ float bflo(unsigned w) { return __uint_as_float(w << 16); }
__device__ __forceinline__ float bfhi(unsigned w) { return __uint_as_float(w & 0xffff0000u); }
__device__ __forceinline__ float wave_sum(float v) {
#pragma unroll
    for (int o = 1; o < 64; o <<= 1) v += __shfl_xor(v, o);
    return v;
}

__device__ __forceinline__ void transpose_item(const float* W, int K, int N, bf16* WT, const float* gain, int ffn_perm, LAS float* scr, int item, int lane) {
    const int nblk = N / 32, kb = item / nblk, nb = item % nblk, k0 = 64 * kb, n0 = 32 * nb;
    float wv[32];
#pragma unroll
    for (int i = 0; i < 32; ++i) { const int kk = 2 * i + (lane >> 5); wv[i] = W[(size_t)(k0 + kk) * N + n0 + (lane & 31)]; }
#pragma unroll
    for (int i = 0; i < 32; ++i) { const int kk = 2 * i + (lane >> 5); const float g = gain ? gain[k0 + kk] : 1.0f; scr[kk * 33 + (lane & 31)] = wv[i] * g; }
    asm volatile("s_waitcnt lgkmcnt(0)" ::: "memory");
    int r0 = n0;
    if (ffn_perm) { r0 = (n0 < DFF) ? ((n0 >> 7) * 256 + (n0 & 127)) : (((n0 - DFF) >> 7) * 256 + 128 + ((n0 - DFF) & 127)); }
    const int c = lane & 7;
#pragma unroll
    for (int j = 0; j < 4; ++j) { const int n = (lane >> 3) + 8 * j; const LAS float* s = scr + (8 * c) * 33 + n;
        u32x4 o; o.x = cvtpk(s[0 * 33], s[1 * 33]); o.y = cvtpk(s[2 * 33], s[3 * 33]); o.z = cvtpk(s[4 * 33], s[5 * 33]); o.w = cvtpk(s[6 * 33], s[7 * 33]);
        *(u32x4*)(WT + (size_t)(r0 + n) * K + k0 + 8 * c) = o; }
    asm volatile("s_waitcnt lgkmcnt(0)" ::: "memory");
}

__device__ __forceinline__ void prologue_phase(const Params& p, LAS unsigned char* lds) {
    int tid_ = threadIdx.x; asm volatile("" : "+v"(tid_));
    const int tid = tid_, lane = tid & 63, wave = tid >> 6;
    const int gw = blockIdx.x * 8 + wave, NGW = gridDim.x * 8;
    const int gt = blockIdx.x * 512 + tid, NGT = gridDim.x * 512;
    { f32x4* z = (f32x4*)(p.ws + WS_SS); for (int i = T / 2 + gt; i < 11 * T / 2; i += NGT) z[i] = (f32x4){0.f, 0.f, 0.f, 0.f}; }
    bf16* WB = (bf16*)(p.ws + WS_W);
    LAS float* scr = (LAS float*)(lds + wave * 16384);
    constexpr int I_INE = 16 * 128, I_OUT = 16 * 32, I_INO = 16 * 64, I_FIN = 16 * 176, I_FOUT = 44 * 32;
    constexpr int NITEMS = 2 * I_INE + 2 * I_OUT + 2 * I_INO + 2 * I_OUT + 4 * I_FIN + 4 * I_FOUT;
    for (int it = gw; it < NITEMS; it += NGW) {
        int r = it;
        if (r < 2 * I_INE) { const int e = r / I_INE; transpose_item(p.w_in_even + (size_t)e * 1024 * 4096, 1024, 4096, WB + W_INE + (size_t)e * 4096 * 1024, p.norm_mix + (2 * e) * 1024, 0, scr, r % I_INE, lane); continue; } r -= 2 * I_INE;
        if (r < 2 * I_OUT) { const int e = r / I_OUT; transpose_item(p.w_out_even + (size_t)e * 1024 * 1024, 1024, 1024, WB + W_OUTE + (size_t)e * 1024 * 1024, nullptr, 0, scr, r % I_OUT, lane); continue; } r -= 2 * I_OUT;
        if (r < 2 * I_INO) { const int e = r / I_INO; transpose_item(p.w_in_odd + (size_t)e * 1024 * 2048, 1024, 2048, WB + W_INO + (size_t)e * 2048 * 1024, p.norm_mix + (2 * e + 1) * 1024, 0, scr, r % I_INO, lane); continue; } r -= 2 * I_INO;
        if (r < 2 * I_OUT) { const int e = r / I_OUT; transpose_item(p.w_out_odd + (size_t)e * 1024 * 1024, 1024, 1024, WB + W_OUTO + (size_t)e * 1024 * 1024, nullptr, 0, scr, r % I_OUT, lane); continue; } r -= 2 * I_OUT;
        if (r < 4 * I_FIN) { const int l = r / I_FIN; transpose_item(p.w_ffn_in + (size_t)l * 1024 * 5632, 1024, 5632, WB + W_FIN + (size_t)l * 5632 * 1024, p.norm_ffn + l * 1024, 1, scr, r % I_FIN, lane); continue; } r -= 4 * I_FIN;
        { const int l = r / I_FOUT; transpose_item(p.w_ffn_out + (size_t)l * 2816 * 1024, 2816, 1024, WB + W_FOUT + (size_t)l * 1024 * 2816, nullptr, 0, scr, r % I_FOUT, lane); }
    }
    { const f32x4* s = (const f32x4*)p.sg_w; u32x2* d = (u32x2*)(WB + W_SGW);
      for (int i = gt; i < 2 * 8 * 128 * 128 / 4; i += NGT) { const f32x4 v = s[i]; u32x2 o; o.x = cvtpk(v[0], v[1]); o.y = cvtpk(v[2], v[3]); d[i] = o; } }
    { unsigned long long* ss0 = (unsigned long long*)(p.ws + WS_SS); bf16* hb = (bf16*)(p.ws + WS_HB);
      for (int m = gw; m < T; m += 2 * NGW) {
        const int m1 = m + NGW; const bool has1 = m1 < T;
        const f32x4* xr0 = (const f32x4*)(p.x + (size_t)m * 1024) + lane; const f32x4* xr1 = (const f32x4*)(p.x + (size_t)(has1 ? m1 : m) * 1024) + lane;
        f32x4 a[4], b[4];
#pragma unroll
        for (int j = 0; j < 4; ++j) { a[j] = xr0[64 * j]; b[j] = xr1[64 * j]; }
        float s0 = 0.f, s1 = 0.f;
        u32x2* o0 = (u32x2*)(hb + (size_t)m * 1024) + lane; u32x2* o1 = (u32x2*)(hb + (size_t)m1 * 1024) + lane;
#pragma unroll
        for (int j = 0; j < 4; ++j) { const f32x4 v = a[j]; s0 += (v[0] * v[0] + v[1] * v[1]) + (v[2] * v[2] + v[3] * v[3]); u32x2 w; w.x = cvtpk(v[0], v[1]); w.y = cvtpk(v[2], v[3]); o0[64 * j] = w; }
        if (has1) {
#pragma unroll
          for (int j = 0; j < 4; ++j) { const f32x4 v = b[j]; s1 += (v[0] * v[0] + v[1] * v[1]) + (v[2] * v[2] + v[3] * v[3]); u32x2 w; w.x = cvtpk(v[0], v[1]); w.y = cvtpk(v[2], v[3]); o1[64 * j] = w; } }
        s0 = wave_sum(s0); s1 = wave_sum(s1);
        if (lane == 0) { ss0[m] = pg8::f2ss(s0); if (has1) ss0[m1] = pg8::f2ss(s1); } } }
}

__device__ __forceinline__ void final_phase(const Params& p) {
    int tid_ = threadIdx.x; asm volatile("" : "+v"(tid_));
    const int tid = tid_, lane = tid & 63, wave = tid >> 6;
    const int gw = blockIdx.x * 8 + wave, NGW = gridDim.x * 8;
    const unsigned long long* ss = (const unsigned long long*)(p.ws + WS_SS) + (size_t)8 * T;
    const bf16* hb = (const bf16*)(p.ws + WS_HB);
    f32x4 g0[2], g1[2];
#pragma unroll
    for (int j = 0; j < 2; ++j) { const int c = j * 512 + lane * 8; g0[j] = *(const f32x4*)(p.norm_final + c); g1[j] = *(const f32x4*)(p.norm_final + c + 4); }
    for (int m0 = gw; m0 < T; m0 += 4 * NGW) {
        u32x4 w[4][2]; unsigned long long sv[4];
#pragma unroll
        for (int q = 0; q < 4; ++q) { const int m = m0 + q * NGW; const int mc = m < T ? m : m0; sv[q] = ss[mc];
#pragma unroll
            for (int j = 0; j < 2; ++j) w[q][j] = *(const u32x4*)(hb + (size_t)mc * 1024 + j * 512 + lane * 8); }
#pragma unroll
        for (int q = 0; q < 4; ++q) { const int m = m0 + q * NGW; if (m < T) { const float r = __builtin_amdgcn_rsqf(pg8::ss2f(sv[q]) * (1.0f / 1024.0f) + EPS);
#pragma unroll
            for (int j = 0; j < 2; ++j) { const int c = j * 512 + lane * 8; const u32x4 x = w[q][j];
                const f32x4 v0 = (f32x4){bflo(x.x), bfhi(x.x), bflo(x.y), bfhi(x.y)}, v1 = (f32x4){bflo(x.z), bfhi(x.z), bflo(x.w), bfhi(x.w)};
                *(f32x4*)(p.out + (size_t)m * 1024 + c) = v0 * r * g0[j]; *(f32x4*)(p.out + (size_t)m * 1024 + c + 4) = v1 * r * g1[j]; } } } }
}

namespace att {
constexpr int KVBLK = 64, LDK = 4096;
constexpr int SHM_V = 64 * 128 * 2, SHM_K = 64 * 64 * 2;
constexpr int OFF_V = 0, OFF_K = 3 * SHM_V, OFF_WS = OFF_K + 3 * SHM_K, OFF_TB = OFF_WS + 8 * 64 * 4, OFF_OST = OFF_TB + 1552, OST_PITCH = 272, OFF_END = OFF_OST + 8 * 32 * OST_PITCH;
constexpr float LOG2E = 1.4426950408889634f;
constexpr float C1 = LOG2E;
constexpr float THR2 = 8.0f * LOG2E;
#define KSWZ64(row, colB) ((row) * 128 + ((colB) ^ ((((row) >> 1) & 7) << 4)))
#define SBAR() __builtin_amdgcn_sched_barrier(0)
__device__ __forceinline__ int crow(int r, int hi) { return (r & 3) + 8 * (r >> 2) + 4 * hi; }

__device__ __forceinline__ void partialSM(f32x16& p0, f32x16& p1, float& m_reg, float& mn, float& alpha, int kt0, int qpos, int qw, int hi, const float* tb2, float cL, float cR) {
  const int rel_hi = kt0 + 63 - qw, rel_lo = kt0 - (qw + 31);
  if (rel_hi <= -91 || rel_lo >= 91) {
    const float c = (rel_hi <= -91) ? cL : cR;
    float pmax = p0[0];
#pragma unroll
    for (int r = 1; r < 16; ++r) pmax = fmaxf(pmax, p0[r]);
#pragma unroll
    for (int r = 0; r < 16; ++r) pmax = fmaxf(pmax, p1[r]);
    pmax = fmaf(pmax, C1, c);
    { auto rr = __builtin_amdgcn_permlane32_swap(__float_as_uint(pmax), __float_as_uint(pmax), false, false);
      pmax = fmaxf(__uint_as_float(rr[0]), __uint_as_float(rr[1])); }
    if (__builtin_expect(__all(pmax - m_reg <= THR2), 1)) { mn = m_reg; alpha = 1.f; }
    else { mn = fmaxf(m_reg, pmax); alpha = __builtin_amdgcn_exp2f(m_reg - mn); m_reg = mn; }
    const float cm = c - mn;
#pragma unroll
    for (int r = 0; r < 16; ++r) { p0[r] = fmaf(p0[r], C1, cm); p1[r] = fmaf(p1[r], C1, cm); }
#pragma unroll
    for (int r = 0; r < 16; ++r) p0[r] = __builtin_amdgcn_exp2f(p0[r]);
    return;
  }
  {
    const float* tp = tb2 + (kt0 - qpos + 192 + 4 * hi);
#pragma unroll
    for (int r4 = 0; r4 < 4; ++r4) {
      float ta[4], tb[4];
#pragma unroll
      for (int i = 0; i < 4; ++i) { ta[i] = tp[8 * r4 + i]; tb[i] = tp[32 + 8 * r4 + i]; }
#pragma unroll
      for (int i = 0; i < 4; ++i) { p0[4 * r4 + i] = fmaf(p0[4 * r4 + i], C1, ta[i]); p1[4 * r4 + i] = fmaf(p1[4 * r4 + i], C1, tb[i]); }
      asm volatile("" ::: "memory");
    }
  }
  float pmax = p0[0];
#pragma unroll
  for (int r = 1; r < 16; ++r) pmax = fmaxf(pmax, p0[r]);
#pragma unroll
  for (int r = 0; r < 16; ++r) pmax = fmaxf(pmax, p1[r]);
  { auto rr = __builtin_amdgcn_permlane32_swap(__float_as_uint(pmax), __float_as_uint(pmax), false, false);
    pmax = fmaxf(__uint_as_float(rr[0]), __uint_as_float(rr[1])); }
  if (__builtin_expect(__all(pmax - m_reg <= THR2), 1)) { mn = m_reg; alpha = 1.f; }
  else { mn = fmaxf(m_reg, pmax); alpha = __builtin_amdgcn_exp2f(m_reg - mn); m_reg = mn; }
#pragma unroll
  for (int r = 0; r < 16; ++r) { p0[r] = p0[r] - mn; p1[r] = p1[r] - mn; }
#pragma unroll
  for (int r = 0; r < 16; ++r) p0[r] = __builtin_amdgcn_exp2f(p0[r]);
}
__device__ __forceinline__ void finishSM(f32x16& p0, f32x16& p1, float alpha, float& l_reg, bf16x8& pa0, bf16x8& pa1, bf16x8& pa2, bf16x8& pa3) {
#pragma unroll
  for (int r = 0; r < 16; ++r) p1[r] = __builtin_amdgcn_exp2f(p1[r]);
  float ps = 0;
#pragma unroll
  for (int r = 0; r < 16; ++r) ps += p0[r];
#pragma unroll
  for (int r = 0; r < 16; ++r) ps += p1[r];
  { auto rr = __builtin_amdgcn_permlane32_swap(__float_as_uint(ps), __float_as_uint(ps), false, false);
    ps = __uint_as_float(rr[0]) + __uint_as_float(rr[1]); }
  l_reg = l_reg * alpha + ps;
#define PK4(P, BASE, OUT) do { unsigned a0 = cvtpk(P[BASE + 0], P[BASE + 1]), a1 = cvtpk(P[BASE + 2], P[BASE + 3]);   \
    unsigned b0 = cvtpk(P[BASE + 4], P[BASE + 5]), b1 = cvtpk(P[BASE + 6], P[BASE + 7]);                              \
    auto r0 = __builtin_amdgcn_permlane32_swap(a0, b0, false, false); auto r1 = __builtin_amdgcn_permlane32_swap(a1, b1, false, false); \
    u32x4 w = {r0[0], r1[0], r0[1], r1[1]}; OUT = *reinterpret_cast<bf16x8*>(&w); } while (0)
  PK4(p0, 0, pa0); PK4(p0, 8, pa1); PK4(p1, 0, pa2); PK4(p1, 8, pa3);
#undef PK4
}
__device__ __forceinline__ void qkt(f32x16& p0, f32x16& p1, const char* Ks, const bf16x8* qr, int r32, int hi) {
  bf16x8 ka[4], kb[4];
#pragma unroll
  for (int d0 = 0; d0 < 4; ++d0) { const int cb = (d0 * 16 + hi * 8) * 2;
    ka[d0] = *reinterpret_cast<const bf16x8*>(Ks + KSWZ64(r32, cb)); kb[d0] = *reinterpret_cast<const bf16x8*>(Ks + KSWZ64(32 + r32, cb)); }
  asm volatile("s_waitcnt lgkmcnt(0)" ::: "memory"); SBAR();
  p0 = f32x16{}; p1 = f32x16{};
#pragma unroll
  for (int d0 = 0; d0 < 4; ++d0) {
    p0 = __builtin_amdgcn_mfma_f32_32x32x16_bf16(ka[d0], qr[d0], p0, 0, 0, 0);
    p1 = __builtin_amdgcn_mfma_f32_32x32x16_bf16(kb[d0], qr[d0], p1, 0, 0, 0); }
}
__device__ __forceinline__ int v_st(int k, int c) { const int kk = (k & ~0xC) | ((k & 4) << 1) | ((k & 8) >> 1); return ((kk >> 3) * 4 + (c >> 5)) * 512 + ((kk & 7) * 32 + (c & 31)) * 2; }
__device__ __forceinline__ int v_rd_base(int lane) { return ((lane & 3) << 3) | (((lane >> 2) & 3) << 6) | (((lane >> 4) & 1) << 5) | (((lane >> 5) & 1) << 8); }
constexpr int v_rd_off(int d0, int ks, int half) { return d0 * 512 + ks * 4096 + half * 2048; }
template <int OFF> __device__ __forceinline__ s16x4 tr_read(int vb) {
  s16x4 r; asm volatile("ds_read_b64_tr_b16 %0, %1 offset:%2" : "=&v"(r) : "v"(vb), "i"(OFF) : "memory"); return r;
}
template <int D0> __device__ __forceinline__ void pv_one(f32x16& od, int vb, bf16x8 pa0, bf16x8 pa1, bf16x8 pa2, bf16x8 pa3) {
  const s16x4 l0 = tr_read<v_rd_off(D0, 0, 0)>(vb), h0 = tr_read<v_rd_off(D0, 0, 1)>(vb), l1 = tr_read<v_rd_off(D0, 1, 0)>(vb), h1 = tr_read<v_rd_off(D0, 1, 1)>(vb);
  const s16x4 l2 = tr_read<v_rd_off(D0, 2, 0)>(vb), h2 = tr_read<v_rd_off(D0, 2, 1)>(vb), l3 = tr_read<v_rd_off(D0, 3, 0)>(vb), h3 = tr_read<v_rd_off(D0, 3, 1)>(vb);
  asm volatile("s_waitcnt lgkmcnt(0)" ::: "memory"); SBAR();
#define PK(L, H) (bf16x8){L[0], L[1], L[2], L[3], H[0], H[1], H[2], H[3]}
  od = __builtin_amdgcn_mfma_f32_32x32x16_bf16(pa0, PK(l0, h0), od, 0, 0, 0);
  od = __builtin_amdgcn_mfma_f32_32x32x16_bf16(pa1, PK(l1, h1), od, 0, 0, 0);
  od = __builtin_amdgcn_mfma_f32_32x32x16_bf16(pa2, PK(l2, h2), od, 0, 0, 0);
  od = __builtin_amdgcn_mfma_f32_32x32x16_bf16(pa3, PK(l3, h3), od, 0, 0, 0);
#undef PK
}
__device__ __forceinline__ void pv_d0(f32x16* o, int vb, bf16x8 pa0, bf16x8 pa1, bf16x8 pa2, bf16x8 pa3) {
  pv_one<0>(o[0], vb, pa0, pa1, pa2, pa3); pv_one<1>(o[1], vb, pa0, pa1, pa2, pa3); pv_one<2>(o[2], vb, pa0, pa1, pa2, pa3); pv_one<3>(o[3], vb, pa0, pa1, pa2, pa3);
}

template <bool GRPB> __device__ __forceinline__ void attn_pass(const int pass, float* __restrict__ scr, bf16* __restrict__ mixrow, const float lam, const float* __restrict__ gsub, const float one_m_li,
                                          const bf16* __restrict__ Qb, const bf16* __restrict__ Kh, const bf16* __restrict__ Vh, int q0seq, char* lds, const float* tb2) {
  int tid_ = threadIdx.x; asm volatile("" : "+v"(tid_));
  const int tid = tid_, wid = tid >> 6, lane = tid & 63, r32 = lane & 31, hi = lane >> 5;
  char* V_lds = lds + OFF_V; char* K_lds = lds + OFF_K;
  float* ws = (float*)(lds + OFF_WS) + wid * 64; float* li_l = ws; float* al_l = ws + 32; char* ost = lds + OFF_OST + wid * (32 * OST_PITCH);
  const float cL = __uint_as_float(__builtin_amdgcn_readfirstlane(__float_as_uint(tb2[0]))), cR = __uint_as_float(__builtin_amdgcn_readfirstlane(__float_as_uint(tb2[384])));
  const int qw = __builtin_amdgcn_readfirstlane(q0seq + wid * 32), qpos = qw + r32;
  float m_reg = -1e30f, l_reg = 0; bf16x8 qr[4]; f32x16 o[4];
#pragma unroll
  for (int d = 0; d < 4; ++d) o[d] = f32x16{};
  const bf16* Qw = Qb + (long)(wid * 32 + r32) * LDK + hi * 8;
#pragma unroll
  for (int d0 = 0; d0 < 4; ++d0) qr[d0] = *(const GAS bf16x8*)(Qw + d0 * 16);
  const int sr = tid >> 4, sc = (tid & 15) * 8, vst0 = v_st(sr, sc), vst1 = v_st(32 + sr, sc);
  const int kr = tid >> 3, kc = (tid & 7) * 8, kst = KSWZ64(kr, kc * 2);
  const int vb0 = (int)(uintptr_t)V_lds + v_rd_base(lane);
  struct { bf16x8 vs0, vs1, ks0; } sr_[2];
#define SLOAD(i, k0) do { sr_[i].vs0 = *(const GAS bf16x8*)(&Vh[(long)((k0) + sr) * LDK + sc]); sr_[i].vs1 = *(const GAS bf16x8*)(&Vh[(long)((k0) + 32 + sr) * LDK + sc]); \
    sr_[i].ks0 = *(const GAS bf16x8*)(&Kh[(long)((k0) + kr) * LDK + kc]); } while (0)
#define SWRITE(b, i) do { *(bf16x8*)(V_lds + (b) * SHM_V + vst0) = sr_[i].vs0; *(bf16x8*)(V_lds + (b) * SHM_V + vst1) = sr_[i].vs1; \
    *(bf16x8*)(K_lds + (b) * SHM_K + kst) = sr_[i].ks0; } while (0)
#define SWAIT() asm volatile("s_waitcnt vmcnt(3)" ::: "memory")
#define RESC(a) do { if (__any((a) < 1.f)) { if (hi == 0) al_l[r32] = (a); asm volatile("s_waitcnt lgkmcnt(0)" ::: "memory"); \
    _Pragma("unroll") for (int d = 0; d < 4; ++d) _Pragma("unroll") for (int r = 0; r < 16; ++r) o[d][r] *= al_l[crow(r, hi)]; } } while (0)
  f32x16 pA0, pA1, pB0, pB1; float mnA, mnB, alA, alB; bf16x8 pa0, pa1, pa2, pa3; constexpr int NT = SEQ / KVBLK;
  __syncthreads();
  SLOAD(0, 0); SLOAD(1, KVBLK); asm volatile("s_waitcnt vmcnt(0)" ::: "memory"); SWRITE(0, 0); SWRITE(1, 1);
  SLOAD(0, 2 * KVBLK); asm volatile("s_waitcnt vmcnt(0)" ::: "memory"); SWRITE(2, 0); __syncthreads();
  qkt(pA0, pA1, K_lds, qr, r32, hi); partialSM(pA0, pA1, m_reg, mnA, alA, 0, qpos, qw, hi, tb2, cL, cR);
  int bm1 = 0, b0 = 1, bp1 = 2;
#define HSTEP(N0, N1, MN, AL, C0, C1, ALC, TPOS, LOADSTMT) do { \
    if constexpr (GRPB) { SBAR(); finishSM(C0, C1, ALC, l_reg, pa0, pa1, pa2, pa3); SBAR(); qkt(N0, N1, K_lds + b0 * SHM_K, qr, r32, hi); SBAR(); LOADSTMT; SBAR(); \
                partialSM(N0, N1, m_reg, MN, AL, (TPOS), qpos, qw, hi, tb2, cL, cR); SBAR(); pv_d0(o, vb0 + bm1 * SHM_V, pa0, pa1, pa2, pa3); } \
    else      { SBAR(); qkt(N0, N1, K_lds + b0 * SHM_K, qr, r32, hi); finishSM(C0, C1, ALC, l_reg, pa0, pa1, pa2, pa3); SBAR(); LOADSTMT; SBAR(); \
                pv_d0(o, vb0 + bm1 * SHM_V, pa0, pa1, pa2, pa3); partialSM(N0, N1, m_reg, MN, AL, (TPOS), qpos, qw, hi, tb2, cL, cR); } } while (0)
  for (int t = 1; t + 1 < NT; t += 2) {
    HSTEP(pB0, pB1, mnB, alB, pA0, pA1, alA, t * KVBLK, SLOAD(0, (t + 2) * KVBLK));
    __syncthreads(); SWRITE(bm1, 0);
    RESC(alB);
    { const int tmp = bm1; bm1 = b0; b0 = bp1; bp1 = tmp; }
    HSTEP(pA0, pA1, mnA, alA, pB0, pB1, alB, (t + 1) * KVBLK, if (t + 3 < NT) SLOAD(0, (t + 3) * KVBLK));
    __syncthreads(); if (t + 3 < NT) SWRITE(bm1, 0);
    RESC(alA);
    { const int tmp = bm1; bm1 = b0; b0 = bp1; bp1 = tmp; }
  }
#undef HSTEP
  SBAR(); qkt(pB0, pB1, K_lds + b0 * SHM_K, qr, r32, hi);
  finishSM(pA0, pA1, alA, l_reg, pa0, pa1, pa2, pa3); SBAR();
  pv_d0(o, vb0 + bm1 * SHM_V, pa0, pa1, pa2, pa3); partialSM(pB0, pB1, m_reg, mnB, alB, (NT - 1) * KVBLK, qpos, qw, hi, tb2, cL, cR);
  RESC(alB);
  finishSM(pB0, pB1, alB, l_reg, pa0, pa1, pa2, pa3); SBAR();
  pv_d0(o, vb0 + b0 * SHM_V, pa0, pa1, pa2, pa3);
  if (hi == 0) li_l[r32] = l_reg; asm volatile("s_waitcnt lgkmcnt(0)" ::: "memory");
  GAS f32x4* scr4 = (GAS f32x4*)(scr + (size_t)tid * 64);
  if (pass == 0) {
#pragma unroll
    for (int r4 = 0; r4 < 4; ++r4) { const f32x4 lv = *(const f32x4*)(li_l + 8 * r4 + 4 * hi);
      const f32x4 rl = (f32x4){__builtin_amdgcn_rcpf(lv[0]), __builtin_amdgcn_rcpf(lv[1]), __builtin_amdgcn_rcpf(lv[2]), __builtin_amdgcn_rcpf(lv[3])};
#pragma unroll
      for (int d0 = 0; d0 < 4; ++d0) scr4[d0 * 4 + r4] = (f32x4){o[d0][4 * r4 + 0] * rl[0], o[d0][4 * r4 + 1] * rl[1], o[d0][4 * r4 + 2] * rl[2], o[d0][4 * r4 + 3] * rl[3]}; }
  } else {
    float g[4];
#pragma unroll
    for (int d0 = 0; d0 < 4; ++d0) g[d0] = gsub[d0 * 32 + r32] * one_m_li;
#pragma unroll
    for (int r4 = 0; r4 < 4; ++r4) { const f32x4 lv = *(const f32x4*)(li_l + 8 * r4 + 4 * hi);
      f32x4 av[4];
#pragma unroll
      for (int d0 = 0; d0 < 4; ++d0) av[d0] = scr4[d0 * 4 + r4];
#pragma unroll
      for (int i = 0; i < 4; ++i) { const float rl = __builtin_amdgcn_rcpf(lv[i]) * lam; float dv[4]; float sq = 0.f;
#pragma unroll
        for (int d0 = 0; d0 < 4; ++d0) { dv[d0] = av[d0][i] - rl * o[d0][4 * r4 + i]; sq += dv[d0] * dv[d0]; }
        sq += __shfl_xor(sq, 1); sq += __shfl_xor(sq, 2); sq += __shfl_xor(sq, 4); sq += __shfl_xor(sq, 8); sq += __shfl_xor(sq, 16);
        const float rs = __builtin_amdgcn_rsqf(sq * (1.0f / 128.0f) + EPS);
        unsigned short* orow = (unsigned short*)(ost + (8 * r4 + 4 * hi + i) * OST_PITCH) + r32;
#pragma unroll
        for (int d0 = 0; d0 < 4; ++d0) orow[d0 * 32] = (unsigned short)(cvtpk(dv[d0] * rs * g[d0], 0.f) & 0xffffu); } }
    asm volatile("s_waitcnt lgkmcnt(0)" ::: "memory");
    { const int rr = lane >> 4, c16 = lane & 15; char* gdst = (char*)(mixrow + (size_t)(wid * 32 + rr) * 1024) + c16 * 16;
#pragma unroll
      for (int j = 0; j < 8; ++j) { const u32x4 w = *(const u32x4*)(ost + (4 * j + rr) * OST_PITCH + c16 * 16); *(GAS u32x4*)(gdst + (size_t)j * 8192) = w; } }
  }
#undef SLOAD
#undef SWRITE
#undef SWAIT
#undef RESC
}

__device__ __forceinline__ int rel_bucket(int rel) {
  const int ret = rel > 0 ? 16 : 0; const int n = rel < 0 ? -rel : rel;
  if (n < 8) return ret + n;
  int large = 2 + (31 - __clz(n * n)); if (large > 15) large = 15;
  return ret + large;
}

__device__ __forceinline__ void attn_phase(const Params& p, int e, char* lds) {
  int tid_ = threadIdx.x; asm volatile("" : "+v"(tid_));
  const int tid = tid_, wid = tid >> 6, lane = tid & 63, r32 = lane & 31, hi = lane >> 5;
  const bf16* big = (const bf16*)(p.ws + WS_BIG); bf16* mix = (bf16*)(p.ws + WS_MIX);
  float* scr = (float*)(p.ws + WS_ASCR) + (size_t)blockIdx.x * 32768;
  float* tb2 = (float*)(lds + OFF_TB);
  float lam, one_m_li;
  { const float a = p.lq1[e * 64 + lane] * p.lk1[e * 64 + lane], b = p.lq2[e * 64 + lane] * p.lk2[e * 64 + lane];
    const float s1 = wave_sum(a), s2 = wave_sum(b); const float li = 0.8f - 0.6f * __expf(-0.3f * (float)(2 * e));
    lam = __uint_as_float(__builtin_amdgcn_readfirstlane(__float_as_uint(__expf(s1) - __expf(s2) + li))); one_m_li = 1.0f - li; }
  int cur_h = -1;
  const bool xmap = (gridDim.x == 256);
  const int nrounds = xmap ? 4 : (BATCH * 4 * 16 + (int)gridDim.x - 1) / (int)gridDim.x;
  for (int k = 0; k < nrounds; ++k) {
    const int u = xmap ? ((((k * 16) + ((int)(blockIdx.x & 7) * 2) + (int)(blockIdx.x >> 7)) << 4) | (int)((blockIdx.x >> 3) & 15)) : ((int)blockIdx.x + k * (int)gridDim.x);
    if (u >= BATCH * 4 * 16) break;
    const int qb = u & 15, h = (u >> 4) & 3, b = u >> 6;
    if (h != cur_h) { __syncthreads(); for (int d = tid; d < 385; d += 512) tb2[d] = p.rel_bias[rel_bucket(d - 192) * 4 + h] * LOG2E; cur_h = h; __syncthreads(); }
    const long row0 = (long)b * SEQ + qb * 256;
    if (__builtin_amdgcn_readfirstlane(wid) & 1) {
      attn_pass<true>(0, scr, mix + (size_t)row0 * 1024 + h * 128, lam, p.da_subln + e * 128, one_m_li,
                big + row0 * LDK + h * 128, big + (long)b * SEQ * LDK + 512 + h * 128, big + (long)b * SEQ * LDK + 1024 + h * 128, qb * 256, lds, tb2);
      attn_pass<true>(1, scr, mix + (size_t)row0 * 1024 + h * 128, lam, p.da_subln + e * 128, one_m_li,
                big + row0 * LDK + h * 128 + 64, big + (long)b * SEQ * LDK + 512 + h * 128 + 64, big + (long)b * SEQ * LDK + 1024 + h * 128, qb * 256, lds, tb2);
    } else {
      attn_pass<false>(0, scr, mix + (size_t)row0 * 1024 + h * 128, lam, p.da_subln + e * 128, one_m_li,
                big + row0 * LDK + h * 128, big + (long)b * SEQ * LDK + 512 + h * 128, big + (long)b * SEQ * LDK + 1024 + h * 128, qb * 256, lds, tb2);
      attn_pass<false>(1, scr, mix + (size_t)row0 * 1024 + h * 128, lam, p.da_subln + e * 128, one_m_li,
                big + row0 * LDK + h * 128 + 64, big + (long)b * SEQ * LDK + 512 + h * 128 + 64, big + (long)b * SEQ * LDK + 1024 + h * 128, qb * 256, lds, tb2);
    }
  }
}
}

namespace hg {
constexpr int TB = 32;
constexpr int OFF_F = 0, OFF_Q = 16384, OFF_V = 32768, OFF_OP = 40960, OFF_END = 40960 + 65536;
__device__ __forceinline__ void hgrn_phase(const Params& p, int e, char* lds) {
  int tid_ = threadIdx.x; asm volatile("" : "+v"(tid_));
  const int tid = tid_, wave = tid >> 6, lane = tid & 63;
  const bf16* big = (const bf16*)(p.ws + WS_BIG);
  bf16* ohg = (bf16*)(p.ws + WS_HB);
  float* F = (float*)(lds + OFF_F); float* Q = (float*)(lds + OFF_Q); float* Vv = (float*)(lds + OFF_V); float* OP = (float*)(lds + OFF_OP);
  const int lt = tid >> 4, lk8 = (tid & 15) * 8;
  const int vt = (tid & 255) >> 3, vv8 = (tid & 7) * 8;
  const int vg = lane & 15, kg = wave * 4 + (lane >> 4), k0 = kg * 4, v0 = vg * 4;
  const int st = tid >> 4, sv4 = (tid & 15) * 4;
  for (int u = blockIdx.x; u < 256; u += gridDim.x) {
    const int vh = u & 1, dir = (u >> 1) & 1, h = (u >> 2) & 3, b = u >> 4;
    const float* lbsrc = dir ? p.lb_bwd : p.lb_fwd;
    float lb[8];
#pragma unroll
    for (int i = 0; i < 8; ++i) { if (e == 0) lb[i] = 0.f; else { const float a0 = lbsrc[h * 128 + lk8 + i], a1 = lbsrc[512 + h * 128 + lk8 + i]; lb[i] = 1.0f / (1.0f + __expf(a0 - a1)); } }
    const bf16* qbase = big + (size_t)b * SEQ * 4096 + 1536 + h * 128 + lk8;
    const bf16* zbase = big + (size_t)b * SEQ * 4096 + (dir ? 2560 : 2048) + h * 128 + lk8;
    const bf16* vbase = big + (size_t)b * SEQ * 4096 + 3072 + h * 128 + vh * 64 + vv8;
    bf16* obase = ohg + (size_t)dir * T * 512 + (size_t)b * SEQ * 512 + h * 128 + vh * 64 + sv4;
    f32x2 S[4][2];
#pragma unroll
    for (int i = 0; i < 4; ++i) { S[i][0] = (f32x2){0.f, 0.f}; S[i][1] = (f32x2){0.f, 0.f}; }
    u32x4 rq, rz, rv;
    { const int pos = dir ? (SEQ - 1 - lt) : lt; rq = *(const u32x4*)(qbase + (size_t)pos * 4096); rz = *(const u32x4*)(zbase + (size_t)pos * 4096);
      const int pv = dir ? (SEQ - 1 - vt) : vt; rv = (tid < 256) ? *(const u32x4*)(vbase + (size_t)pv * 4096) : (u32x4){0, 0, 0, 0}; }
    for (int blk = 0; blk < SEQ / TB; ++blk) {
      { float zf[8], qf[8];
        zf[0] = bflo(rz.x); zf[1] = bfhi(rz.x); zf[2] = bflo(rz.y); zf[3] = bfhi(rz.y); zf[4] = bflo(rz.z); zf[5] = bfhi(rz.z); zf[6] = bflo(rz.w); zf[7] = bfhi(rz.w);
        qf[0] = bflo(rq.x); qf[1] = bfhi(rq.x); qf[2] = bflo(rq.y); qf[3] = bfhi(rq.y); qf[4] = bflo(rq.z); qf[5] = bfhi(rq.z); qf[6] = bflo(rq.w); qf[7] = bfhi(rq.w);
        float ff[8];
#pragma unroll
        for (int i = 0; i < 8; ++i) { const float sg = __builtin_amdgcn_rcpf(1.0f + __builtin_amdgcn_exp2f(-1.4426950408889634f * zf[i])); ff[i] = lb[i] + (1.0f - lb[i]) * sg; }
        *(f32x4*)(F + lt * 128 + lk8) = (f32x4){ff[0], ff[1], ff[2], ff[3]}; *(f32x4*)(F + lt * 128 + lk8 + 4) = (f32x4){ff[4], ff[5], ff[6], ff[7]};
        *(f32x4*)(Q + lt * 128 + lk8) = (f32x4){qf[0], qf[1], qf[2], qf[3]}; *(f32x4*)(Q + lt * 128 + lk8 + 4) = (f32x4){qf[4], qf[5], qf[6], qf[7]};
        if (tid < 256) { *(f32x4*)(Vv + vt * 64 + vv8) = (f32x4){bflo(rv.x), bfhi(rv.x), bflo(rv.y), bfhi(rv.y)}; *(f32x4*)(Vv + vt * 64 + vv8 + 4) = (f32x4){bflo(rv.z), bfhi(rv.z), bflo(rv.w), bfhi(rv.w)}; } }
      __syncthreads();
      if (blk + 1 < SEQ / TB) { const int t1 = (blk + 1) * TB;
        const int pos = dir ? (SEQ - 1 - (t1 + lt)) : (t1 + lt); rq = *(const u32x4*)(qbase + (size_t)pos * 4096); rz = *(const u32x4*)(zbase + (size_t)pos * 4096);
        const int pv = dir ? (SEQ - 1 - (t1 + vt)) : (t1 + vt); if (tid < 256) rv = *(const u32x4*)(vbase + (size_t)pv * 4096); }
#pragma unroll 4
      for (int t = 0; t < TB; ++t) {
        const f32x4 f4 = *(const f32x4*)(F + t * 128 + k0), q4 = *(const f32x4*)(Q + t * 128 + k0), v4 = *(const f32x4*)(Vv + t * 64 + v0);
        const f32x2 va = (f32x2){v4[0], v4[1]}, vb = (f32x2){v4[2], v4[3]};
        f32x2 oa = (f32x2){0.f, 0.f}, ob = (f32x2){0.f, 0.f};
#pragma unroll
        for (int i = 0; i < 4; ++i) { const f32x2 fi = (f32x2){f4[i], f4[i]}, qi = (f32x2){q4[i], q4[i]};
          S[i][0] = fi * (S[i][0] - va) + va; S[i][1] = fi * (S[i][1] - vb) + vb;
          oa += S[i][0] * qi; ob += S[i][1] * qi; }
        float o0 = oa.x, o1 = oa.y, o2 = ob.x, o3 = ob.y;
        o0 += __shfl_xor(o0, 16); o1 += __shfl_xor(o1, 16); o2 += __shfl_xor(o2, 16); o3 += __shfl_xor(o3, 16);
        o0 += __shfl_xor(o0, 32); o1 += __shfl_xor(o1, 32); o2 += __shfl_xor(o2, 32); o3 += __shfl_xor(o3, 32);
        if (lane < 16) *(f32x4*)(OP + (wave * TB + t) * 64 + v0) = (f32x4){o0, o1, o2, o3};
      }
      __syncthreads();
      { f32x4 s = *(const f32x4*)(OP + (0 * TB + st) * 64 + sv4);
#pragma unroll
        for (int w = 1; w < 8; ++w) s += *(const f32x4*)(OP + (w * TB + st) * 64 + sv4);
        const int tt = blk * TB + st; const int pos = dir ? (SEQ - 1 - tt) : tt;
        u32x2 o; o.x = cvtpk(s[0], s[1]); o.y = cvtpk(s[2], s[3]); *(u32x2*)(obase + (size_t)pos * 512) = o; }
    }
    __syncthreads();
  }
}
__device__ __forceinline__ void hgpost_phase(const Params& p, int e) {
  int tid_ = threadIdx.x; asm volatile("" : "+v"(tid_));
  const int tid = tid_, lane = tid & 63, wave = tid >> 6;
  const int gw = blockIdx.x * 8 + wave, NGW = gridDim.x * 8;
  const bf16* big = (const bf16*)(p.ws + WS_BIG); const bf16* ohg = (const bf16*)p.out; bf16* mix = (bf16*)(p.ws + WS_MIX);
  float gn[8];
#pragma unroll
  for (int i = 0; i < 8; ++i) gn[i] = p.hg_norm[e * 128 + (lane & 15) * 8 + i];
  for (int m0 = gw; m0 < T; m0 += 4 * NGW) {
    u32x4 av[4], bv[4], cv[4], dv4[4], gv[4];
#pragma unroll
    for (int q = 0; q < 4; ++q) { const int m = m0 + q * NGW; const int mc = m < T ? m : m0;
      av[q] = *(const u32x4*)(ohg + (size_t)mc * 512 + lane * 8); bv[q] = *(const u32x4*)(ohg + (size_t)T * 512 + (size_t)mc * 512 + lane * 8);
      cv[q] = *(const u32x4*)(ohg + (size_t)2 * T * 512 + (size_t)mc * 512 + lane * 8); dv4[q] = *(const u32x4*)(ohg + (size_t)3 * T * 512 + (size_t)mc * 512 + lane * 8); gv[q] = *(const u32x4*)(big + (size_t)mc * 4096 + 3584 + lane * 8); }
#pragma unroll
    for (int q = 0; q < 4; ++q) { const int m = m0 + q * NGW; const u32x4 a = av[q], b = bv[q], cc4 = cv[q], dd4 = dv4[q], g = gv[q];
      float s[8];
      s[0] = (bflo(a.x) + bflo(b.x)) + (bflo(cc4.x) + bflo(dd4.x)); s[1] = (bfhi(a.x) + bfhi(b.x)) + (bfhi(cc4.x) + bfhi(dd4.x));
      s[2] = (bflo(a.y) + bflo(b.y)) + (bflo(cc4.y) + bflo(dd4.y)); s[3] = (bfhi(a.y) + bfhi(b.y)) + (bfhi(cc4.y) + bfhi(dd4.y));
      s[4] = (bflo(a.z) + bflo(b.z)) + (bflo(cc4.z) + bflo(dd4.z)); s[5] = (bfhi(a.z) + bfhi(b.z)) + (bfhi(cc4.z) + bfhi(dd4.z));
      s[6] = (bflo(a.w) + bflo(b.w)) + (bflo(cc4.w) + bflo(dd4.w)); s[7] = (bfhi(a.w) + bfhi(b.w)) + (bfhi(cc4.w) + bfhi(dd4.w));
      float sq = 0.f;
#pragma unroll
      for (int i = 0; i < 8; ++i) sq += s[i] * s[i];
      sq += __shfl_xor(sq, 1); sq += __shfl_xor(sq, 2); sq += __shfl_xor(sq, 4); sq += __shfl_xor(sq, 8);
      const float rs = __builtin_amdgcn_rsqf(sq * (1.0f / 128.0f) + EPS);
      float gg[8]; gg[0] = bflo(g.x); gg[1] = bfhi(g.x); gg[2] = bflo(g.y); gg[3] = bfhi(g.y); gg[4] = bflo(g.z); gg[5] = bfhi(g.z); gg[6] = bflo(g.w); gg[7] = bfhi(g.w);
      float o[8];
#pragma unroll
      for (int i = 0; i < 8; ++i) o[i] = s[i] * rs * gn[i] * gg[i];
      u32x4 w; w.x = cvtpk(o[0], o[1]); w.y = cvtpk(o[2], o[3]); w.z = cvtpk(o[4], o[5]); w.w = cvtpk(o[6], o[7]);
      if (m < T) *(u32x4*)(mix + (size_t)m * 1024 + 512 + lane * 8) = w; }
  }
}
}


namespace hg2 {
constexpr int PQ = 272, PJ = 144;
constexpr int OFF_QD = 0, OFF_QA = 17408, OFF_KB = 34816, OFF_KS = 52224, OFF_VT = 70656, OFF_P = 79872, OFF_ST = 89088, OFF_TOT = 123904, OFF_D = 125952, OFF_END = 126464;
constexpr float L2E = 1.4426950408889634f;
__device__ __forceinline__ bf16x8 ldfrag(const char* base, int row, int pitch, int koff) { return *(const bf16x8*)(base + row * pitch + koff * 2); }
__device__ __forceinline__ void hgrn_phase(const Params& p, int e, char* lds) {
  int tid_ = threadIdx.x; asm volatile("" : "+v"(tid_));
  const int tid = tid_, wave = tid >> 6, lane = tid & 63, fr = lane & 15, fq_ = lane >> 4;
  const char* bigc = (const char*)(p.ws + WS_BIG);
  char* ohgc = (char*)p.out;
  char* QD = lds + OFF_QD; char* QA = lds + OFF_QA; char* KB = lds + OFF_KB; char* KS = lds + OFF_KS; char* VT = lds + OFF_VT; char* PP = lds + OFF_P; char* ST = lds + OFF_ST;
  char* RQ = QD; char* RZ = QA; char* RV = KB;
  float* TOT = (float*)(lds + OFF_TOT); float* DD = (float*)(lds + OFF_D);
  const int k = tid & 127, rq = tid >> 7;
  const int vv = tid & 63, jg = tid >> 6;
  const int lr0 = tid >> 4, lc8 = (tid & 15) * 8;
  const int vr = tid >> 3, vc8 = (tid & 7) * 8;
  for (int u = blockIdx.x; u < 256; u += gridDim.x) {
    const int vh = u & 1, dir = (u >> 1) & 1, h = (u >> 2) & 3, b = u >> 4;
    float lbk = 0.f;
    if (e != 0) { const float* lbsrc = dir ? p.lb_bwd : p.lb_fwd; const float a0 = lbsrc[h * 128 + k], a1 = lbsrc[512 + h * 128 + k]; lbk = 1.0f / (1.0f + __expf(a0 - a1)); }
    const int rsb = dir ? -8192 : 8192;
    const int base0 = (b * SEQ + (dir ? (SEQ - 1) : 0)) * 8192;
    const int qcol = (1536 + h * 128 + lc8) * 2, zcol = ((dir ? 2560 : 2048) + h * 128 + lc8) * 2, vcol = (3072 + h * 128 + vh * 64 + vc8) * 2;
    const int osb = dir ? -1024 : 1024;
    const int obase = dir * (T * 1024) + (b * SEQ + (dir ? (SEQ - 1) : 0)) * 1024 + (h * 128 + vh * 64) * 2;
    f32x4 Sacc[4];
#pragma unroll
    for (int i = 0; i < 4; ++i) Sacc[i] = (f32x4){0.f, 0.f, 0.f, 0.f};
    for (int i = tid; i < 64 * PQ / 16; i += 512) *(u32x4*)(ST + i * 16) = (u32x4){0, 0, 0, 0};
    u32x4 gq0, gq1, gz0, gz1, gv;
    { const int o0 = base0 + rsb * lr0, o1 = base0 + rsb * (lr0 + 32);
      gq0 = *(const GAS u32x4*)(bigc + (size_t)(unsigned)(o0 + qcol)); gq1 = *(const GAS u32x4*)(bigc + (size_t)(unsigned)(o1 + qcol));
      gz0 = *(const GAS u32x4*)(bigc + (size_t)(unsigned)(o0 + zcol)); gz1 = *(const GAS u32x4*)(bigc + (size_t)(unsigned)(o1 + zcol));
      gv = *(const GAS u32x4*)(bigc + (size_t)(unsigned)(base0 + rsb * vr + vcol)); }
    for (int c = 0; c < SEQ / 64; ++c) {
      const int pb = c & 1;
      *(u32x4*)(RQ + lr0 * PQ + lc8 * 2) = gq0; *(u32x4*)(RQ + (lr0 + 32) * PQ + lc8 * 2) = gq1;
      *(u32x4*)(RZ + lr0 * PQ + lc8 * 2) = gz0; *(u32x4*)(RZ + (lr0 + 32) * PQ + lc8 * 2) = gz1;
      *(u32x4*)(RV + vr * PJ + vc8 * 2) = gv;
      __syncthreads();
      float qf[16], kk[16], cl[16]; float run = 0.f;
#pragma unroll
      for (int i = 0; i < 16; ++i) { const int t = 16 * rq + i; const float z = bf2f(*(const unsigned short*)(RZ + t * PQ + k * 2)); qf[i] = bf2f(*(const unsigned short*)(RQ + t * PQ + k * 2));
        const float sg = __builtin_amdgcn_rcpf(1.0f + __builtin_amdgcn_exp2f(-L2E * z)); const float f = lbk + (1.0f - lbk) * sg;
        run += __builtin_amdgcn_logf(f); cl[i] = run; kk[i] = 1.0f - f; }
      TOT[rq * 128 + k] = run;
      unsigned short rvv[8];
#pragma unroll
      for (int i = 0; i < 8; ++i) rvv[i] = *(const unsigned short*)(RV + (8 * jg + i) * PJ + vv * 2);
      u32x4 vpk; vpk.x = rvv[0] | ((unsigned)rvv[1] << 16); vpk.y = rvv[2] | ((unsigned)rvv[3] << 16); vpk.z = rvv[4] | ((unsigned)rvv[5] << 16); vpk.w = rvv[6] | ((unsigned)rvv[7] << 16);
      __syncthreads();
      { const float t0 = TOT[k], t1 = TOT[128 + k], t2 = TOT[256 + k], t3 = TOT[384 + k];
        const float mid = t0 + t1, last = (t0 + t1) + (t2 + t3);
        const float off = (rq == 0) ? 0.f : (rq == 1) ? t0 : (rq == 2) ? (t0 + t1) : (t0 + t1 + t2);
        const float el = __builtin_amdgcn_exp2f(last), em = __builtin_amdgcn_exp2f(fminf(-mid, 120.f)), emi = __builtin_amdgcn_exp2f(mid);
        if (rq == 0) DD[k] = el;
        unsigned ksw[8];
#pragma unroll
        for (int i = 0; i < 16; ++i) { const float cc = off + cl[i];
          const float e1 = __builtin_amdgcn_exp2f(cc), inv1 = __builtin_amdgcn_exp2f(fminf(-cc, 120.f));
          const float ea = fminf(e1 * em, 3.6e16f);
          const float eb = fminf(inv1 * emi, 3.6e16f);
          const float es = fminf(inv1 * el, 1.0f);
          const int t = 16 * rq + i;
          const unsigned w0 = cvtpk(qf[i] * e1, qf[i] * ea), w1 = cvtpk(kk[i] * eb, kk[i] * es);
          *(unsigned short*)(QD + t * PQ + k * 2) = (unsigned short)(w0 & 0xffffu);
          *(unsigned short*)(QA + t * PQ + k * 2) = (unsigned short)(w0 >> 16);
          *(unsigned short*)(KB + t * PQ + k * 2) = (unsigned short)(w1 & 0xffffu);
          if (i & 1) ksw[i >> 1] |= (w1 & 0xffff0000u); else ksw[i >> 1] = (w1 >> 16); }
        *(u32x4*)(KS + k * PJ + rq * 32) = (u32x4){ksw[0], ksw[1], ksw[2], ksw[3]};
        *(u32x4*)(KS + k * PJ + rq * 32 + 16) = (u32x4){ksw[4], ksw[5], ksw[6], ksw[7]};
        *(u32x4*)(VT + vv * PJ + jg * 16) = vpk; }
      __syncthreads();
      if (c + 1 < SEQ / 64) { const int bc = base0 + rsb * 64 * (c + 1); const int o0 = bc + rsb * lr0, o1 = bc + rsb * (lr0 + 32);
        gq0 = *(const GAS u32x4*)(bigc + (size_t)(unsigned)(o0 + qcol)); gq1 = *(const GAS u32x4*)(bigc + (size_t)(unsigned)(o1 + qcol));
        gz0 = *(const GAS u32x4*)(bigc + (size_t)(unsigned)(o0 + zcol)); gz1 = *(const GAS u32x4*)(bigc + (size_t)(unsigned)(o1 + zcol));
        gv = *(const GAS u32x4*)(bigc + (size_t)(unsigned)(bc + rsb * vr + vcol)); }
#define HWAIT() do { asm volatile("s_waitcnt lgkmcnt(0)" ::: "memory"); __builtin_amdgcn_sched_barrier(0); } while (0)
      f32x4 oacc[2];
      { const int jt = wave >> 1, ttA = 2 * (wave & 1), ttO = wave >> 1, vtO = 2 * (wave & 1); const char* STp = ST + pb * (64 * PQ);
        bf16x8 fa[4], fb0[4], fb1[4], fq[4], fs0[4], fs1[4];
#pragma unroll
        for (int ks = 0; ks < 4; ++ks) { fa[ks] = ldfrag(KB, 16 * jt + fr, PQ, ks * 32 + fq_ * 8); fb0[ks] = ldfrag(QA, 16 * ttA + fr, PQ, ks * 32 + fq_ * 8); fb1[ks] = ldfrag(QA, 16 * (ttA + 1) + fr, PQ, ks * 32 + fq_ * 8);
          fq[ks] = ldfrag(QD, 16 * ttO + fr, PQ, ks * 32 + fq_ * 8); fs0[ks] = ldfrag(STp, 16 * vtO + fr, PQ, ks * 32 + fq_ * 8); fs1[ks] = ldfrag(STp, 16 * (vtO + 1) + fr, PQ, ks * 32 + fq_ * 8); }
        HWAIT();
        f32x4 acc0 = (f32x4){0.f, 0.f, 0.f, 0.f}, acc1 = acc0; oacc[0] = acc0; oacc[1] = acc0;
#pragma unroll
        for (int ks = 0; ks < 4; ++ks) {
          if (jt <= ttA) acc0 = __builtin_amdgcn_mfma_f32_16x16x32_bf16(fa[ks], fb0[ks], acc0, 0, 0, 0);
          if (jt <= ttA + 1) acc1 = __builtin_amdgcn_mfma_f32_16x16x32_bf16(fa[ks], fb1[ks], acc1, 0, 0, 0);
          oacc[0] = __builtin_amdgcn_mfma_f32_16x16x32_bf16(fq[ks], fs0[ks], oacc[0], 0, 0, 0);
          oacc[1] = __builtin_amdgcn_mfma_f32_16x16x32_bf16(fq[ks], fs1[ks], oacc[1], 0, 0, 0); }
        { const int j0 = 16 * jt + 4 * fq_;
          { const int tcol = 16 * ttA + fr; u32x2 w; w.x = cvtpk_c(j0 + 0 <= tcol ? acc0[0] : 0.f, j0 + 1 <= tcol ? acc0[1] : 0.f); w.y = cvtpk_c(j0 + 2 <= tcol ? acc0[2] : 0.f, j0 + 3 <= tcol ? acc0[3] : 0.f);
            *(u32x2*)(PP + tcol * PJ + j0 * 2) = w; }
          { const int tcol = 16 * (ttA + 1) + fr; u32x2 w; w.x = cvtpk_c(j0 + 0 <= tcol ? acc1[0] : 0.f, j0 + 1 <= tcol ? acc1[1] : 0.f); w.y = cvtpk_c(j0 + 2 <= tcol ? acc1[2] : 0.f, j0 + 3 <= tcol ? acc1[3] : 0.f);
            *(u32x2*)(PP + tcol * PJ + j0 * 2) = w; } } }
      { const f32x4 d4 = *(const f32x4*)(DD + 16 * wave + 4 * fq_); char* STn = ST + (pb ^ 1) * (64 * PQ);
        const bf16x8 a0 = ldfrag(KS, 16 * wave + fr, PJ, fq_ * 8), a1 = ldfrag(KS, 16 * wave + fr, PJ, 32 + fq_ * 8);
        bf16x8 v0[4], v1[4];
#pragma unroll
        for (int vt = 0; vt < 4; ++vt) { v0[vt] = ldfrag(VT, 16 * vt + fr, PJ, fq_ * 8); v1[vt] = ldfrag(VT, 16 * vt + fr, PJ, 32 + fq_ * 8); }
        HWAIT();
#pragma unroll
        for (int vt = 0; vt < 4; ++vt) { Sacc[vt] = Sacc[vt] * d4;
          Sacc[vt] = __builtin_amdgcn_mfma_f32_16x16x32_bf16(a0, v0[vt], Sacc[vt], 0, 0, 0);
          Sacc[vt] = __builtin_amdgcn_mfma_f32_16x16x32_bf16(a1, v1[vt], Sacc[vt], 0, 0, 0); }
#pragma unroll
        for (int vt = 0; vt < 4; ++vt) { u32x2 w; w.x = cvtpk_c(Sacc[vt][0], Sacc[vt][1]); w.y = cvtpk_c(Sacc[vt][2], Sacc[vt][3]);
          *(u32x2*)(STn + (16 * vt + fr) * PQ + (16 * wave + 4 * fq_) * 2) = w; } }
      __syncthreads();
      { const int tt = wave >> 1, vt0 = 2 * (wave & 1);
        bf16x8 pf[2], vf0[2], vf1[2];
#pragma unroll
        for (int ks = 0; ks < 2; ++ks) { pf[ks] = ldfrag(PP, 16 * tt + fr, PJ, ks * 32 + fq_ * 8); vf0[ks] = ldfrag(VT, 16 * vt0 + fr, PJ, ks * 32 + fq_ * 8); vf1[ks] = ldfrag(VT, 16 * (vt0 + 1) + fr, PJ, ks * 32 + fq_ * 8); }
        HWAIT();
#pragma unroll
        for (int ks = 0; ks < 2; ++ks) { oacc[0] = __builtin_amdgcn_mfma_f32_16x16x32_bf16(pf[ks], vf0[ks], oacc[0], 0, 0, 0); oacc[1] = __builtin_amdgcn_mfma_f32_16x16x32_bf16(pf[ks], vf1[ks], oacc[1], 0, 0, 0); }
#pragma unroll
        for (int n = 0; n < 2; ++n) { const int oo = obase + osb * (64 * c + 16 * tt + 4 * fq_) + (16 * (vt0 + n) + fr) * 2;
#pragma unroll
          for (int i = 0; i < 4; ++i) *(GAS unsigned short*)(ohgc + (size_t)(unsigned)(oo + osb * i)) = (unsigned short)(cvtpk_c(oacc[n][i], 0.f) & 0xffffu); } }
#undef HWAIT
    }
    __syncthreads();
  }
}
}


namespace hg3 {
constexpr int PK = 144, PJ = 144, PV = 272;
constexpr int OFF_QD = 0, OFF_QA = 9216, OFF_KB = 18432, OFF_KS = 27648, OFF_VT = 36864, OFF_P = 55296, OFF_ST = 64512, OFF_TOT = 101376, OFF_D = 103424, OFF_END = 103680;
constexpr float L2E = 1.4426950408889634f;
__device__ __forceinline__ bf16x8 ldfrag(const char* base, int row, int pitch, int koff) { return *(const bf16x8*)(base + row * pitch + koff * 2); }
__device__ __forceinline__ void hgrn_phase(const Params& p, int e, char* lds) {
  int tid_ = threadIdx.x; asm volatile("" : "+v"(tid_));
  const int tid = tid_, wave = tid >> 6, lane = tid & 63, fr = lane & 15, fq_ = lane >> 4;
  const char* bigc = (const char*)(p.ws + WS_BIG);
  char* ohgc = (char*)p.out;
  char* QD = lds + OFF_QD; char* QA = lds + OFF_QA; char* KB = lds + OFF_KB; char* KS = lds + OFF_KS; char* VT = lds + OFF_VT; char* PP = lds + OFF_P; char* ST = lds + OFF_ST;
  char* RQ = QD; char* RZ = QA; char* RV = KB;
  float* TOT = (float*)(lds + OFF_TOT); float* DD = (float*)(lds + OFF_D);
  const int k = tid & 63, rq = tid >> 6;
  const int vv = tid & 127, jg = tid >> 7;
  const int lr = tid >> 3, lc8 = (tid & 7) * 8;
  const int vr = tid >> 4, vc8 = (tid & 15) * 8;
  for (int u = blockIdx.x; u < 256; u += gridDim.x) {
    const int kh = u & 1, dir = (u >> 1) & 1, h = (u >> 2) & 3, b = u >> 4;
    float lbk = 0.f;
    if (e != 0) { const float* lbsrc = dir ? p.lb_bwd : p.lb_fwd; const float a0 = lbsrc[h * 128 + kh * 64 + k], a1 = lbsrc[512 + h * 128 + kh * 64 + k]; lbk = 1.0f / (1.0f + __expf(a0 - a1)); }
    const int rsb = dir ? -8192 : 8192;
    const int base0 = (b * SEQ + (dir ? (SEQ - 1) : 0)) * 8192;
    const int qcol = (1536 + h * 128 + kh * 64 + lc8) * 2, zcol = ((dir ? 2560 : 2048) + h * 128 + kh * 64 + lc8) * 2, vcol = (3072 + h * 128 + vc8) * 2;
    const int osb = dir ? -1024 : 1024;
    const int obase = (dir * 2 + kh) * (T * 1024) + (b * SEQ + (dir ? (SEQ - 1) : 0)) * 1024 + h * 256;
    f32x4 Sacc[4];
#pragma unroll
    for (int i = 0; i < 4; ++i) Sacc[i] = (f32x4){0.f, 0.f, 0.f, 0.f};
    for (int i = tid; i < 128 * PK / 16; i += 512) *(u32x4*)(ST + i * 16) = (u32x4){0, 0, 0, 0};
    u32x4 gq, gz, gv0, gv1;
    { const int o0 = base0 + rsb * lr;
      gq = *(const GAS u32x4*)(bigc + (size_t)(unsigned)(o0 + qcol)); gz = *(const GAS u32x4*)(bigc + (size_t)(unsigned)(o0 + zcol));
      gv0 = *(const GAS u32x4*)(bigc + (size_t)(unsigned)(base0 + rsb * vr + vcol)); gv1 = *(const GAS u32x4*)(bigc + (size_t)(unsigned)(base0 + rsb * (vr + 32) + vcol)); }
    for (int c = 0; c < SEQ / 64; ++c) {
      const int pb = c & 1;
      *(u32x4*)(RQ + lr * PK + lc8 * 2) = gq; *(u32x4*)(RZ + lr * PK + lc8 * 2) = gz;
      *(u32x4*)(RV + vr * PV + vc8 * 2) = gv0; *(u32x4*)(RV + (vr + 32) * PV + vc8 * 2) = gv1;
      __syncthreads();
      float qf[8], kk[8], cl[8]; float run = 0.f;
#pragma unroll
      for (int i = 0; i < 8; ++i) { const int t = 8 * rq + i; const float z = bf2f(*(const unsigned short*)(RZ + t * PK + k * 2)); qf[i] = bf2f(*(const unsigned short*)(RQ + t * PK + k * 2));
        const float sg = __builtin_amdgcn_rcpf(1.0f + __builtin_amdgcn_exp2f(-L2E * z)); const float f = lbk + (1.0f - lbk) * sg;
        run += __builtin_amdgcn_logf(f); cl[i] = run; kk[i] = 1.0f - f; }
      TOT[rq * 64 + k] = run;
      unsigned short rvv[16];
#pragma unroll
      for (int i = 0; i < 16; ++i) rvv[i] = *(const unsigned short*)(RV + (16 * jg + i) * PV + vv * 2);
      u32x4 vpa, vpb;
      vpa.x = rvv[0] | ((unsigned)rvv[1] << 16); vpa.y = rvv[2] | ((unsigned)rvv[3] << 16); vpa.z = rvv[4] | ((unsigned)rvv[5] << 16); vpa.w = rvv[6] | ((unsigned)rvv[7] << 16);
      vpb.x = rvv[8] | ((unsigned)rvv[9] << 16); vpb.y = rvv[10] | ((unsigned)rvv[11] << 16); vpb.z = rvv[12] | ((unsigned)rvv[13] << 16); vpb.w = rvv[14] | ((unsigned)rvv[15] << 16);
      __syncthreads();
      { float tt[8];
#pragma unroll
        for (int r8 = 0; r8 < 8; ++r8) tt[r8] = TOT[r8 * 64 + k];
        const float mid = (tt[0] + tt[1]) + (tt[2] + tt[3]), last = mid + ((tt[4] + tt[5]) + (tt[6] + tt[7]));
        float off = 0.f;
#pragma unroll
        for (int r8 = 0; r8 < 7; ++r8) off += (r8 < rq) ? tt[r8] : 0.f;
        const float el = __builtin_amdgcn_exp2f(last), em = __builtin_amdgcn_exp2f(fminf(-mid, 120.f)), emi = __builtin_amdgcn_exp2f(mid);
        if (rq == 0) DD[k] = el;
        unsigned ksw[4];
#pragma unroll
        for (int i = 0; i < 8; ++i) { const float cc = off + cl[i];
          const float e1 = __builtin_amdgcn_exp2f(cc), inv1 = __builtin_amdgcn_exp2f(fminf(-cc, 120.f));
          const float ea = fminf(e1 * em, 3.6e16f), eb = fminf(inv1 * emi, 3.6e16f), es = fminf(inv1 * el, 1.0f);
          const int t = 8 * rq + i;
          const unsigned w0 = cvtpk(qf[i] * e1, qf[i] * ea), w1 = cvtpk(kk[i] * eb, kk[i] * es);
          *(unsigned short*)(QD + t * PK + k * 2) = (unsigned short)(w0 & 0xffffu);
          *(unsigned short*)(QA + t * PK + k * 2) = (unsigned short)(w0 >> 16);
          *(unsigned short*)(KB + t * PK + k * 2) = (unsigned short)(w1 & 0xffffu);
          if (i & 1) ksw[i >> 1] |= (w1 & 0xffff0000u); else ksw[i >> 1] = (w1 >> 16); }
        *(u32x4*)(KS + k * PJ + rq * 16) = (u32x4){ksw[0], ksw[1], ksw[2], ksw[3]};
        *(u32x4*)(VT + vv * PJ + jg * 32) = vpa; *(u32x4*)(VT + vv * PJ + jg * 32 + 16) = vpb; }
      __syncthreads();
      if (c + 1 < SEQ / 64) { const int bc = base0 + rsb * 64 * (c + 1); const int o0 = bc + rsb * lr;
        gq = *(const GAS u32x4*)(bigc + (size_t)(unsigned)(o0 + qcol)); gz = *(const GAS u32x4*)(bigc + (size_t)(unsigned)(o0 + zcol));
        gv0 = *(const GAS u32x4*)(bigc + (size_t)(unsigned)(bc + rsb * vr + vcol)); gv1 = *(const GAS u32x4*)(bigc + (size_t)(unsigned)(bc + rsb * (vr + 32) + vcol)); }
#define HWAIT() do { asm volatile("s_waitcnt lgkmcnt(0)" ::: "memory"); __builtin_amdgcn_sched_barrier(0); } while (0)
      f32x4 oacc[4];
      const int wq = wave >> 1, vt0 = 4 * (wave & 1);
      { const int ttA = 2 * (wave & 1); const char* STp = ST + pb * (128 * PK);
        bf16x8 fa[2], fb0[2], fb1[2], fqd[2], fs[4][2];
#pragma unroll
        for (int ks = 0; ks < 2; ++ks) { fa[ks] = ldfrag(KB, 16 * wq + fr, PK, ks * 32 + fq_ * 8); fb0[ks] = ldfrag(QA, 16 * ttA + fr, PK, ks * 32 + fq_ * 8); fb1[ks] = ldfrag(QA, 16 * (ttA + 1) + fr, PK, ks * 32 + fq_ * 8);
          fqd[ks] = ldfrag(QD, 16 * wq + fr, PK, ks * 32 + fq_ * 8);
#pragma unroll
          for (int n = 0; n < 4; ++n) fs[n][ks] = ldfrag(STp, 16 * (vt0 + n) + fr, PK, ks * 32 + fq_ * 8); }
        HWAIT();
        f32x4 acc0 = (f32x4){0.f, 0.f, 0.f, 0.f}, acc1 = acc0;
#pragma unroll
        for (int n = 0; n < 4; ++n) oacc[n] = acc0;
#pragma unroll
        for (int ks = 0; ks < 2; ++ks) {
          if (wq <= ttA) acc0 = __builtin_amdgcn_mfma_f32_16x16x32_bf16(fa[ks], fb0[ks], acc0, 0, 0, 0);
          if (wq <= ttA + 1) acc1 = __builtin_amdgcn_mfma_f32_16x16x32_bf16(fa[ks], fb1[ks], acc1, 0, 0, 0);
#pragma unroll
          for (int n = 0; n < 4; ++n) oacc[n] = __builtin_amdgcn_mfma_f32_16x16x32_bf16(fqd[ks], fs[n][ks], oacc[n], 0, 0, 0); }
        { const int j0 = 16 * wq + 4 * fq_;
          { const int tcol = 16 * ttA + fr; u32x2 w; w.x = cvtpk_c(j0 + 0 <= tcol ? acc0[0] : 0.f, j0 + 1 <= tcol ? acc0[1] : 0.f); w.y = cvtpk_c(j0 + 2 <= tcol ? acc0[2] : 0.f, j0 + 3 <= tcol ? acc0[3] : 0.f);
            *(u32x2*)(PP + tcol * PJ + j0 * 2) = w; }
          { const int tcol = 16 * (ttA + 1) + fr; u32x2 w; w.x = cvtpk_c(j0 + 0 <= tcol ? acc1[0] : 0.f, j0 + 1 <= tcol ? acc1[1] : 0.f); w.y = cvtpk_c(j0 + 2 <= tcol ? acc1[2] : 0.f, j0 + 3 <= tcol ? acc1[3] : 0.f);
            *(u32x2*)(PP + tcol * PJ + j0 * 2) = w; } } }
      { const f32x4 d4 = *(const f32x4*)(DD + 16 * wq + 4 * fq_); char* STn = ST + (pb ^ 1) * (128 * PK);
        const bf16x8 a0 = ldfrag(KS, 16 * wq + fr, PJ, fq_ * 8), a1 = ldfrag(KS, 16 * wq + fr, PJ, 32 + fq_ * 8);
        bf16x8 v0[4], v1[4];
#pragma unroll
        for (int n = 0; n < 4; ++n) { v0[n] = ldfrag(VT, 16 * (vt0 + n) + fr, PJ, fq_ * 8); v1[n] = ldfrag(VT, 16 * (vt0 + n) + fr, PJ, 32 + fq_ * 8); }
        HWAIT();
#pragma unroll
        for (int n = 0; n < 4; ++n) { Sacc[n] = Sacc[n] * d4;
          Sacc[n] = __builtin_amdgcn_mfma_f32_16x16x32_bf16(a0, v0[n], Sacc[n], 0, 0, 0);
          Sacc[n] = __builtin_amdgcn_mfma_f32_16x16x32_bf16(a1, v1[n], Sacc[n], 0, 0, 0); }
#pragma unroll
        for (int n = 0; n < 4; ++n) { u32x2 w; w.x = cvtpk_c(Sacc[n][0], Sacc[n][1]); w.y = cvtpk_c(Sacc[n][2], Sacc[n][3]);
          *(u32x2*)(STn + (16 * (vt0 + n) + fr) * PK + (16 * wq + 4 * fq_) * 2) = w; } }
      __syncthreads();
      { bf16x8 pf[2], vf[4][2];
#pragma unroll
        for (int ks = 0; ks < 2; ++ks) { pf[ks] = ldfrag(PP, 16 * wq + fr, PJ, ks * 32 + fq_ * 8);
#pragma unroll
          for (int n = 0; n < 4; ++n) vf[n][ks] = ldfrag(VT, 16 * (vt0 + n) + fr, PJ, ks * 32 + fq_ * 8); }
        HWAIT();
#pragma unroll
        for (int ks = 0; ks < 2; ++ks)
#pragma unroll
          for (int n = 0; n < 4; ++n) oacc[n] = __builtin_amdgcn_mfma_f32_16x16x32_bf16(pf[ks], vf[n][ks], oacc[n], 0, 0, 0);
#pragma unroll
        for (int n = 0; n < 4; ++n) { const int oo = obase + osb * (64 * c + 16 * wq + 4 * fq_) + (16 * (vt0 + n) + fr) * 2;
#pragma unroll
          for (int i = 0; i < 4; ++i) *(GAS unsigned short*)(ohgc + (size_t)(unsigned)(oo + osb * i)) = (unsigned short)(cvtpk_c(oacc[n][i], 0.f) & 0xffffu); } }
#undef HWAIT
    }
    __syncthreads();
  }
}
}

namespace sgu {
constexpr int VT_PITCH = 272;
constexpr int OFF_VT = 0, OFF_RS = 128 * VT_PITCH, OFF_END = OFF_RS + 512;
__device__ __forceinline__ void sgu_phase(const Params& p, int o, char* lds) {
  int tid_ = threadIdx.x; asm volatile("" : "+v"(tid_));
  const int tid = tid_, wave = tid >> 6, lane = tid & 63, fr = lane & 15, quad = lane >> 4;
  const int wr = wave >> 1, wc = wave & 1;
  const bf16* big = (const bf16*)(p.ws + WS_BIG); bf16* mix = (bf16*)(p.ws + WS_MIX);
  const bf16* Wb = (const bf16*)(p.ws + WS_W) + W_SGW + (size_t)o * 8 * 128 * 128;
  const unsigned long long* vss = (const unsigned long long*)(p.ws + WS_SS) + (size_t)(9 + o) * T;
  float* rs = (float*)(lds + OFF_RS);
  const int NU = 512 * 8, G = gridDim.x;
  const bool gfix = (G & 7) == 0;
  u32x4 wraw[4][2]; f32x4 gainv[4]; float biasv[2]; int gcur = -1;
  const int sq0 = tid >> 4, sc8 = (tid & 15) * 8;
  u32x4 vst[4];
  int u = blockIdx.x;
  if (u < NU) { const int g = u & 7; const size_t T0 = (size_t)(u >> 3) * 128;
#pragma unroll
    for (int i = 0; i < 4; ++i) vst[i] = *(const GAS u32x4*)(big + (T0 + sq0 + 32 * i) * 2048 + 1024 + g * 128 + sc8); }
  for (; u < NU; u += G) {
    const int g = u & 7, n = u >> 3; const size_t T0 = (size_t)n * 128;
    if (g != gcur) { gcur = g;
#pragma unroll
      for (int kq = 0; kq < 4; ++kq)
#pragma unroll
        for (int nt = 0; nt < 2; ++nt) wraw[kq][nt] = *(const GAS u32x4*)(Wb + ((size_t)g * 128 + wr * 32 + nt * 16 + fr) * 128 + kq * 32 + quad * 8);
#pragma unroll
      for (int mt = 0; mt < 4; ++mt) gainv[mt] = *(const f32x4*)(p.sg_norm + o * 1024 + g * 128 + wc * 64 + mt * 16 + 4 * quad);
#pragma unroll
      for (int nt = 0; nt < 2; ++nt) biasv[nt] = p.sg_b[(o * 8 + g) * 128 + wr * 32 + nt * 16 + fr]; }
    u32x2 uw[2][4];
#pragma unroll
    for (int nt = 0; nt < 2; ++nt)
#pragma unroll
      for (int mt = 0; mt < 4; ++mt) uw[nt][mt] = *(const GAS u32x2*)(big + (T0 + wr * 32 + nt * 16 + fr) * 2048 + g * 128 + wc * 64 + mt * 16 + 4 * quad);
    __syncthreads();
#pragma unroll
    for (int i = 0; i < 4; ++i) { const int q = sq0 + 32 * i; const u32x4 w = vst[i];
      unsigned short* d = (unsigned short*)(lds + OFF_VT + (sc8) * VT_PITCH + q * 2);
      d[0 * (VT_PITCH / 2)] = (unsigned short)(w.x & 0xffffu); d[1 * (VT_PITCH / 2)] = (unsigned short)(w.x >> 16);
      d[2 * (VT_PITCH / 2)] = (unsigned short)(w.y & 0xffffu); d[3 * (VT_PITCH / 2)] = (unsigned short)(w.y >> 16);
      d[4 * (VT_PITCH / 2)] = (unsigned short)(w.z & 0xffffu); d[5 * (VT_PITCH / 2)] = (unsigned short)(w.z >> 16);
      d[6 * (VT_PITCH / 2)] = (unsigned short)(w.w & 0xffffu); d[7 * (VT_PITCH / 2)] = (unsigned short)(w.w >> 16); }
    if (tid < 128) rs[tid] = __builtin_amdgcn_rsqf(pg8::ss2f(vss[T0 + tid]) * (1.0f / 1024.0f) + EPS);
    __syncthreads();
    if (u + G < NU) { const int g2 = (u + G) & 7; const size_t T2 = (size_t)((u + G) >> 3) * 128;
#pragma unroll
      for (int i = 0; i < 4; ++i) vst[i] = *(const GAS u32x4*)(big + (T2 + sq0 + 32 * i) * 2048 + 1024 + g2 * 128 + sc8); }
    f32x4 acc[4][2];
#pragma unroll
    for (int mt = 0; mt < 4; ++mt)
#pragma unroll
      for (int nt = 0; nt < 2; ++nt) acc[mt][nt] = (f32x4){0.f, 0.f, 0.f, 0.f};
#pragma unroll
    for (int kq = 0; kq < 4; ++kq) {
      const f32x4 r0 = *(const f32x4*)(rs + kq * 32 + quad * 8), r1 = *(const f32x4*)(rs + kq * 32 + quad * 8 + 4);
      bf16x8 wf[2];
#pragma unroll
      for (int nt = 0; nt < 2; ++nt) { const u32x4 w = wraw[kq][nt];
        u32x4 s; s.x = cvtpk(bflo(w.x) * r0[0], bfhi(w.x) * r0[1]); s.y = cvtpk(bflo(w.y) * r0[2], bfhi(w.y) * r0[3]); s.z = cvtpk(bflo(w.z) * r1[0], bfhi(w.z) * r1[1]); s.w = cvtpk(bflo(w.w) * r1[2], bfhi(w.w) * r1[3]);
        wf[nt] = __builtin_bit_cast(bf16x8, s); }
#pragma unroll
      for (int mt = 0; mt < 4; ++mt) { const bf16x8 vf = *(const bf16x8*)(lds + OFF_VT + (wc * 64 + mt * 16 + fr) * VT_PITCH + (kq * 32 + quad * 8) * 2);
#pragma unroll
        for (int nt = 0; nt < 2; ++nt) acc[mt][nt] = __builtin_amdgcn_mfma_f32_16x16x32_bf16(vf, wf[nt], acc[mt][nt], 0, 0, 0); }
    }
#pragma unroll
    for (int nt = 0; nt < 2; ++nt) { const int pp = wr * 32 + nt * 16 + fr;
#pragma unroll
      for (int mt = 0; mt < 4; ++mt) { const int c = g * 128 + wc * 64 + mt * 16 + 4 * quad; const u32x2 uu = uw[nt][mt];
        const f32x4 v = (f32x4){bflo(uu.x), bfhi(uu.x), bflo(uu.y), bfhi(uu.y)} * (gainv[mt] * acc[mt][nt] + biasv[nt]);
        u32x2 ow; ow.x = cvtpk(v[0], v[1]); ow.y = cvtpk(v[2], v[3]);
        *(GAS u32x2*)(mix + (T0 + pp) * 1024 + c) = ow; } }
  }
  (void)gfix;
}
}

#define XB_TMO      128
#define XB_XCNT(j)  (256  + 64 * (j))
#define XB_XSUB(j)  (1280 + 64 * (j))
#define XB_XGEN(j)  (2304 + 64 * (j))
#define XB_TOP      3328
#define XB_TOPGEN   3392
#define XCD_BAR_WORDS 3456
#define XB_SPIN_CAP (1u << 18)

__device__ __forceinline__ unsigned xb_ld(unsigned* p)              { return __hip_atomic_load(p, __ATOMIC_RELAXED, __HIP_MEMORY_SCOPE_AGENT); }
__device__ __forceinline__ unsigned xb_add(unsigned* p, unsigned v) { return __hip_atomic_fetch_add(p, v, __ATOMIC_RELAXED, __HIP_MEMORY_SCOPE_AGENT); }
__device__ __forceinline__ unsigned xb_xcc_id() { return (unsigned)__builtin_amdgcn_s_getreg((3 << 11) | 20) & 0xFu; }
#define XB_SPIN(cond, bar) do { unsigned _sp = 0; while (cond) { __builtin_amdgcn_s_sleep(1); \
    if ((++_sp & 255u) == 0u) { if (xb_ld(&(bar)[XB_TMO])) break; if (_sp > XB_SPIN_CAP) { atomicAdd(&(bar)[XB_TMO], 1u); break; } } } } while (0)

struct XcdBarrier {
    unsigned* bar; unsigned x;
    volatile LAS unsigned* st;
};

__device__ __forceinline__ XcdBarrier xcd_barrier_post(unsigned* bar, volatile LAS unsigned* st) {
    XcdBarrier b; b.bar = bar; b.x = xb_xcc_id(); b.st = st;
    if (threadIdx.x == 0) (void)xb_add(&bar[XB_XCNT(b.x)], 1u);
    return b;
}
__device__ __forceinline__ void xcd_barrier_complete(unsigned* bar, unsigned x, unsigned& nloc, unsigned& nx) {
    const unsigned G = gridDim.x * gridDim.y * gridDim.z;
    unsigned sum, cnt, mine, sp = 0u;
    for (;;) {
        sum = 0u; cnt = 0u; mine = 0u;
#pragma unroll
        for (unsigned j = 0; j < 16; ++j) { const unsigned c = xb_ld(&bar[XB_XCNT(j)]); sum += c; cnt += (c > 0u) ? 1u : 0u; mine = (j == x) ? c : mine; }
        if (sum == G) break;
        __builtin_amdgcn_s_sleep(1);
        if ((++sp & 255u) == 0u) { if (xb_ld(&bar[XB_TMO])) break; if (sp > XB_SPIN_CAP) { atomicAdd(&bar[XB_TMO], 1u); break; } }
    }
    nloc = mine > 0u ? mine : 1u; nx = cnt > 0u ? cnt : 1u;
}

__device__ __forceinline__ void xcd_barrier(const XcdBarrier& b) {
    asm volatile("s_waitcnt vmcnt(0)" ::: "memory");
    __syncthreads();
    if (threadIdx.x == 0) {
        unsigned* bar = b.bar;
        __builtin_amdgcn_s_waitcnt(0);
        unsigned nloc = b.st[0], nx = b.st[1];
        if (nloc == 0u) { xcd_barrier_complete(bar, b.x, nloc, nx); b.st[0] = nloc; b.st[1] = nx; }
        const unsigned old = xb_add(&bar[XB_XSUB(b.x)], 1u);
        const unsigned gen = old / nloc;
        if (old + 1u == (gen + 1u) * nloc) {
            __builtin_amdgcn_fence(__ATOMIC_RELEASE, "agent");
            asm volatile("s_waitcnt vmcnt(0)" ::: "memory");
            const unsigned og = xb_add(&bar[XB_TOP], 1u);
            const unsigned tg = og / nx;
            if (og + 1u == (tg + 1u) * nx) xb_add(&bar[XB_TOPGEN], 1u);
            else XB_SPIN(xb_ld(&bar[XB_TOPGEN]) == tg, bar);
            __builtin_amdgcn_fence(__ATOMIC_ACQUIRE, "agent");
            xb_add(&bar[XB_XGEN(b.x)], 1u);
            asm volatile("s_waitcnt vmcnt(0)" ::: "memory");
        } else {
            XB_SPIN(xb_ld(&bar[XB_XGEN(b.x)]) == gen, bar);
            __builtin_amdgcn_fence(__ATOMIC_ACQUIRE, "agent");
            asm volatile("s_waitcnt vmcnt(0)" ::: "memory");
        }
    }
    __syncthreads();
}

constexpr int NPHASE = 24;
__global__ void __launch_bounds__(512, 2) mega_fwd(Params pin) {
    extern __shared__ __attribute__((aligned(16))) unsigned char lds_raw[];
    PG8_LAS unsigned char* lds = (PG8_LAS unsigned char*)lds_raw;
    const int G = gridDim.x, c = blockIdx.x;
    volatile LAS unsigned* bst = (volatile LAS unsigned*)(lds + (LDS_BYTES - 64));
    if (threadIdx.x < 2) bst[threadIdx.x] = 0u;
    __syncthreads();
    const XcdBarrier xbar = xcd_barrier_post((unsigned*)(pin.ws + WS_BAR), bst);
    for (int ph = pin.ph_lo; ph < pin.ph_hi; ++ph) {
        Params p = pin;
        { unsigned long long w = (unsigned long long)pin.ws, o = (unsigned long long)pin.out; asm volatile("" : "+s"(w), "+s"(o)); p.ws = (unsigned char*)w; p.out = (float*)o; }
        unsigned char* ws = p.ws;
        bf16* WB = (bf16*)(ws + WS_W);
        bf16* hb = (bf16*)(ws + WS_HB); bf16* mix = (bf16*)(ws + WS_MIX); bf16* big = (bf16*)(ws + WS_BIG);
        unsigned long long* SS = (unsigned long long*)(ws + WS_SS);
        if (ph == 0) prologue_phase(p, lds);
        else if (ph == 23) final_phase(p);
        else {
            const int li = (ph - 1) / 11, r = (ph - 1) % 11;
            const int l = (r < 6) ? 2 * li : 2 * li + 1;
            if (r == 0) { pg8::Gemm g{hb, WB + W_INE + (size_t)li * 4096 * 1024, T, 4096, 1024}; pg8::StaticOrder S; S.init(T, 4096, G, c);
                pg8::EpiEvenIn E{big, SS + (size_t)(2 * l) * T}; pg8::gemm_phase<pg8::EpiEvenIn, pg8::StaticOrder, true, true>(lds, g, S, E); }
            else if (r == 1) { hg3::hgrn_phase(p, li, (char*)lds_raw); att::attn_phase(p, li, (char*)lds_raw); }
            else if (r == 2) { hg::hgpost_phase(p, li); }
            else if (r == 3 || r == 8) { const bf16* Wt = (r == 3) ? WB + W_OUTE + (size_t)li * 1024 * 1024 : WB + W_OUTO + (size_t)li * 1024 * 1024;
                pg8::Gemm g{mix, Wt, T, 1024, 1024}; pg8::StaticOrder S; S.init(T, 1024, G, c);
                pg8::EpiRes E{hb, SS + (size_t)(2 * l + 1) * T}; pg8::gemm_phase<pg8::EpiRes, pg8::StaticOrder, true, true>(lds, g, S, E); }
            else if (r == 4 || r == 9) { pg8::Gemm g{hb, WB + W_FIN + (size_t)l * 5632 * 1024, T, 5632, 1024}; pg8::StaticOrder S; S.init(T, 5632, G, c);
                pg8::EpiFfnIn E{big, SS + (size_t)(2 * l + 1) * T}; pg8::gemm_phase<pg8::EpiFfnIn, pg8::StaticOrder, true, true>(lds, g, S, E); }
            else if (r == 5 || r == 10) { pg8::Gemm g{big, WB + W_FOUT + (size_t)l * 1024 * 2816, T, 1024, 2816}; pg8::StaticOrder S; S.init(T, 1024, G, c);
                pg8::EpiRes E{hb, SS + (size_t)(2 * l + 2) * T}; pg8::gemm_phase<pg8::EpiRes, pg8::StaticOrder, true, true>(lds, g, S, E); }
            else if (r == 6) { pg8::Gemm g{hb, WB + W_INO + (size_t)li * 2048 * 1024, T, 2048, 1024}; pg8::StaticOrder S; S.init(T, 2048, G, c);
                pg8::EpiOddIn E{big, SS + (size_t)(2 * l) * T, SS + (size_t)(9 + li) * T}; pg8::gemm_phase<pg8::EpiOddIn, pg8::StaticOrder, true, true>(lds, g, S, E); }
            else if (r == 7) { sgu::sgu_phase(p, li, (char*)lds_raw); }
        }
        if (ph + 1 < pin.ph_hi) { if (ph == 0) cg::this_grid().sync(); else xcd_barrier(xbar); }
    }
}

#ifndef MK_MULTI
#define MK_MULTI 0
#endif
extern "C" void kernel_launch(void* const* d_in, const int* in_sizes, int n_in, void* d_out, int out_size, void* d_ws, size_t ws_size, hipStream_t stream) {
    static int grid = 0;
    if (grid == 0) {
        if (n_in != 22 || in_sizes[0] != T * D_MODEL || out_size != T * D_MODEL || ws_size < WS_END) { fprintf(stderr, "kernel_launch: unexpected shapes / workspace (n_in %d, in0 %d, out %d, ws %zu need %zu)\n", n_in, n_in > 0 ? in_sizes[0] : -1, out_size, ws_size, (size_t)WS_END); grid = -1; return; }
        int dev = 0, cus = 0, per_cu = 0;
        if (hipGetDevice(&dev) != hipSuccess || hipDeviceGetAttribute(&cus, hipDeviceAttributeMultiprocessorCount, dev) != hipSuccess) { grid = -1; return; }
        if (hipFuncSetAttribute((const void*)mega_fwd, hipFuncAttributeMaxDynamicSharedMemorySize, LDS_BYTES) != hipSuccess) { fprintf(stderr, "kernel_launch: hipFuncSetAttribute failed\n"); grid = -1; return; }
        if (hipOccupancyMaxActiveBlocksPerMultiprocessor(&per_cu, (const void*)mega_fwd, 512, LDS_BYTES) != hipSuccess || per_cu < 1) { fprintf(stderr, "kernel_launch: occupancy query says %d\n", per_cu); per_cu = 1; }
        (void)hipGetLastError();
        grid = cus * 1;
    }
    if (grid < 0) return;
    Params p{};
    const float* const* in = (const float* const*)d_in;
    p.x = in[0]; p.rel_bias = in[1]; p.norm_mix = in[2]; p.norm_ffn = in[3]; p.norm_final = in[4]; p.w_in_even = in[5]; p.w_out_even = in[6];
    p.lq1 = in[7]; p.lk1 = in[8]; p.lq2 = in[9]; p.lk2 = in[10]; p.da_subln = in[11]; p.lb_fwd = in[12]; p.lb_bwd = in[13]; p.hg_norm = in[14];
    p.w_in_odd = in[15]; p.sg_norm = in[16]; p.sg_w = in[17]; p.sg_b = in[18]; p.w_out_odd = in[19]; p.w_ffn_in = in[20]; p.w_ffn_out = in[21];
    p.out = (float*)d_out; p.ws = (unsigned char*)d_ws;
#if MK_MULTI
    for (int ph = 0; ph < NPHASE; ++ph) { p.ph_lo = ph; p.ph_hi = ph + 1; hipLaunchKernelGGL(mega_fwd, dim3(grid), dim3(512), LDS_BYTES, stream, p); }
#else
    p.ph_lo = 0; p.ph_hi = NPHASE;
    if (hipMemsetAsync((char*)d_ws + WS_BAR, 0, XCD_BAR_WORDS * 4, stream) != hipSuccess) { fprintf(stderr, "kernel_launch: memset of the barrier words failed\n"); return; }
    void* args[] = {&p};
    hipError_t e = hipLaunchCooperativeKernel((const void*)mega_fwd, dim3(grid), dim3(512), args, LDS_BYTES, stream);
    if (e != hipSuccess) fprintf(stderr, "cooperative launch failed: %s (grid %d)\n", hipGetErrorString(e), grid);
#endif
}
```

```cpp
#include <hip/hip_runtime.h>
#include <hip/hip_cooperative_groups.h>
#include <cstdio>
#include <cstdint>
namespace cg = cooperative_groups;
namespace pg8 {
#define PG8_LAS __attribute__((address_space(3)))
typedef unsigned short bf16_t;
typedef short bf16x8 __attribute__((ext_vector_type(8)));
typedef float f32x4 __attribute__((ext_vector_type(4)));
typedef unsigned u32x4 __attribute__((ext_vector_type(4)));
constexpr int BM = 256, BK = 64, HALF = 128, HTB = HALF * BK * 2  , STAGE_BYTES = 8 * HTB, NXCD = 8, WGM = 8;

__host__ __device__ __forceinline__ int lds_byte(int r, int c) { const int st = (r >> 4) * 2 + (c >> 5), rr = r & 15, cc = c & 31, ob = rr * 64 + cc * 2; return st * 1024 + (ob ^ (((ob >> 9) & 1) << 5)); }
__host__ __device__ __forceinline__ void stage_rc(int b, int& R, int& C) { const int st = b / 1024, sb = b % 1024, swz = sb ^ (((sb >> 9) & 1) << 5); R = (st >> 1) * 16 + swz / 64; C = (st & 1) * 32 + (swz % 64) / 2; }
__host__ __device__ __forceinline__ int perm32(int rho) { const int n = rho >> 4, i = rho & 15; return 8 * (i >> 2) + 4 * n + (i & 3); }

struct Unit { int pm, pn; };
struct Gemm { const bf16_t* A; const bf16_t* Bt; int M, N, K; };

struct StaticOrder {
    int nM, nN, nwg, G, c;
    __host__ __device__ void init(int M, int N, int G_, int c_) { nM = M / BM; nN = N / BM; nwg = nM * nN; G = G_; c = c_; }
    __host__ __device__ bool next(int i, Unit& u) const {
        const long L = (long)i * G + c; if (L >= nwg) return false;
        int wgid = (int)L; { const int q = nwg / NXCD, r = nwg % NXCD, xcd = wgid % NXCD, off = wgid / NXCD; wgid = (xcd < r ? xcd * (q + 1) : r * (q + 1) + (xcd - r) * q) + off; }
        const int nig = WGM * nN, gid = wgid / nig, fm = gid * WGM, gsz = (nM - fm) < WGM ? (nM - fm) : WGM;
        u.pm = fm + ((wgid % nig) % gsz); u.pn = (wgid % nig) / gsz; return true;
    }
    __device__ __forceinline__ void a_ready(const Unit&) const {}
    __device__ __forceinline__ void done(const Unit&) const {}
};

__device__ __forceinline__ unsigned cvt_pk_bf16(float lo, float hi) { unsigned r; asm volatile("v_cvt_pk_bf16_f32 %0, %1, %2" : "=v"(r) : "v"(lo), "v"(hi)); return r; }
typedef float f32x2 __attribute__((ext_vector_type(2)));
__device__ __forceinline__ f32x2 gelu_pk(f32x2 v) {
    const f32x2 av = __builtin_elementwise_abs(v), d = av * 0.2316418882f + 1.0f;
    f32x2 t; t.x = __builtin_amdgcn_rcpf(d.x); t.y = __builtin_amdgcn_rcpf(d.y);
    f32x2 q = t * 0.5307027145f + (-0.7265760135f); q = q * t + 0.7107068705f; q = q * t + (-0.142248368f); q = q * t + 0.127414796f; q = q * t;
    const f32x2 s = (v * v) * (-0.72134752044f);
    f32x2 e; e.x = __builtin_amdgcn_exp2f(s.x); e.y = __builtin_amdgcn_exp2f(s.y);
    const f32x2 m = v * (q * e), r = v - m;
    f32x2 o; o.x = v.x < 0.f ? m.x : r.x; o.y = v.y < 0.f ? m.y : r.y; return o;
}

constexpr float RMS_EPS = 1e-6f;
__device__ __forceinline__ float ss2f(unsigned long long v) { return (float)v * (1.0f / 16777216.0f); }
__device__ __forceinline__ unsigned long long f2ss(float v) { return (unsigned long long)(v * 16777216.0f); }
struct PreSS { unsigned long long v0, v1; };
struct PreNone {};
__device__ __forceinline__ void prefetch_ss(PreSS& p, const unsigned long long* ss, const Unit& u, int wr, int fr, int fq) {
    const int k0 = 2 * fq, k1 = 2 * fq + 1, base = u.pm * BM + wr * 64 + fr;
    p.v0 = *(const __attribute__((address_space(1))) unsigned long long*)(ss + base + (k0 >> 2) * HALF + (k0 & 3) * 16);
    p.v1 = *(const __attribute__((address_space(1))) unsigned long long*)(ss + base + (k1 >> 2) * HALF + (k1 & 3) * 16);
}
__device__ __forceinline__ void rstd8(float (&r)[8], const PreSS& p, int fr) {
    const float a = __builtin_amdgcn_rsqf(ss2f(p.v0) * (1.0f / 1024.0f) + RMS_EPS), b = __builtin_amdgcn_rsqf(ss2f(p.v1) * (1.0f / 1024.0f) + RMS_EPS);
#pragma unroll
    for (int k = 0; k < 8; ++k) r[k] = __shfl((k & 1) ? b : a, fr + 16 * (k >> 1));
}
__device__ __forceinline__ float silu1(float v) { return v * __builtin_amdgcn_rcpf(1.0f + __builtin_amdgcn_exp2f(-1.4426950408889634f * v)); }
__device__ __forceinline__ f32x4 silu4(f32x4 v) { return (f32x4){silu1(v[0]), silu1(v[1]), silu1(v[2]), silu1(v[3])}; }
__device__ __forceinline__ u32x4 pack8(f32x4 v0, f32x4 v1) { u32x4 w; w.x = cvt_pk_bf16(v0[0], v0[1]); w.y = cvt_pk_bf16(v0[2], v0[3]); w.z = cvt_pk_bf16(v1[0], v1[1]); w.w = cvt_pk_bf16(v1[2], v1[3]); return w; }

struct EpiEvenIn {
    static constexpr bool PERM = true, AFTER_DRAIN = false;
    bf16_t* O; const unsigned long long* ss; unsigned* kmx;
    typedef PreSS Pre;
    __device__ __forceinline__ void prefetch(Pre& p, const Unit& u, int wr, int fr, int fq) const { prefetch_ss(p, ss, u, wr, fr, fq); }
    __device__ __forceinline__ void operator()(const f32x4 (&acc)[2][2][4][2], const Unit& u, int wr, int wc, int fr, int fq, const Pre& pre) const {
        const int row0 = u.pm * BM + wr * 64 + fr, col0 = u.pn * BM + wc * 32 + 8 * fq;
        float rs8[8]; rstd8(rs8, pre, fr);
        if (u.pn == 2 || u.pn == 3) {
            float mx0 = 0.f, mx1 = 0.f;
#pragma unroll
            for (int ai = 0; ai < 2; ++ai)
#pragma unroll
                for (int m = 0; m < 4; ++m) { const float r = rs8[ai * 4 + m];
#pragma unroll
                    for (int bj = 0; bj < 2; ++bj) { const f32x4 a = acc[ai][bj][m][0] * r, b = acc[ai][bj][m][1] * r;
                        float s = (a[0] * a[0] + a[1] * a[1]) + (a[2] * a[2] + a[3] * a[3]) + (b[0] * b[0] + b[1] * b[1]) + (b[2] * b[2] + b[3] * b[3]);
                        s += __shfl_xor(s, 16); s += __shfl_xor(s, 32);
                        if (bj == 0) mx0 = fmaxf(mx0, s); else mx1 = fmaxf(mx1, s); } }
#pragma unroll
            for (int o = 1; o < 16; o <<= 1) { mx0 = fmaxf(mx0, __shfl_xor(mx0, o)); mx1 = fmaxf(mx1, __shfl_xor(mx1, o)); }
            if (fr == 0 && fq == 0) { unsigned* kp = kmx + (u.pm >> 4) * 8 + (u.pn - 2) * 4 + (wc >> 1);
                atomicMax(kp, __float_as_uint(mx0)); atomicMax(kp + 2, __float_as_uint(mx1)); } }
        const bool act = (u.pn == 6) || (u.pn == 7) || (u.pn == 14) || (u.pn == 15);
        const float sc = (u.pn < 2) ? 0.125f : 1.0f;
#pragma unroll
        for (int ai = 0; ai < 2; ++ai)
#pragma unroll
            for (int m = 0; m < 4; ++m) { const int row = row0 + ai * HALF + m * 16; const float r = rs8[ai * 4 + m] * sc;
                bf16_t* rowp = O + (size_t)row * 4096 + col0;
#pragma unroll
                for (int bj = 0; bj < 2; ++bj) { f32x4 v0 = acc[ai][bj][m][0] * r, v1 = acc[ai][bj][m][1] * r;
                    if (act) { v0 = silu4(v0); v1 = silu4(v1); }
                    *(u32x4*)(rowp + bj * HALF) = pack8(v0, v1); } }
    }
};
struct EpiOddIn {
    static constexpr bool PERM = true, AFTER_DRAIN = false;
    bf16_t* O; const unsigned long long* ss; unsigned long long* vss;
    typedef PreSS Pre;
    __device__ __forceinline__ void prefetch(Pre& p, const Unit& u, int wr, int fr, int fq) const { prefetch_ss(p, ss, u, wr, fr, fq); }
    __device__ __forceinline__ void operator()(const f32x4 (&acc)[2][2][4][2], const Unit& u, int wr, int wc, int fr, int fq, const Pre& pre) const {
        const int row0 = u.pm * BM + wr * 64 + fr, col0 = u.pn * BM + wc * 32 + 8 * fq;
        float rs8[8]; rstd8(rs8, pre, fr);
        const bool isv = u.pn >= 4;
#pragma unroll
        for (int ai = 0; ai < 2; ++ai)
#pragma unroll
            for (int m = 0; m < 4; ++m) { const int row = row0 + ai * HALF + m * 16; const float r = rs8[ai * 4 + m];
                bf16_t* rowp = O + (size_t)row * 2048 + col0; float sq = 0.f;
#pragma unroll
                for (int bj = 0; bj < 2; ++bj) { f32x4 v0 = acc[ai][bj][m][0] * r, v1 = acc[ai][bj][m][1] * r;
                    f32x2 a = gelu_pk((f32x2){v0[0], v0[1]}), b = gelu_pk((f32x2){v0[2], v0[3]}), c = gelu_pk((f32x2){v1[0], v1[1]}), d = gelu_pk((f32x2){v1[2], v1[3]});
                    v0 = (f32x4){a.x, a.y, b.x, b.y}; v1 = (f32x4){c.x, c.y, d.x, d.y};
                    sq += (v0[0] * v0[0] + v0[1] * v0[1]) + (v0[2] * v0[2] + v0[3] * v0[3]) + (v1[0] * v1[0] + v1[1] * v1[1]) + (v1[2] * v1[2] + v1[3] * v1[3]);
                    *(u32x4*)(rowp + bj * HALF) = pack8(v0, v1); }
                if (isv) { sq += __shfl_xor(sq, 16); sq += __shfl_xor(sq, 32); if (fq == 0) atomicAdd(vss + row, f2ss(sq)); } }
    }
};
struct EpiFfnIn {
    static constexpr bool PERM = true, AFTER_DRAIN = false;
    bf16_t* O; const unsigned long long* ss;
    typedef PreSS Pre;
    __device__ __forceinline__ void prefetch(Pre& p, const Unit& u, int wr, int fr, int fq) const { prefetch_ss(p, ss, u, wr, fr, fq); }
    __device__ __forceinline__ void operator()(const f32x4 (&acc)[2][2][4][2], const Unit& u, int wr, int wc, int fr, int fq, const Pre& pre) const {
        const int row0 = u.pm * BM + wr * 64 + fr, col0 = u.pn * HALF + wc * 32 + 8 * fq;
        float rs8[8]; rstd8(rs8, pre, fr);
#pragma unroll
        for (int ai = 0; ai < 2; ++ai)
#pragma unroll
            for (int m = 0; m < 4; ++m) { const int row = row0 + ai * HALF + m * 16; const float r = rs8[ai * 4 + m];
                const f32x4 g0 = silu4(acc[ai][0][m][0] * r), g1 = silu4(acc[ai][0][m][1] * r);
                const f32x4 v0 = g0 * (acc[ai][1][m][0] * r), v1 = g1 * (acc[ai][1][m][1] * r);
                *(u32x4*)(O + (size_t)row * 2816 + col0) = pack8(v0, v1); }
    }
};
struct EpiRes {
    static constexpr bool PERM = true, AFTER_DRAIN = false;
    bf16_t* hb; unsigned long long* ssn;
    typedef PreNone Pre;
    __device__ __forceinline__ void prefetch(Pre&, const Unit&, int, int, int) const {}
    __device__ __forceinline__ void operator()(const f32x4 (&acc)[2][2][4][2], const Unit& u, int wr, int wc, int fr, int fq, const Pre&) const {
        const int row0 = u.pm * BM + wr * 64 + fr, col0 = u.pn * BM + wc * 32 + 8 * fq;
        typedef __attribute__((address_space(1))) u32x4 gu32x4;
        u32x4 bwv[2][4][2];
#pragma unroll
        for (int ai = 0; ai < 2; ++ai)
#pragma unroll
            for (int m = 0; m < 4; ++m)
#pragma unroll
                for (int bj = 0; bj < 2; ++bj) bwv[ai][m][bj] = *(const gu32x4*)(hb + (size_t)(row0 + ai * HALF + m * 16) * 1024 + col0 + bj * HALF);
#pragma unroll
        for (int ai = 0; ai < 2; ++ai)
#pragma unroll
            for (int m = 0; m < 4; ++m) { const int row = row0 + ai * HALF + m * 16; const size_t off = (size_t)row * 1024 + col0; float sq = 0.f;
#pragma unroll
                for (int bj = 0; bj < 2; ++bj) { const u32x4 bw = bwv[ai][m][bj];
                    const f32x4 b0 = (f32x4){__uint_as_float(bw.x << 16), __uint_as_float(bw.x & 0xffff0000u), __uint_as_float(bw.y << 16), __uint_as_float(bw.y & 0xffff0000u)};
                    const f32x4 b1 = (f32x4){__uint_as_float(bw.z << 16), __uint_as_float(bw.z & 0xffff0000u), __uint_as_float(bw.w << 16), __uint_as_float(bw.w & 0xffff0000u)};
                    const f32x4 v0 = acc[ai][bj][m][0] + b0, v1 = acc[ai][bj][m][1] + b1;
                    *(gu32x4*)(hb + off + bj * HALF) = pack8(v0, v1);
                    sq += (v0[0] * v0[0] + v0[1] * v0[1]) + (v0[2] * v0[2] + v0[3] * v0[3]) + (v1[0] * v1[0] + v1[1] * v1[1]) + (v1[2] * v1[2] + v1[3] * v1[3]); }
                sq += __shfl_xor(sq, 16); sq += __shfl_xor(sq, 32); if (fq == 0) atomicAdd(ssn + row, f2ss(sq)); }
    }
};
template <class Epi, class Sched, bool ALIGN_EPI = false, bool SP2 = false>
__device__ __forceinline__ void gemm_phase(PG8_LAS unsigned char* lds, const Gemm g, const Sched& S, const Epi& E) {
    int tid_ = threadIdx.x; asm volatile("" : "+v"(tid_));
    const int tid = tid_, wid = __builtin_amdgcn_readfirstlane(tid >> 6), lane = tid & 63, wr = wid >> 2, wc = wid & 3, fr = lane & 15, fq = lane >> 4;
    const int K = g.K, nt = K / BK;
    unsigned voffA[2], voffB[2];
#pragma unroll
    for (int i = 0; i < 2; ++i) { int R, C; stage_rc(tid * 16 + i * 8192, R, C); const int Rb = Epi::PERM ? ((R & ~31) + perm32(R & 31)) : R;
        voffA[i] = (unsigned)(R * K + C) * 2u; voffB[i] = (unsigned)(Rb * K + C) * 2u; }
    const size_t kstep = (size_t)(BK * 2);
    const size_t hstep = (size_t)HALF * K * 2;
    const size_t tstep = 2 * hstep;
    const unsigned ldsw = (unsigned)wid * 1024u;
    const int aoff = lds_byte(wr * 64 + fr, fq * 8), boff = lds_byte(wc * 32 + fr, fq * 8);
#define PG8_SA(b, h) (((b) * 2 + (h)) * HTB)
#define PG8_SB(b, h) ((4 + (b) * 2 + (h)) * HTB)
#define PG8_STAGE(bufoff, gbase, voff) do { _Pragma("unroll") for (int _i = 0; _i < 2; ++_i) \
        __builtin_amdgcn_global_load_lds((const unsigned*)((const char*)(gbase) + (voff)[_i]), (PG8_LAS unsigned*)(lds + (bufoff) + ldsw + _i * 8192), 16, 0, 0); } while (0)
#define PG8_LDA(dst, b, h) do { _Pragma("unroll") for (int m = 0; m < 4; ++m) _Pragma("unroll") for (int k = 0; k < 2; ++k) dst[m][k] = *(const PG8_LAS bf16x8*)(lds + PG8_SA(b, h) + aoff + m * 2048 + k * 1024); } while (0)
#define PG8_LDB(dst, b, h) do { _Pragma("unroll") for (int n = 0; n < 2; ++n) _Pragma("unroll") for (int k = 0; k < 2; ++k) dst[n][k] = *(const PG8_LAS bf16x8*)(lds + PG8_SB(b, h) + boff + n * 2048 + k * 1024); } while (0)
#define PG8_MMA(ai, bj, At, Bt) do { __builtin_amdgcn_s_setprio(1); _Pragma("unroll") for (int m = 0; m < 4; ++m) _Pragma("unroll") for (int n = 0; n < 2; ++n) _Pragma("unroll") for (int k = 0; k < 2; ++k) \
        acc[ai][bj][m][n] = __builtin_amdgcn_mfma_f32_16x16x32_bf16(Bt[n][k], At[m][k], acc[ai][bj][m][n], 0, 0, 0); __builtin_amdgcn_s_setprio(0); } while (0)
#define PG8_WAIT_V(n) asm volatile("s_waitcnt vmcnt(" #n ")" ::: "memory")
#define PG8_WAIT_L(n) asm volatile("s_waitcnt lgkmcnt(" #n ")" ::: "memory")
#define PG8_BAR __builtin_amdgcn_s_barrier()
#define PG8_SCHED __builtin_amdgcn_sched_barrier(0)
    Unit cur, nxt; int ui = 0;
    if (!S.next(0, cur)) return;
    f32x4 acc[2][2][4][2];
#pragma unroll
    for (int a = 0; a < 2; ++a)
#pragma unroll
        for (int b = 0; b < 2; ++b)
#pragma unroll
            for (int m = 0; m < 4; ++m)
#pragma unroll
                for (int n = 0; n < 2; ++n) acc[a][b][m][n] = (f32x4){0.f, 0.f, 0.f, 0.f};
    bf16x8 At[4][2], B0[2][2], B1[2][2];
    const char* cA = (const char*)g.A + (size_t)cur.pm * tstep; const char* cB = (const char*)g.Bt + (size_t)cur.pn * tstep;
    S.a_ready(cur);
    if constexpr (SP2) {
        PG8_STAGE(PG8_SB(0, 0), cB, voffB); PG8_STAGE(PG8_SB(0, 1), cB + hstep, voffB); PG8_STAGE(PG8_SA(0, 0), cA, voffA); PG8_STAGE(PG8_SA(0, 1), cA + hstep, voffA);
        if (wr == 1) PG8_BAR;
        PG8_WAIT_V(2); PG8_BAR;
        PG8_STAGE(PG8_SB(1, 0), cB + kstep, voffB); PG8_STAGE(PG8_SA(1, 0), cA + kstep, voffA); PG8_STAGE(PG8_SB(1, 1), cB + hstep + kstep, voffB);
        PG8_WAIT_V(6); PG8_BAR;
    } else {
        PG8_STAGE(PG8_SB(0, 0), cB, voffB); PG8_STAGE(PG8_SA(0, 0), cA, voffA); PG8_STAGE(PG8_SB(0, 1), cB + hstep, voffB); PG8_STAGE(PG8_SA(0, 1), cA + hstep, voffA);
        if (wr == 1) PG8_BAR;
        PG8_WAIT_V(4); PG8_BAR;
        PG8_STAGE(PG8_SB(1, 0), cB + kstep, voffB); PG8_STAGE(PG8_SA(1, 0), cA + kstep, voffA); PG8_STAGE(PG8_SB(1, 1), cB + hstep + kstep, voffB);
        PG8_WAIT_V(6); PG8_BAR;
    }
    for (;;) {
        const bool has_next = S.next(ui + 1, nxt);
        typename Epi::Pre pre; E.prefetch(pre, cur, wr, fr, fq);
        const char* nA = has_next ? (const char*)g.A + (size_t)nxt.pm * tstep : cA; const char* nB = has_next ? (const char*)g.Bt + (size_t)nxt.pn * tstep : cB;
        for (int t = 0; t < nt; t += 2) {
            const bool last = (t == nt - 2);
            const char* a1 = cA + (size_t)(t + 1) * kstep;
            const char* a2 = last ? nA : cA + (size_t)(t + 2) * kstep; const char* b2 = last ? nB : cB + (size_t)(t + 2) * kstep;
            const char* a3 = a2 + kstep; const char* b3 = b2 + kstep;
            if (last && has_next) S.a_ready(nxt);
            if constexpr (SP2) {
            PG8_LDB(B0, 0, 0); PG8_LDB(B1, 0, 1); PG8_SCHED; PG8_LDA(At, 0, 0); PG8_STAGE(PG8_SA(1, 1), a1 + hstep, voffA);
            PG8_WAIT_V(8); PG8_WAIT_L(0); PG8_BAR; PG8_MMA(0, 0, At, B0); PG8_MMA(0, 1, At, B1); PG8_BAR; PG8_SCHED;
            PG8_LDA(At, 0, 1); PG8_STAGE(PG8_SB(0, 0), b2, voffB); PG8_STAGE(PG8_SB(0, 1), b2 + hstep, voffB); PG8_STAGE(PG8_SA(0, 0), a2, voffA);
            PG8_WAIT_V(8); PG8_WAIT_L(0); PG8_BAR; PG8_MMA(1, 0, At, B0); PG8_MMA(1, 1, At, B1); PG8_BAR; PG8_SCHED;
            PG8_LDB(B0, 1, 0); PG8_LDB(B1, 1, 1); PG8_SCHED; PG8_LDA(At, 1, 0); PG8_STAGE(PG8_SA(0, 1), a2 + hstep, voffA);
            PG8_WAIT_V(8); PG8_WAIT_L(0); PG8_BAR; PG8_MMA(0, 0, At, B0); PG8_MMA(0, 1, At, B1); PG8_BAR; PG8_SCHED;
            PG8_LDA(At, 1, 1); PG8_STAGE(PG8_SB(1, 0), b3, voffB); PG8_STAGE(PG8_SB(1, 1), b3 + hstep, voffB); PG8_STAGE(PG8_SA(1, 0), a3, voffA);
            PG8_WAIT_V(8); PG8_WAIT_L(0); PG8_BAR; PG8_MMA(1, 0, At, B0); PG8_MMA(1, 1, At, B1); PG8_BAR; PG8_SCHED;
            } else {
            PG8_LDB(B0, 0, 0); PG8_SCHED; PG8_LDA(At, 0, 0); PG8_STAGE(PG8_SA(1, 1), a1 + hstep, voffA);
            PG8_WAIT_L(8); PG8_BAR; PG8_WAIT_L(0); PG8_MMA(0, 0, At, B0); PG8_BAR; PG8_SCHED;
            PG8_LDB(B1, 0, 1); PG8_STAGE(PG8_SB(0, 0), b2, voffB);
            PG8_BAR; PG8_WAIT_L(0); PG8_MMA(0, 1, At, B1); PG8_BAR;
            PG8_LDA(At, 0, 1); PG8_STAGE(PG8_SA(0, 0), a2, voffA);
            PG8_BAR; PG8_WAIT_L(0); PG8_MMA(1, 0, At, B0); PG8_BAR; PG8_SCHED;
            PG8_STAGE(PG8_SB(0, 1), b2 + hstep, voffB);
            PG8_WAIT_V(6); PG8_BAR; PG8_MMA(1, 1, At, B1); PG8_BAR;
            PG8_LDB(B0, 1, 0); PG8_SCHED; PG8_LDA(At, 1, 0); PG8_STAGE(PG8_SA(0, 1), a2 + hstep, voffA);
            PG8_WAIT_L(8); PG8_BAR; PG8_WAIT_L(0); PG8_MMA(0, 0, At, B0); PG8_BAR; PG8_SCHED;
            PG8_LDB(B1, 1, 1); PG8_STAGE(PG8_SB(1, 0), b3, voffB);
            PG8_BAR; PG8_WAIT_L(0); PG8_MMA(0, 1, At, B1); PG8_BAR;
            PG8_LDA(At, 1, 1); PG8_STAGE(PG8_SA(1, 0), a3, voffA);
            PG8_BAR; PG8_WAIT_L(0); PG8_MMA(1, 0, At, B0); PG8_BAR; PG8_SCHED;
            PG8_STAGE(PG8_SB(1, 1), b3 + hstep, voffB);
            PG8_WAIT_V(6); PG8_BAR; PG8_MMA(1, 1, At, B1); PG8_BAR;
            }
        }
        if constexpr (ALIGN_EPI) { if (wr == 0) PG8_BAR; }
        if constexpr (!Epi::AFTER_DRAIN) { E(acc, cur, wr, wc, fr, fq, pre); S.done(cur); }
        if (!has_next) break;
#pragma unroll
        for (int a = 0; a < 2; ++a)
#pragma unroll
            for (int b = 0; b < 2; ++b)
#pragma unroll
                for (int m = 0; m < 4; ++m)
#pragma unroll
                    for (int n = 0; n < 2; ++n) acc[a][b][m][n] = (f32x4){0.f, 0.f, 0.f, 0.f};
        cur = nxt; cA = nA; cB = nB; ++ui;
        if constexpr (ALIGN_EPI) { if (wr == 1) PG8_BAR; }
    }
    PG8_WAIT_V(0);
    if constexpr (!ALIGN_EPI) { if (wr == 0) PG8_BAR; }
    PG8_BAR;
    if constexpr (Epi::AFTER_DRAIN) { E.fused(acc, cur, wr, wc, fr, fq, lds, wid, lane); S.done(cur); }
#undef PG8_SA
#undef PG8_SB
#undef PG8_STAGE
#undef PG8_LDA
#undef PG8_LDB
#undef PG8_MMA
#undef PG8_WAIT_V
#undef PG8_WAIT_L
#undef PG8_BAR
#undef PG8_SCHED
}
}

constexpr int D_MODEL = 1024, BATCH = 16, SEQ = 4096, T = BATCH * SEQ, DFF = 2816, DEPTH = 4;
constexpr int EVEN_IN = 4096, ODD_IN = 2048;
constexpr float EPS = 1e-6f;
typedef unsigned short bf16;
typedef unsigned u32x4 __attribute__((ext_vector_type(4)));
typedef unsigned u32x2 __attribute__((ext_vector_type(2)));
typedef float f32x4 __attribute__((ext_vector_type(4)));
typedef float f32x2 __attribute__((ext_vector_type(2)));
typedef float f32x8 __attribute__((ext_vector_type(8)));
typedef float f32x16 __attribute__((ext_vector_type(16)));
typedef short bf16x8 __attribute__((ext_vector_type(8)));
typedef short s16x4 __attribute__((ext_vector_type(4)));
#define LAS __attribute__((address_space(3)))
#define GAS __attribute__((address_space(1)))

constexpr size_t MiB = 1u << 20;
constexpr size_t WS_SS = 0;
constexpr size_t WS_BAR = 6 * MiB;
constexpr size_t WS_KMX = 7 * MiB;
constexpr size_t WS_W = 8 * MiB;
constexpr size_t W_INE = 0, W_OUTE = W_INE + 2ull * 4096 * 1024, W_INO = W_OUTE + 2ull * 1024 * 1024, W_OUTO = W_INO + 2ull * 2048 * 1024,
                 W_FIN = W_OUTO + 2ull * 1024 * 1024, W_FOUT = W_FIN + 4ull * 5632 * 1024, W_SGW = W_FOUT + 4ull * 1024 * 2816, W_END = W_SGW + 2ull * 8 * 128 * 128;
static_assert(WS_W + W_END * 2 <= 108 * MiB, "weights");
constexpr size_t WS_ASCR = 108 * MiB;
constexpr size_t WS_HB = 140 * MiB;
constexpr size_t WS_MIX = 268 * MiB;
constexpr size_t WS_BIG = 396 * MiB;
constexpr size_t WS_END = 908 * MiB;
constexpr int LDS_BYTES = 147456;

struct Params {
    const float* x; const float* rel_bias; const float* norm_mix; const float* norm_ffn; const float* norm_final; const float* w_in_even; const float* w_out_even;
    const float* lq1; const float* lk1; const float* lq2; const float* lk2; const float* da_subln; const float* lb_fwd; const float* lb_bwd; const float* hg_norm;
    const float* w_in_odd; const float* sg_norm; const float* sg_w; const float* sg_b; const float* w_out_odd; const float* w_ffn_in; const float* w_ffn_out;
    float* out; unsigned char* ws; int ph_lo, ph_hi;
};

__device__ __forceinline__ unsigned cvtpk(float lo, float hi) { unsigned r; asm volatile("v_cvt_pk_bf16_f32 %0, %1, %2" : "=v"(r) : "v"(lo), "v"(hi)); return r; }
typedef __bf16 bf16v2 __attribute__((ext_vector_type(2)));
__device__ __forceinline__ unsigned cvtpk_c(float lo, float hi) { bf16v2 v; v.x = (__bf16)lo; v.y = (__bf16)hi; return __builtin_bit_cast(unsigned, v); }
__device__ __forceinline__ float bf2f(unsigned short b) { return __uint_as_float(((unsigned)b) << 16); }
__device__ __forceinline__ float bflo(unsigned w) { return __uint_as_float(w << 16); }
__device__ __forceinline__ float bfhi(unsigned w) { return __uint_as_float(w & 0xffff0000u); }
__device__ __forceinline__ float wave_sum(float v) {
#pragma unroll
    for (int o = 1; o < 64; o <<= 1) v += __shfl_xor(v, o);
    return v;
}

__device__ __forceinline__ void transpose_item(const float* W, int K, int N, bf16* WT, const float* gain, int ffn_perm, LAS float* scr, int item, int lane) {
    const int nblk = N / 32, kb = item / nblk, nb = item % nblk, k0 = 64 * kb, n0 = 32 * nb;
    float wv[32];
#pragma unroll
    for (int i = 0; i < 32; ++i) { const int kk = 2 * i + (lane >> 5); wv[i] = W[(size_t)(k0 + kk) * N + n0 + (lane & 31)]; }
#pragma unroll
    for (int i = 0; i < 32; ++i) { const int kk = 2 * i + (lane >> 5); const float g = gain ? gain[k0 + kk] : 1.0f; scr[kk * 33 + (lane & 31)] = wv[i] * g; }
    asm volatile("s_waitcnt lgkmcnt(0)" ::: "memory");
    int r0 = n0;
    if (ffn_perm) { r0 = (n0 < DFF) ? ((n0 >> 7) * 256 + (n0 & 127)) : (((n0 - DFF) >> 7) * 256 + 128 + ((n0 - DFF) & 127)); }
    const int c = lane & 7;
#pragma unroll
    for (int j = 0; j < 4; ++j) { const int n = (lane >> 3) + 8 * j; const LAS float* s = scr + (8 * c) * 33 + n;
        u32x4 o; o.x = cvtpk(s[0 * 33], s[1 * 33]); o.y = cvtpk(s[2 * 33], s[3 * 33]); o.z = cvtpk(s[4 * 33], s[5 * 33]); o.w = cvtpk(s[6 * 33], s[7 * 33]);
        *(u32x4*)(WT + (size_t)(r0 + n) * K + k0 + 8 * c) = o; }
    asm volatile("s_waitcnt lgkmcnt(0)" ::: "memory");
}

__device__ __forceinline__ void prologue_phase(const Params& p, LAS unsigned char* lds) {
    int tid_ = threadIdx.x; asm volatile("" : "+v"(tid_));
    const int tid = tid_, lane = tid & 63, wave = tid >> 6;
    const int gw = blockIdx.x * 8 + wave, NGW = gridDim.x * 8;
    const int gt = blockIdx.x * 512 + tid, NGT = gridDim.x * 512;
    { f32x4* z = (f32x4*)(p.ws + WS_SS); for (int i = T / 2 + gt; i < 11 * T / 2; i += NGT) z[i] = (f32x4){0.f, 0.f, 0.f, 0.f}; }
    if (gt < 256) ((unsigned*)(p.ws + WS_KMX))[gt] = 0u;
    bf16* WB = (bf16*)(p.ws + WS_W);
    LAS float* scr = (LAS float*)(lds + wave * 16384);
    constexpr int I_INE = 16 * 128, I_OUT = 16 * 32, I_INO = 16 * 64, I_FIN = 16 * 176, I_FOUT = 44 * 32;
    constexpr int NITEMS = 2 * I_INE + 2 * I_OUT + 2 * I_INO + 2 * I_OUT + 4 * I_FIN + 4 * I_FOUT;
    for (int it = gw; it < NITEMS; it += NGW) {
        int r = it;
        if (r < 2 * I_INE) { const int e = r / I_INE; transpose_item(p.w_in_even + (size_t)e * 1024 * 4096, 1024, 4096, WB + W_INE + (size_t)e * 4096 * 1024, p.norm_mix + (2 * e) * 1024, 0, scr, r % I_INE, lane); continue; } r -= 2 * I_INE;
        if (r < 2 * I_OUT) { const int e = r / I_OUT; transpose_item(p.w_out_even + (size_t)e * 1024 * 1024, 1024, 1024, WB + W_OUTE + (size_t)e * 1024 * 1024, nullptr, 0, scr, r % I_OUT, lane); continue; } r -= 2 * I_OUT;
        if (r < 2 * I_INO) { const int e = r / I_INO; transpose_item(p.w_in_odd + (size_t)e * 1024 * 2048, 1024, 2048, WB + W_INO + (size_t)e * 2048 * 1024, p.norm_mix + (2 * e + 1) * 1024, 0, scr, r % I_INO, lane); continue; } r -= 2 * I_INO;
        if (r < 2 * I_OUT) { const int e = r / I_OUT; transpose_item(p.w_out_odd + (size_t)e * 1024 * 1024, 1024, 1024, WB + W_OUTO + (size_t)e * 1024 * 1024, nullptr, 0, scr, r % I_OUT, lane); continue; } r -= 2 * I_OUT;
        if (r < 4 * I_FIN) { const int l = r / I_FIN; transpose_item(p.w_ffn_in + (size_t)l * 1024 * 5632, 1024, 5632, WB + W_FIN + (size_t)l * 5632 * 1024, p.norm_ffn + l * 1024, 1, scr, r % I_FIN, lane); continue; } r -= 4 * I_FIN;
        { const int l = r / I_FOUT; transpose_item(p.w_ffn_out + (size_t)l * 2816 * 1024, 2816, 1024, WB + W_FOUT + (size_t)l * 1024 * 2816, nullptr, 0, scr, r % I_FOUT, lane); }
    }
    { const f32x4* s = (const f32x4*)p.sg_w; u32x2* d = (u32x2*)(WB + W_SGW);
      for (int i = gt; i < 2 * 8 * 128 * 128 / 4; i += NGT) { const f32x4 v = s[i]; u32x2 o; o.x = cvtpk(v[0], v[1]); o.y = cvtpk(v[2], v[3]); d[i] = o; } }
    { unsigned long long* ss0 = (unsigned long long*)(p.ws + WS_SS); bf16* hb = (bf16*)(p.ws + WS_HB);
      for (int m = gw; m < T; m += 2 * NGW) {
        const int m1 = m + NGW; const bool has1 = m1 < T;
        const f32x4* xr0 = (const f32x4*)(p.x + (size_t)m * 1024) + lane; const f32x4* xr1 = (const f32x4*)(p.x + (size_t)(has1 ? m1 : m) * 1024) + lane;
        f32x4 a[4], b[4];
#pragma unroll
        for (int j = 0; j < 4; ++j) { a[j] = xr0[64 * j]; b[j] = xr1[64 * j]; }
        float s0 = 0.f, s1 = 0.f;
        u32x2* o0 = (u32x2*)(hb + (size_t)m * 1024) + lane; u32x2* o1 = (u32x2*)(hb + (size_t)m1 * 1024) + lane;
#pragma unroll
        for (int j = 0; j < 4; ++j) { const f32x4 v = a[j]; s0 += (v[0] * v[0] + v[1] * v[1]) + (v[2] * v[2] + v[3] * v[3]); u32x2 w; w.x = cvtpk(v[0], v[1]); w.y = cvtpk(v[2], v[3]); o0[64 * j] = w; }
        if (has1) {
#pragma unroll
          for (int j = 0; j < 4; ++j) { const f32x4 v = b[j]; s1 += (v[0] * v[0] + v[1] * v[1]) + (v[2] * v[2] + v[3] * v[3]); u32x2 w; w.x = cvtpk(v[0], v[1]); w.y = cvtpk(v[2], v[3]); o1[64 * j] = w; } }
        s0 = wave_sum(s0); s1 = wave_sum(s1);
        if (lane == 0) { ss0[m] = pg8::f2ss(s0); if (has1) ss0[m1] = pg8::f2ss(s1); } } }
}

__device__ __forceinline__ void final_phase(const Params& p) {
    int tid_ = threadIdx.x; asm volatile("" : "+v"(tid_));
    const int tid = tid_, lane = tid & 63, wave = tid >> 6;
    const int gw = blockIdx.x * 8 + wave, NGW = gridDim.x * 8;
    const unsigned long long* ss = (const unsigned long long*)(p.ws + WS_SS) + (size_t)8 * T;
    const bf16* hb = (const bf16*)(p.ws + WS_HB);
    f32x4 g0[2], g1[2];
#pragma unroll
    for (int j = 0; j < 2; ++j) { const int c = j * 512 + lane * 8; g0[j] = *(const f32x4*)(p.norm_final + c); g1[j] = *(const f32x4*)(p.norm_final + c + 4); }
    for (int m0 = gw; m0 < T; m0 += 4 * NGW) {
        u32x4 w[4][2]; unsigned long long sv[4];
#pragma unroll
        for (int q = 0; q < 4; ++q) { const int m = m0 + q * NGW; const int mc = m < T ? m : m0; sv[q] = ss[mc];
#pragma unroll
            for (int j = 0; j < 2; ++j) w[q][j] = *(const u32x4*)(hb + (size_t)mc * 1024 + j * 512 + lane * 8); }
#pragma unroll
        for (int q = 0; q < 4; ++q) { const int m = m0 + q * NGW; if (m < T) { const float r = __builtin_amdgcn_rsqf(pg8::ss2f(sv[q]) * (1.0f / 1024.0f) + EPS);
#pragma unroll
            for (int j = 0; j < 2; ++j) { const int c = j * 512 + lane * 8; const u32x4 x = w[q][j];
                const f32x4 v0 = (f32x4){bflo(x.x), bfhi(x.x), bflo(x.y), bfhi(x.y)}, v1 = (f32x4){bflo(x.z), bfhi(x.z), bflo(x.w), bfhi(x.w)};
                *(f32x4*)(p.out + (size_t)m * 1024 + c) = v0 * r * g0[j]; *(f32x4*)(p.out + (size_t)m * 1024 + c + 4) = v1 * r * g1[j]; } } } }
}

namespace att {
constexpr int KVBLK = 64, LDK = 4096;
constexpr int SHM_V = 64 * 128 * 2, SHM_K = 64 * 64 * 2;
constexpr int OFF_V = 0, OFF_K = 3 * SHM_V, OFF_WS = OFF_K + 3 * SHM_K, OFF_TB = OFF_WS + 8 * 64 * 4, OFF_OST = OFF_TB + 1552, OST_PITCH = 272, OFF_END = OFF_OST + 8 * 32 * OST_PITCH;
constexpr float LOG2E = 1.4426950408889634f;
constexpr float C1 = LOG2E;
constexpr float THR2 = 8.0f * LOG2E;
#define KSWZ64(row, colB) ((row) * 128 + ((colB) ^ ((((row) >> 1) & 7) << 4)))
#define SBAR() __builtin_amdgcn_sched_barrier(0)
__device__ __forceinline__ int crow(int r, int hi) { return (r & 3) + 8 * (r >> 2) + 4 * hi; }

__device__ __forceinline__ void partialSM(f32x16& p0, f32x16& p1, float& m_reg, float& mn, float& alpha, int kt0, int qpos, int qw, int hi, const float* tb2, float cL, float cR) {
  mn = m_reg; alpha = 1.f;
  const int rel_hi = kt0 + 63 - qw, rel_lo = kt0 - (qw + 31);
  if (rel_hi <= -91 || rel_lo >= 91) {
    const float cm = ((rel_hi <= -91) ? cL : cR) - m_reg;
#pragma unroll
    for (int r = 0; r < 16; ++r) { p0[r] = fmaf(p0[r], C1, cm); p1[r] = fmaf(p1[r], C1, cm); }
  } else {
    const float* tp = tb2 + (kt0 - qpos + 192 + 4 * hi);
#pragma unroll
    for (int r4 = 0; r4 < 4; ++r4) {
      float ta[4], tb[4];
#pragma unroll
      for (int i = 0; i < 4; ++i) { ta[i] = tp[8 * r4 + i] - m_reg; tb[i] = tp[32 + 8 * r4 + i] - m_reg; }
#pragma unroll
      for (int i = 0; i < 4; ++i) { p0[4 * r4 + i] = fmaf(p0[4 * r4 + i], C1, ta[i]); p1[4 * r4 + i] = fmaf(p1[4 * r4 + i], C1, tb[i]); }
      asm volatile("" ::: "memory");
    }
  }
#pragma unroll
  for (int r = 0; r < 16; ++r) p0[r] = __builtin_amdgcn_exp2f(p0[r]);
}
__device__ __forceinline__ void finishSM(f32x16& p0, f32x16& p1, float alpha, float& l_reg, bf16x8& pa0, bf16x8& pa1, bf16x8& pa2, bf16x8& pa3) {
#pragma unroll
  for (int r = 0; r < 16; ++r) p1[r] = __builtin_amdgcn_exp2f(p1[r]);
  float ps = 0;
#pragma unroll
  for (int r = 0; r < 16; ++r) ps += p0[r];
#pragma unroll
  for (int r = 0; r < 16; ++r) ps += p1[r];
  { auto rr = __builtin_amdgcn_permlane32_swap(__float_as_uint(ps), __float_as_uint(ps), false, false);
    ps = __uint_as_float(rr[0]) + __uint_as_float(rr[1]); }
  l_reg = l_reg * alpha + ps;
#define PK4(P, BASE, OUT) do { unsigned a0 = cvtpk(P[BASE + 0], P[BASE + 1]), a1 = cvtpk(P[BASE + 2], P[BASE + 3]);   \
    unsigned b0 = cvtpk(P[BASE + 4], P[BASE + 5]), b1 = cvtpk(P[BASE + 6], P[BASE + 7]);                              \
    auto r0 = __builtin_amdgcn_permlane32_swap(a0, b0, false, false); auto r1 = __builtin_amdgcn_permlane32_swap(a1, b1, false, false); \
    u32x4 w = {r0[0], r1[0], r0[1], r1[1]}; OUT = *reinterpret_cast<bf16x8*>(&w); } while (0)
  PK4(p0, 0, pa0); PK4(p0, 8, pa1); PK4(p1, 0, pa2); PK4(p1, 8, pa3);
#undef PK4
}
__device__ __forceinline__ void qkt(f32x16& p0, f32x16& p1, const char* Ks, const bf16x8* qr, int r32, int hi) {
  bf16x8 ka[4], kb[4];
#pragma unroll
  for (int d0 = 0; d0 < 4; ++d0) { const int cb = (d0 * 16 + hi * 8) * 2;
    ka[d0] = *reinterpret_cast<const bf16x8*>(Ks + KSWZ64(r32, cb)); kb[d0] = *reinterpret_cast<const bf16x8*>(Ks + KSWZ64(32 + r32, cb)); }
  asm volatile("s_waitcnt lgkmcnt(0)" ::: "memory"); SBAR();
  p0 = f32x16{}; p1 = f32x16{};
#pragma unroll
  for (int d0 = 0; d0 < 4; ++d0) {
    p0 = __builtin_amdgcn_mfma_f32_32x32x16_bf16(ka[d0], qr[d0], p0, 0, 0, 0);
    p1 = __builtin_amdgcn_mfma_f32_32x32x16_bf16(kb[d0], qr[d0], p1, 0, 0, 0); }
}
__device__ __forceinline__ int v_st(int k, int c) { const int kk = (k & ~0xC) | ((k & 4) << 1) | ((k & 8) >> 1); return ((kk >> 3) * 4 + (c >> 5)) * 512 + ((kk & 7) * 32 + (c & 31)) * 2; }
__device__ __forceinline__ int v_rd_base(int lane) { return ((lane & 3) << 3) | (((lane >> 2) & 3) << 6) | (((lane >> 4) & 1) << 5) | (((lane >> 5) & 1) << 8); }
constexpr int v_rd_off(int d0, int ks, int half) { return d0 * 512 + ks * 4096 + half * 2048; }
template <int OFF> __device__ __forceinline__ s16x4 tr_read(int vb) {
  s16x4 r; asm volatile("ds_read_b64_tr_b16 %0, %1 offset:%2" : "=&v"(r) : "v"(vb), "i"(OFF) : "memory"); return r;
}
template <int D0> __device__ __forceinline__ void pv_one(f32x16& od, int vb, bf16x8 pa0, bf16x8 pa1, bf16x8 pa2, bf16x8 pa3) {
  const s16x4 l0 = tr_read<v_rd_off(D0, 0, 0)>(vb), h0 = tr_read<v_rd_off(D0, 0, 1)>(vb), l1 = tr_read<v_rd_off(D0, 1, 0)>(vb), h1 = tr_read<v_rd_off(D0, 1, 1)>(vb);
  const s16x4 l2 = tr_read<v_rd_off(D0, 2, 0)>(vb), h2 = tr_read<v_rd_off(D0, 2, 1)>(vb), l3 = tr_read<v_rd_off(D0, 3, 0)>(vb), h3 = tr_read<v_rd_off(D0, 3, 1)>(vb);
  asm volatile("s_waitcnt lgkmcnt(0)" ::: "memory"); SBAR();
#define PK(L, H) (bf16x8){L[0], L[1], L[2], L[3], H[0], H[1], H[2], H[3]}
  od = __builtin_amdgcn_mfma_f32_32x32x16_bf16(pa0, PK(l0, h0), od, 0, 0, 0);
  od = __builtin_amdgcn_mfma_f32_32x32x16_bf16(pa1, PK(l1, h1), od, 0, 0, 0);
  od = __builtin_amdgcn_mfma_f32_32x32x16_bf16(pa2, PK(l2, h2), od, 0, 0, 0);
  od = __builtin_amdgcn_mfma_f32_32x32x16_bf16(pa3, PK(l3, h3), od, 0, 0, 0);
#undef PK
}
__device__ __forceinline__ void pv_d0(f32x16* o, int vb, bf16x8 pa0, bf16x8 pa1, bf16x8 pa2, bf16x8 pa3) {
  pv_one<0>(o[0], vb, pa0, pa1, pa2, pa3); pv_one<1>(o[1], vb, pa0, pa1, pa2, pa3); pv_one<2>(o[2], vb, pa0, pa1, pa2, pa3); pv_one<3>(o[3], vb, pa0, pa1, pa2, pa3);
}

template <bool GRPB> __device__ __forceinline__ void attn_pass(const float mbK, const float bmax2, const int pass, float* __restrict__ scr, bf16* __restrict__ mixrow, const float lam, const float* __restrict__ gsub, const float one_m_li,
                                          const bf16* __restrict__ Qb, const bf16* __restrict__ Kh, const bf16* __restrict__ Vh, int q0seq, char* lds, const float* tb2) {
  int tid_ = threadIdx.x; asm volatile("" : "+v"(tid_));
  const int tid = tid_, wid = tid >> 6, lane = tid & 63, r32 = lane & 31, hi = lane >> 5;
  char* V_lds = lds + OFF_V; char* K_lds = lds + OFF_K;
  float* ws = (float*)(lds + OFF_WS) + wid * 64; float* li_l = ws; float* al_l = ws + 32; char* ost = lds + OFF_OST + wid * (32 * OST_PITCH);
  const float cL = __uint_as_float(__builtin_amdgcn_readfirstlane(__float_as_uint(tb2[0]))), cR = __uint_as_float(__builtin_amdgcn_readfirstlane(__float_as_uint(tb2[384])));
  const int qw = __builtin_amdgcn_readfirstlane(q0seq + wid * 32), qpos = qw + r32;
  float m_reg, l_reg = 0; bf16x8 qr[4]; f32x16 o[4];
#pragma unroll
  for (int d = 0; d < 4; ++d) o[d] = f32x16{};
  const bf16* Qw = Qb + (long)(wid * 32 + r32) * LDK + hi * 8;
#pragma unroll
  for (int d0 = 0; d0 < 4; ++d0) qr[d0] = *(const GAS bf16x8*)(Qw + d0 * 16);
  { float qs = 0.f;
#pragma unroll
    for (int d0 = 0; d0 < 4; ++d0)
#pragma unroll
      for (int j = 0; j < 8; ++j) { const float v = bf2f((unsigned short)qr[d0][j]); qs = fmaf(v, v, qs); }
    { auto rr = __builtin_amdgcn_permlane32_swap(__float_as_uint(qs), __float_as_uint(qs), false, false); qs = __uint_as_float(rr[0]) + __uint_as_float(rr[1]); }
    m_reg = __builtin_sqrtf(qs) * mbK + bmax2 + 0.25f; }
  const int sr = tid >> 4, sc = (tid & 15) * 8, vst0 = v_st(sr, sc), vst1 = v_st(32 + sr, sc);
  const int kr = tid >> 3, kc = (tid & 7) * 8, kst = KSWZ64(kr, kc * 2);
  const int vb0 = (int)(uintptr_t)V_lds + v_rd_base(lane);
  struct { bf16x8 vs0, vs1, ks0; } sr_[2];
#define SLOAD(i, k0) do { sr_[i].vs0 = *(const GAS bf16x8*)(&Vh[(long)((k0) + sr) * LDK + sc]); sr_[i].vs1 = *(const GAS bf16x8*)(&Vh[(long)((k0) + 32 + sr) * LDK + sc]); \
    sr_[i].ks0 = *(const GAS bf16x8*)(&Kh[(long)((k0) + kr) * LDK + kc]); } while (0)
#define SWRITE(b, i) do { *(bf16x8*)(V_lds + (b) * SHM_V + vst0) = sr_[i].vs0; *(bf16x8*)(V_lds + (b) * SHM_V + vst1) = sr_[i].vs1; \
    *(bf16x8*)(K_lds + (b) * SHM_K + kst) = sr_[i].ks0; } while (0)
#define SWAIT() asm volatile("s_waitcnt vmcnt(3)" ::: "memory")
#define RESC(a) do { if (__any((a) < 1.f)) { if (hi == 0) al_l[r32] = (a); asm volatile("s_waitcnt lgkmcnt(0)" ::: "memory"); \
    _Pragma("unroll") for (int d = 0; d < 4; ++d) _Pragma("unroll") for (int r = 0; r < 16; ++r) o[d][r] *= al_l[crow(r, hi)]; } } while (0)
  f32x16 pA0, pA1, pB0, pB1; float mnA, mnB, alA, alB; bf16x8 pa0, pa1, pa2, pa3; constexpr int NT = SEQ / KVBLK;
  __syncthreads();
  SLOAD(0, 0); SLOAD(1, KVBLK); asm volatile("s_waitcnt vmcnt(0)" ::: "memory"); SWRITE(0, 0); SWRITE(1, 1);
  SLOAD(0, 2 * KVBLK); asm volatile("s_waitcnt vmcnt(0)" ::: "memory"); SWRITE(2, 0); __syncthreads();
  qkt(pA0, pA1, K_lds, qr, r32, hi); partialSM(pA0, pA1, m_reg, mnA, alA, 0, qpos, qw, hi, tb2, cL, cR);
  int bm1 = 0, b0 = 1, bp1 = 2;
#define HSTEP(N0, N1, MN, AL, C0, C1, ALC, TPOS, LOADSTMT) do { \
    if constexpr (GRPB) { SBAR(); finishSM(C0, C1, ALC, l_reg, pa0, pa1, pa2, pa3); SBAR(); qkt(N0, N1, K_lds + b0 * SHM_K, qr, r32, hi); SBAR(); LOADSTMT; SBAR(); \
                partialSM(N0, N1, m_reg, MN, AL, (TPOS), qpos, qw, hi, tb2, cL, cR); SBAR(); pv_d0(o, vb0 + bm1 * SHM_V, pa0, pa1, pa2, pa3); } \
    else      { SBAR(); qkt(N0, N1, K_lds + b0 * SHM_K, qr, r32, hi); finishSM(C0, C1, ALC, l_reg, pa0, pa1, pa2, pa3); SBAR(); LOADSTMT; SBAR(); \
                pv_d0(o, vb0 + bm1 * SHM_V, pa0, pa1, pa2, pa3); partialSM(N0, N1, m_reg, MN, AL, (TPOS), qpos, qw, hi, tb2, cL, cR); } } while (0)
  for (int t = 1; t + 1 < NT; t += 2) {
    HSTEP(pB0, pB1, mnB, alB, pA0, pA1, alA, t * KVBLK, SLOAD(0, (t + 2) * KVBLK));
    __syncthreads(); SWRITE(bm1, 0);
    RESC(alB);
    { const int tmp = bm1; bm1 = b0; b0 = bp1; bp1 = tmp; }
    HSTEP(pA0, pA1, mnA, alA, pB0, pB1, alB, (t + 1) * KVBLK, if (t + 3 < NT) SLOAD(0, (t + 3) * KVBLK));
    __syncthreads(); if (t + 3 < NT) SWRITE(bm1, 0);
    RESC(alA);
    { const int tmp = bm1; bm1 = b0; b0 = bp1; bp1 = tmp; }
  }
#undef HSTEP
  SBAR(); qkt(pB0, pB1, K_lds + b0 * SHM_K, qr, r32, hi);
  finishSM(pA0, pA1, alA, l_reg, pa0, pa1, pa2, pa3); SBAR();
  pv_d0(o, vb0 + bm1 * SHM_V, pa0, pa1, pa2, pa3); partialSM(pB0, pB1, m_reg, mnB, alB, (NT - 1) * KVBLK, qpos, qw, hi, tb2, cL, cR);
  RESC(alB);
  finishSM(pB0, pB1, alB, l_reg, pa0, pa1, pa2, pa3); SBAR();
  pv_d0(o, vb0 + b0 * SHM_V, pa0, pa1, pa2, pa3);
  int te_ = threadIdx.x; asm volatile("" : "+v"(te_));
  float* li_e = (float*)(lds + OFF_WS) + (te_ >> 6) * 64; char* ost_e = lds + OFF_OST + (te_ >> 6) * (32 * OST_PITCH);
  if (hi == 0) li_e[r32] = l_reg; asm volatile("s_waitcnt lgkmcnt(0)" ::: "memory");
  GAS f32x4* scr4 = (GAS f32x4*)(scr + (size_t)tid * 64);
  if (pass == 0) {
#pragma unroll
    for (int r4 = 0; r4 < 4; ++r4) { const f32x4 lv = *(const f32x4*)(li_e + 8 * r4 + 4 * hi);
      const f32x4 rl = (f32x4){__builtin_amdgcn_rcpf(lv[0]), __builtin_amdgcn_rcpf(lv[1]), __builtin_amdgcn_rcpf(lv[2]), __builtin_amdgcn_rcpf(lv[3])};
#pragma unroll
      for (int d0 = 0; d0 < 4; ++d0) scr4[d0 * 4 + r4] = (f32x4){o[d0][4 * r4 + 0] * rl[0], o[d0][4 * r4 + 1] * rl[1], o[d0][4 * r4 + 2] * rl[2], o[d0][4 * r4 + 3] * rl[3]}; }
  } else {
    float g[4];
    const float lam_ = *(const float*)(lds + 147328), oml_ = *(const float*)(lds + 147332);
#pragma unroll
    for (int d0 = 0; d0 < 4; ++d0) g[d0] = gsub[d0 * 32 + r32] * oml_;
#pragma unroll
    for (int r4 = 0; r4 < 4; ++r4) { const f32x4 lv = *(const f32x4*)(li_e + 8 * r4 + 4 * hi);
      f32x4 av[4];
#pragma unroll
      for (int d0 = 0; d0 < 4; ++d0) av[d0] = scr4[d0 * 4 + r4];
#pragma unroll
      for (int i = 0; i < 4; ++i) { const float rl = __builtin_amdgcn_rcpf(lv[i]) * lam_; float dv[4]; float sq = 0.f;
#pragma unroll
        for (int d0 = 0; d0 < 4; ++d0) { dv[d0] = av[d0][i] - rl * o[d0][4 * r4 + i]; sq += dv[d0] * dv[d0]; }
        sq += __shfl_xor(sq, 1); sq += __shfl_xor(sq, 2); sq += __shfl_xor(sq, 4); sq += __shfl_xor(sq, 8); sq += __shfl_xor(sq, 16);
        const float rs = __builtin_amdgcn_rsqf(sq * (1.0f / 128.0f) + EPS);
        unsigned short* orow = (unsigned short*)(ost_e + (8 * r4 + 4 * hi + i) * OST_PITCH) + r32;
#pragma unroll
        for (int d0 = 0; d0 < 4; ++d0) orow[d0 * 32] = (unsigned short)(cvtpk(dv[d0] * rs * g[d0], 0.f) & 0xffffu); } }
    asm volatile("s_waitcnt lgkmcnt(0)" ::: "memory");
    { const int rr = lane >> 4, c16 = lane & 15; char* gdst = (char*)(mixrow + (size_t)(wid * 32 + rr) * 1024) + c16 * 16;
#pragma unroll
      for (int j = 0; j < 8; ++j) { const u32x4 w = *(const u32x4*)(ost_e + (4 * j + rr) * OST_PITCH + c16 * 16); *(GAS u32x4*)(gdst + (size_t)j * 8192) = w; } }
  }
#undef SLOAD
#undef SWRITE
#undef SWAIT
#undef RESC
}

__device__ __forceinline__ int rel_bucket(int rel) {
  const int ret = rel > 0 ? 16 : 0; const int n = rel < 0 ? -rel : rel;
  if (n < 8) return ret + n;
  int large = 2 + (31 - __clz(n * n)); if (large > 15) large = 15;
  return ret + large;
}

__device__ __forceinline__ void attn_phase(const Params& p, int e, char* lds) {
  const int tid = threadIdx.x,
      wid = tid >> 6, lane = tid & 63, r32 = lane & 31, hi = lane >> 5;
  const bf16* big = (const bf16*)(p.ws + WS_BIG); bf16* mix = (bf16*)(p.ws + WS_MIX);
  float* scr = (float*)(p.ws + WS_ASCR) + (size_t)blockIdx.x * 32768;
  float* tb2 = (float*)(lds + OFF_TB);
  float lam, one_m_li;
  { const float a = p.lq1[e * 64 + lane] * p.lk1[e * 64 + lane], b = p.lq2[e * 64 + lane] * p.lk2[e * 64 + lane];
    const float s1 = wave_sum(a), s2 = wave_sum(b); const float li = 0.8f - 0.6f * __expf(-0.3f * (float)(2 * e));
    lam = __uint_as_float(__builtin_amdgcn_readfirstlane(__float_as_uint(__expf(s1) - __expf(s2) + li))); one_m_li = __uint_as_float(__builtin_amdgcn_readfirstlane(__float_as_uint(1.0f - li))); }
  if (tid == 0) { *(float*)(lds + 147328) = lam; *(float*)(lds + 147332) = one_m_li; }
  int cur_h = -1;
  const bool xmap = (gridDim.x == 256);
  const int nrounds = xmap ? 4 : (BATCH * 4 * 16 + (int)gridDim.x - 1) / (int)gridDim.x;
  for (int k = 0; k < nrounds; ++k) {
    const int u = xmap ? ((((k * 16) + ((int)(blockIdx.x & 7) * 2) + (int)(blockIdx.x >> 7)) << 4) | (int)((blockIdx.x >> 3) & 15)) : ((int)blockIdx.x + k * (int)gridDim.x);
    if (u >= BATCH * 4 * 16) break;
    const int qb = u & 15, h = (u >> 4) & 3, b = u >> 6;
    if (h != cur_h) { int tf_ = threadIdx.x; asm volatile("" : "+v"(tf_));
      __syncthreads(); for (int d = tf_; d < 385; d += 512) tb2[d] = p.rel_bias[rel_bucket(d - 192) * 4 + h] * LOG2E; cur_h = h; __syncthreads(); }
    const long row0 = (long)b * SEQ + qb * 256;
    float bmax2 = -1e30f;
#pragma unroll 4
    for (int bk = 0; bk < 32; ++bk) bmax2 = fmaxf(bmax2, p.rel_bias[bk * 4 + h] * LOG2E);
    const unsigned* kmx = (const unsigned*)(p.ws + WS_KMX) + e * 128 + b * 8 + h * 2;
    const float mbK0 = __uint_as_float(__builtin_amdgcn_readfirstlane(__float_as_uint(C1 * 1.01f * __builtin_sqrtf(2.0f * __uint_as_float(kmx[0])))));
    const float mbK1 = __uint_as_float(__builtin_amdgcn_readfirstlane(__float_as_uint(C1 * 1.01f * __builtin_sqrtf(2.0f * __uint_as_float(kmx[1])))));
    bmax2 = __uint_as_float(__builtin_amdgcn_readfirstlane(__float_as_uint(bmax2)));
    if (__builtin_amdgcn_readfirstlane(wid) & 1) {
      attn_pass<true>(mbK0, bmax2, 0, scr, mix + (size_t)row0 * 1024 + h * 128, lam, p.da_subln + e * 128, one_m_li,
                big + row0 * LDK + h * 128, big + (long)b * SEQ * LDK + 512 + h * 128, big + (long)b * SEQ * LDK + 1024 + h * 128, qb * 256, lds, tb2);
      attn_pass<true>(mbK1, bmax2, 1, scr, mix + (size_t)row0 * 1024 + h * 128, lam, p.da_subln + e * 128, one_m_li,
                big + row0 * LDK + h * 128 + 64, big + (long)b * SEQ * LDK + 512 + h * 128 + 64, big + (long)b * SEQ * LDK + 1024 + h * 128, qb * 256, lds, tb2);
    } else {
      attn_pass<false>(mbK0, bmax2, 0, scr, mix + (size_t)row0 * 1024 + h * 128, lam, p.da_subln + e * 128, one_m_li,
                big + row0 * LDK + h * 128, big + (long)b * SEQ * LDK + 512 + h * 128, big + (long)b * SEQ * LDK + 1024 + h * 128, qb * 256, lds, tb2);
      attn_pass<false>(mbK1, bmax2, 1, scr, mix + (size_t)row0 * 1024 + h * 128, lam, p.da_subln + e * 128, one_m_li,
                big + row0 * LDK + h * 128 + 64, big + (long)b * SEQ * LDK + 512 + h * 128 + 64, big + (long)b * SEQ * LDK + 1024 + h * 128, qb * 256, lds, tb2);
    }
  }
}
}

namespace hg {
constexpr int TB = 32;
constexpr int OFF_F = 0, OFF_Q = 16384, OFF_V = 32768, OFF_OP = 40960, OFF_END = 40960 + 65536;
__device__ __forceinline__ void hgrn_phase(const Params& p, int e, char* lds) {
  int tid_ = threadIdx.x; asm volatile("" : "+v"(tid_));
  const int tid = tid_, wave = tid >> 6, lane = tid & 63;
  const bf16* big = (const bf16*)(p.ws + WS_BIG);
  bf16* ohg = (bf16*)(p.ws + WS_HB);
  float* F = (float*)(lds + OFF_F); float* Q = (float*)(lds + OFF_Q); float* Vv = (float*)(lds + OFF_V); float* OP = (float*)(lds + OFF_OP);
  const int lt = tid >> 4, lk8 = (tid & 15) * 8;
  const int vt = (tid & 255) >> 3, vv8 = (tid & 7) * 8;
  const int vg = lane & 15, kg = wave * 4 + (lane >> 4), k0 = kg * 4, v0 = vg * 4;
  const int st = tid >> 4, sv4 = (tid & 15) * 4;
  for (int u = blockIdx.x; u < 256; u += gridDim.x) {
    const int vh = u & 1, dir = (u >> 1) & 1, h = (u >> 2) & 3, b = u >> 4;
    const float* lbsrc = dir ? p.lb_bwd : p.lb_fwd;
    float lb[8];
#pragma unroll
    for (int i = 0; i < 8; ++i) { if (e == 0) lb[i] = 0.f; else { const float a0 = lbsrc[h * 128 + lk8 + i], a1 = lbsrc[512 + h * 128 + lk8 + i]; lb[i] = 1.0f / (1.0f + __expf(a0 - a1)); } }
    const bf16* qbase = big + (size_t)b * SEQ * 4096 + 1536 + h * 128 + lk8;
    const bf16* zbase = big + (size_t)b * SEQ * 4096 + (dir ? 2560 : 2048) + h * 128 + lk8;
    const bf16* vbase = big + (size_t)b * SEQ * 4096 + 3072 + h * 128 + vh * 64 + vv8;
    bf16* obase = ohg + (size_t)dir * T * 512 + (size_t)b * SEQ * 512 + h * 128 + vh * 64 + sv4;
    f32x2 S[4][2];
#pragma unroll
    for (int i = 0; i < 4; ++i) { S[i][0] = (f32x2){0.f, 0.f}; S[i][1] = (f32x2){0.f, 0.f}; }
    u32x4 rq, rz, rv;
    { const int pos = dir ? (SEQ - 1 - lt) : lt; rq = *(const u32x4*)(qbase + (size_t)pos * 4096); rz = *(const u32x4*)(zbase + (size_t)pos * 4096);
      const int pv = dir ? (SEQ - 1 - vt) : vt; rv = (tid < 256) ? *(const u32x4*)(vbase + (size_t)pv * 4096) : (u32x4){0, 0, 0, 0}; }
    for (int blk = 0; blk < SEQ / TB; ++blk) {
      { float zf[8], qf[8];
        zf[0] = bflo(rz.x); zf[1] = bfhi(rz.x); zf[2] = bflo(rz.y); zf[3] = bfhi(rz.y); zf[4] = bflo(rz.z); zf[5] = bfhi(rz.z); zf[6] = bflo(rz.w); zf[7] = bfhi(rz.w);
        qf[0] = bflo(rq.x); qf[1] = bfhi(rq.x); qf[2] = bflo(rq.y); qf[3] = bfhi(rq.y); qf[4] = bflo(rq.z); qf[5] = bfhi(rq.z); qf[6] = bflo(rq.w); qf[7] = bfhi(rq.w);
        float ff[8];
#pragma unroll
        for (int i = 0; i < 8; ++i) { const float sg = __builtin_amdgcn_rcpf(1.0f + __builtin_amdgcn_exp2f(-1.4426950408889634f * zf[i])); ff[i] = lb[i] + (1.0f - lb[i]) * sg; }
        *(f32x4*)(F + lt * 128 + lk8) = (f32x4){ff[0], ff[1], ff[2], ff[3]}; *(f32x4*)(F + lt * 128 + lk8 + 4) = (f32x4){ff[4], ff[5], ff[6], ff[7]};
        *(f32x4*)(Q + lt * 128 + lk8) = (f32x4){qf[0], qf[1], qf[2], qf[3]}; *(f32x4*)(Q + lt * 128 + lk8 + 4) = (f32x4){qf[4], qf[5], qf[6], qf[7]};
        if (tid < 256) { *(f32x4*)(Vv + vt * 64 + vv8) = (f32x4){bflo(rv.x), bfhi(rv.x), bflo(rv.y), bfhi(rv.y)}; *(f32x4*)(Vv + vt * 64 + vv8 + 4) = (f32x4){bflo(rv.z), bfhi(rv.z), bflo(rv.w), bfhi(rv.w)}; } }
      __syncthreads();
      if (blk + 1 < SEQ / TB) { const int t1 = (blk + 1) * TB;
        const int pos = dir ? (SEQ - 1 - (t1 + lt)) : (t1 + lt); rq = *(const u32x4*)(qbase + (size_t)pos * 4096); rz = *(const u32x4*)(zbase + (size_t)pos * 4096);
        const int pv = dir ? (SEQ - 1 - (t1 + vt)) : (t1 + vt); if (tid < 256) rv = *(const u32x4*)(vbase + (size_t)pv * 4096); }
#pragma unroll 4
      for (int t = 0; t < TB; ++t) {
        const f32x4 f4 = *(const f32x4*)(F + t * 128 + k0), q4 = *(const f32x4*)(Q + t * 128 + k0), v4 = *(const f32x4*)(Vv + t * 64 + v0);
        const f32x2 va = (f32x2){v4[0], v4[1]}, vb = (f32x2){v4[2], v4[3]};
        f32x2 oa = (f32x2){0.f, 0.f}, ob = (f32x2){0.f, 0.f};
#pragma unroll
        for (int i = 0; i < 4; ++i) { const f32x2 fi = (f32x2){f4[i], f4[i]}, qi = (f32x2){q4[i], q4[i]};
          S[i][0] = fi * (S[i][0] - va) + va; S[i][1] = fi * (S[i][1] - vb) + vb;
          oa += S[i][0] * qi; ob += S[i][1] * qi; }
        float o0 = oa.x, o1 = oa.y, o2 = ob.x, o3 = ob.y;
        o0 += __shfl_xor(o0, 16); o1 += __shfl_xor(o1, 16); o2 += __shfl_xor(o2, 16); o3 += __shfl_xor(o3, 16);
        o0 += __shfl_xor(o0, 32); o1 += __shfl_xor(o1, 32); o2 += __shfl_xor(o2, 32); o3 += __shfl_xor(o3, 32);
        if (lane < 16) *(f32x4*)(OP + (wave * TB + t) * 64 + v0) = (f32x4){o0, o1, o2, o3};
      }
      __syncthreads();
      { f32x4 s = *(const f32x4*)(OP + (0 * TB + st) * 64 + sv4);
#pragma unroll
        for (int w = 1; w < 8; ++w) s += *(const f32x4*)(OP + (w * TB + st) * 64 + sv4);
        const int tt = blk * TB + st; const int pos = dir ? (SEQ - 1 - tt) : tt;
        u32x2 o; o.x = cvtpk(s[0], s[1]); o.y = cvtpk(s[2], s[3]); *(u32x2*)(obase + (size_t)pos * 512) = o; }
    }
    __syncthreads();
  }
}
__device__ __forceinline__ void hgpost_phase(const Params& p, int e) {
  int tid_ = threadIdx.x; asm volatile("" : "+v"(tid_));
  const int tid = tid_, lane = tid & 63, wave = tid >> 6;
  const int gw = blockIdx.x * 8 + wave, NGW = gridDim.x * 8;
  const bf16* big = (const bf16*)(p.ws + WS_BIG); const bf16* ohg = (const bf16*)p.out; bf16* mix = (bf16*)(p.ws + WS_MIX);
  float gn[8];
#pragma unroll
  for (int i = 0; i < 8; ++i) gn[i] = p.hg_norm[e * 128 + (lane & 15) * 8 + i];
  for (int m0 = gw; m0 < T; m0 += 4 * NGW) {
    u32x4 av[4], bv[4], cv[4], dv4[4], gv[4];
#pragma unroll
    for (int q = 0; q < 4; ++q) { const int m = m0 + q * NGW; const int mc = m < T ? m : m0;
      av[q] = *(const u32x4*)(ohg + (size_t)mc * 512 + lane * 8); bv[q] = *(const u32x4*)(ohg + (size_t)T * 512 + (size_t)mc * 512 + lane * 8);
      cv[q] = *(const u32x4*)(ohg + (size_t)2 * T * 512 + (size_t)mc * 512 + lane * 8); dv4[q] = *(const u32x4*)(ohg + (size_t)3 * T * 512 + (size_t)mc * 512 + lane * 8); gv[q] = *(const u32x4*)(big + (size_t)mc * 4096 + 3584 + lane * 8); }
#pragma unroll
    for (int q = 0; q < 4; ++q) { const int m = m0 + q * NGW; const u32x4 a = av[q], b = bv[q], cc4 = cv[q], dd4 = dv4[q], g = gv[q];
      float s[8];
      s[0] = (bflo(a.x) + bflo(b.x)) + (bflo(cc4.x) + bflo(dd4.x)); s[1] = (bfhi(a.x) + bfhi(b.x)) + (bfhi(cc4.x) + bfhi(dd4.x));
      s[2] = (bflo(a.y) + bflo(b.y)) + (bflo(cc4.y) + bflo(dd4.y)); s[3] = (bfhi(a.y) + bfhi(b.y)) + (bfhi(cc4.y) + bfhi(dd4.y));
      s[4] = (bflo(a.z) + bflo(b.z)) + (bflo(cc4.z) + bflo(dd4.z)); s[5] = (bfhi(a.z) + bfhi(b.z)) + (bfhi(cc4.z) + bfhi(dd4.z));
      s[6] = (bflo(a.w) + bflo(b.w)) + (bflo(cc4.w) + bflo(dd4.w)); s[7] = (bfhi(a.w) + bfhi(b.w)) + (bfhi(cc4.w) + bfhi(dd4.w));
      float sq = 0.f;
#pragma unroll
      for (int i = 0; i < 8; ++i) sq += s[i] * s[i];
      sq += __shfl_xor(sq, 1); sq += __shfl_xor(sq, 2); sq += __shfl_xor(sq, 4); sq += __shfl_xor(sq, 8);
      const float rs = __builtin_amdgcn_rsqf(sq * (1.0f / 128.0f) + EPS);
      float gg[8]; gg[0] = bflo(g.x); gg[1] = bfhi(g.x); gg[2] = bflo(g.y); gg[3] = bfhi(g.y); gg[4] = bflo(g.z); gg[5] = bfhi(g.z); gg[6] = bflo(g.w); gg[7] = bfhi(g.w);
      float o[8];
#pragma unroll
      for (int i = 0; i < 8; ++i) o[i] = s[i] * rs * gn[i] * gg[i];
      u32x4 w; w.x = cvtpk(o[0], o[1]); w.y = cvtpk(o[2], o[3]); w.z = cvtpk(o[4], o[5]); w.w = cvtpk(o[6], o[7]);
      if (m < T) *(u32x4*)(mix + (size_t)m * 1024 + 512 + lane * 8) = w; }
  }
}
}


namespace hg2 {
constexpr int PQ = 272, PJ = 144;
constexpr int OFF_QD = 0, OFF_QA = 17408, OFF_KB = 34816, OFF_KS = 52224, OFF_VT = 70656, OFF_P = 79872, OFF_ST = 89088, OFF_TOT = 123904, OFF_D = 125952, OFF_END = 126464;
constexpr float L2E = 1.4426950408889634f;
__device__ __forceinline__ bf16x8 ldfrag(const char* base, int row, int pitch, int koff) { return *(const bf16x8*)(base + row * pitch + koff * 2); }
__device__ __forceinline__ void hgrn_phase(const Params& p, int e, char* lds) {
  int tid_ = threadIdx.x; asm volatile("" : "+v"(tid_));
  const int tid = tid_, wave = tid >> 6, lane = tid & 63, fr = lane & 15, fq_ = lane >> 4;
  const char* bigc = (const char*)(p.ws + WS_BIG);
  char* ohgc = (char*)p.out;
  char* QD = lds + OFF_QD; char* QA = lds + OFF_QA; char* KB = lds + OFF_KB; char* KS = lds + OFF_KS; char* VT = lds + OFF_VT; char* PP = lds + OFF_P; char* ST = lds + OFF_ST;
  char* RQ = QD; char* RZ = QA; char* RV = KB;
  float* TOT = (float*)(lds + OFF_TOT); float* DD = (float*)(lds + OFF_D);
  const int k = tid & 127, rq = tid >> 7;
  const int vv = tid & 63, jg = tid >> 6;
  const int lr0 = tid >> 4, lc8 = (tid & 15) * 8;
  const int vr = tid >> 3, vc8 = (tid & 7) * 8;
  for (int u = blockIdx.x; u < 256; u += gridDim.x) {
    const int vh = u & 1, dir = (u >> 1) & 1, h = (u >> 2) & 3, b = u >> 4;
    float lbk = 0.f;
    if (e != 0) { const float* lbsrc = dir ? p.lb_bwd : p.lb_fwd; const float a0 = lbsrc[h * 128 + k], a1 = lbsrc[512 + h * 128 + k]; lbk = 1.0f / (1.0f + __expf(a0 - a1)); }
    const int rsb = dir ? -8192 : 8192;
    const int base0 = (b * SEQ + (dir ? (SEQ - 1) : 0)) * 8192;
    const int qcol = (1536 + h * 128 + lc8) * 2, zcol = ((dir ? 2560 : 2048) + h * 128 + lc8) * 2, vcol = (3072 + h * 128 + vh * 64 + vc8) * 2;
    const int osb = dir ? -1024 : 1024;
    const int obase = dir * (T * 1024) + (b * SEQ + (dir ? (SEQ - 1) : 0)) * 1024 + (h * 128 + vh * 64) * 2;
    f32x4 Sacc[4];
#pragma unroll
    for (int i = 0; i < 4; ++i) Sacc[i] = (f32x4){0.f, 0.f, 0.f, 0.f};
    for (int i = tid; i < 64 * PQ / 16; i += 512) *(u32x4*)(ST + i * 16) = (u32x4){0, 0, 0, 0};
    u32x4 gq0, gq1, gz0, gz1, gv;
    { const int o0 = base0 + rsb * lr0, o1 = base0 + rsb * (lr0 + 32);
      gq0 = *(const GAS u32x4*)(bigc + (size_t)(unsigned)(o0 + qcol)); gq1 = *(const GAS u32x4*)(bigc + (size_t)(unsigned)(o1 + qcol));
      gz0 = *(const GAS u32x4*)(bigc + (size_t)(unsigned)(o0 + zcol)); gz1 = *(const GAS u32x4*)(bigc + (size_t)(unsigned)(o1 + zcol));
      gv = *(const GAS u32x4*)(bigc + (size_t)(unsigned)(base0 + rsb * vr + vcol)); }
    for (int c = 0; c < SEQ / 64; ++c) {
      const int pb = c & 1;
      *(u32x4*)(RQ + lr0 * PQ + lc8 * 2) = gq0; *(u32x4*)(RQ + (lr0 + 32) * PQ + lc8 * 2) = gq1;
      *(u32x4*)(RZ + lr0 * PQ + lc8 * 2) = gz0; *(u32x4*)(RZ + (lr0 + 32) * PQ + lc8 * 2) = gz1;
      *(u32x4*)(RV + vr * PJ + vc8 * 2) = gv;
      __syncthreads();
      float qf[16], kk[16], cl[16]; float run = 0.f;
#pragma unroll
      for (int i = 0; i < 16; ++i) { const int t = 16 * rq + i; const float z = bf2f(*(const unsigned short*)(RZ + t * PQ + k * 2)); qf[i] = bf2f(*(const unsigned short*)(RQ + t * PQ + k * 2));
        const float sg = __builtin_amdgcn_rcpf(1.0f + __builtin_amdgcn_exp2f(-L2E * z)); const float f = lbk + (1.0f - lbk) * sg;
        run += __builtin_amdgcn_logf(f); cl[i] = run; kk[i] = 1.0f - f; }
      TOT[rq * 128 + k] = run;
      unsigned short rvv[8];
#pragma unroll
      for (int i = 0; i < 8; ++i) rvv[i] = *(const unsigned short*)(RV + (8 * jg + i) * PJ + vv * 2);
      u32x4 vpk; vpk.x = rvv[0] | ((unsigned)rvv[1] << 16); vpk.y = rvv[2] | ((unsigned)rvv[3] << 16); vpk.z = rvv[4] | ((unsigned)rvv[5] << 16); vpk.w = rvv[6] | ((unsigned)rvv[7] << 16);
      __syncthreads();
      { const float t0 = TOT[k], t1 = TOT[128 + k], t2 = TOT[256 + k], t3 = TOT[384 + k];
        const float mid = t0 + t1, last = (t0 + t1) + (t2 + t3);
        const float off = (rq == 0) ? 0.f : (rq == 1) ? t0 : (rq == 2) ? (t0 + t1) : (t0 + t1 + t2);
        const float el = __builtin_amdgcn_exp2f(last), em = __builtin_amdgcn_exp2f(fminf(-mid, 120.f)), emi = __builtin_amdgcn_exp2f(mid);
        if (rq == 0) DD[k] = el;
        unsigned ksw[8];
#pragma unroll
        for (int i = 0; i < 16; ++i) { const float cc = off + cl[i];
          const float e1 = __builtin_amdgcn_exp2f(cc), inv1 = __builtin_amdgcn_exp2f(fminf(-cc, 120.f));
          const float ea = fminf(e1 * em, 3.6e16f);
          const float eb = fminf(inv1 * emi, 3.6e16f);
          const float es = fminf(inv1 * el, 1.0f);
          const int t = 16 * rq + i;
          const unsigned w0 = cvtpk(qf[i] * e1, qf[i] * ea), w1 = cvtpk(kk[i] * eb, kk[i] * es);
          *(unsigned short*)(QD + t * PQ + k * 2) = (unsigned short)(w0 & 0xffffu);
          *(unsigned short*)(QA + t * PQ + k * 2) = (unsigned short)(w0 >> 16);
          *(unsigned short*)(KB + t * PQ + k * 2) = (unsigned short)(w1 & 0xffffu);
          if (i & 1) ksw[i >> 1] |= (w1 & 0xffff0000u); else ksw[i >> 1] = (w1 >> 16); }
        *(u32x4*)(KS + k * PJ + rq * 32) = (u32x4){ksw[0], ksw[1], ksw[2], ksw[3]};
        *(u32x4*)(KS + k * PJ + rq * 32 + 16) = (u32x4){ksw[4], ksw[5], ksw[6], ksw[7]};
        *(u32x4*)(VT + vv * PJ + jg * 16) = vpk; }
      __syncthreads();
      if (c + 1 < SEQ / 64) { const int bc = base0 + rsb * 64 * (c + 1); const int o0 = bc + rsb * lr0, o1 = bc + rsb * (lr0 + 32);
        gq0 = *(const GAS u32x4*)(bigc + (size_t)(unsigned)(o0 + qcol)); gq1 = *(const GAS u32x4*)(bigc + (size_t)(unsigned)(o1 + qcol));
        gz0 = *(const GAS u32x4*)(bigc + (size_t)(unsigned)(o0 + zcol)); gz1 = *(const GAS u32x4*)(bigc + (size_t)(unsigned)(o1 + zcol));
        gv = *(const GAS u32x4*)(bigc + (size_t)(unsigned)(bc + rsb * vr + vcol)); }
#define HWAIT() do { asm volatile("s_waitcnt lgkmcnt(0)" ::: "memory"); __builtin_amdgcn_sched_barrier(0); } while (0)
      f32x4 oacc[2];
      { const int jt = wave >> 1, ttA = 2 * (wave & 1), ttO = wave >> 1, vtO = 2 * (wave & 1); const char* STp = ST + pb * (64 * PQ);
        bf16x8 fa[4], fb0[4], fb1[4], fq[4], fs0[4], fs1[4];
#pragma unroll
        for (int ks = 0; ks < 4; ++ks) { fa[ks] = ldfrag(KB, 16 * jt + fr, PQ, ks * 32 + fq_ * 8); fb0[ks] = ldfrag(QA, 16 * ttA + fr, PQ, ks * 32 + fq_ * 8); fb1[ks] = ldfrag(QA, 16 * (ttA + 1) + fr, PQ, ks * 32 + fq_ * 8);
          fq[ks] = ldfrag(QD, 16 * ttO + fr, PQ, ks * 32 + fq_ * 8); fs0[ks] = ldfrag(STp, 16 * vtO + fr, PQ, ks * 32 + fq_ * 8); fs1[ks] = ldfrag(STp, 16 * (vtO + 1) + fr, PQ, ks * 32 + fq_ * 8); }
        HWAIT();
        f32x4 acc0 = (f32x4){0.f, 0.f, 0.f, 0.f}, acc1 = acc0; oacc[0] = acc0; oacc[1] = acc0;
#pragma unroll
        for (int ks = 0; ks < 4; ++ks) {
          if (jt <= ttA) acc0 = __builtin_amdgcn_mfma_f32_16x16x32_bf16(fa[ks], fb0[ks], acc0, 0, 0, 0);
          if (jt <= ttA + 1) acc1 = __builtin_amdgcn_mfma_f32_16x16x32_bf16(fa[ks], fb1[ks], acc1, 0, 0, 0);
          oacc[0] = __builtin_amdgcn_mfma_f32_16x16x32_bf16(fq[ks], fs0[ks], oacc[0], 0, 0, 0);
          oacc[1] = __builtin_amdgcn_mfma_f32_16x16x32_bf16(fq[ks], fs1[ks], oacc[1], 0, 0, 0); }
        { const int j0 = 16 * jt + 4 * fq_;
          { const int tcol = 16 * ttA + fr; u32x2 w; w.x = cvtpk_c(j0 + 0 <= tcol ? acc0[0] : 0.f, j0 + 1 <= tcol ? acc0[1] : 0.f); w.y = cvtpk_c(j0 + 2 <= tcol ? acc0[2] : 0.f, j0 + 3 <= tcol ? acc0[3] : 0.f);
            *(u32x2*)(PP + tcol * PJ + j0 * 2) = w; }
          { const int tcol = 16 * (ttA + 1) + fr; u32x2 w; w.x = cvtpk_c(j0 + 0 <= tcol ? acc1[0] : 0.f, j0 + 1 <= tcol ? acc1[1] : 0.f); w.y = cvtpk_c(j0 + 2 <= tcol ? acc1[2] : 0.f, j0 + 3 <= tcol ? acc1[3] : 0.f);
            *(u32x2*)(PP + tcol * PJ + j0 * 2) = w; } } }
      { const f32x4 d4 = *(const f32x4*)(DD + 16 * wave + 4 * fq_); char* STn = ST + (pb ^ 1) * (64 * PQ);
        const bf16x8 a0 = ldfrag(KS, 16 * wave + fr, PJ, fq_ * 8), a1 = ldfrag(KS, 16 * wave + fr, PJ, 32 + fq_ * 8);
        bf16x8 v0[4], v1[4];
#pragma unroll
        for (int vt = 0; vt < 4; ++vt) { v0[vt] = ldfrag(VT, 16 * vt + fr, PJ, fq_ * 8); v1[vt] = ldfrag(VT, 16 * vt + fr, PJ, 32 + fq_ * 8); }
        HWAIT();
#pragma unroll
        for (int vt = 0; vt < 4; ++vt) { Sacc[vt] = Sacc[vt] * d4;
          Sacc[vt] = __builtin_amdgcn_mfma_f32_16x16x32_bf16(a0, v0[vt], Sacc[vt], 0, 0, 0);
          Sacc[vt] = __builtin_amdgcn_mfma_f32_16x16x32_bf16(a1, v1[vt], Sacc[vt], 0, 0, 0); }
#pragma unroll
        for (int vt = 0; vt < 4; ++vt) { u32x2 w; w.x = cvtpk_c(Sacc[vt][0], Sacc[vt][1]); w.y = cvtpk_c(Sacc[vt][2], Sacc[vt][3]);
          *(u32x2*)(STn + (16 * vt + fr) * PQ + (16 * wave + 4 * fq_) * 2) = w; } }
      __syncthreads();
      { const int tt = wave >> 1, vt0 = 2 * (wave & 1);
        bf16x8 pf[2], vf0[2], vf1[2];
#pragma unroll
        for (int ks = 0; ks < 2; ++ks) { pf[ks] = ldfrag(PP, 16 * tt + fr, PJ, ks * 32 + fq_ * 8); vf0[ks] = ldfrag(VT, 16 * vt0 + fr, PJ, ks * 32 + fq_ * 8); vf1[ks] = ldfrag(VT, 16 * (vt0 + 1) + fr, PJ, ks * 32 + fq_ * 8); }
        HWAIT();
#pragma unroll
        for (int ks = 0; ks < 2; ++ks) { oacc[0] = __builtin_amdgcn_mfma_f32_16x16x32_bf16(pf[ks], vf0[ks], oacc[0], 0, 0, 0); oacc[1] = __builtin_amdgcn_mfma_f32_16x16x32_bf16(pf[ks], vf1[ks], oacc[1], 0, 0, 0); }
#pragma unroll
        for (int n = 0; n < 2; ++n) { const int oo = obase + osb * (64 * c + 16 * tt + 4 * fq_) + (16 * (vt0 + n) + fr) * 2;
#pragma unroll
          for (int i = 0; i < 4; ++i) *(GAS unsigned short*)(ohgc + (size_t)(unsigned)(oo + osb * i)) = (unsigned short)(cvtpk_c(oacc[n][i], 0.f) & 0xffffu); } }
#undef HWAIT
    }
    __syncthreads();
  }
}
}


namespace hg3 {
constexpr int PK = 144, PJ = 144, PV = 272;
constexpr int OFF_QD = 0, OFF_QA = 9216, OFF_KB = 18432, OFF_KS = 27648, OFF_VT = 36864, OFF_P = 55296, OFF_ST = 64512, OFF_TOT = 101376, OFF_D = 103424, OFF_END = 103680;
constexpr float L2E = 1.4426950408889634f;
__device__ __forceinline__ bf16x8 ldfrag(const char* base, int row, int pitch, int koff) { return *(const bf16x8*)(base + row * pitch + koff * 2); }
__device__ __forceinline__ void hgrn_phase(const Params& p, int e, char* lds) {
  int tid_ = threadIdx.x; asm volatile("" : "+v"(tid_));
  const int tid = tid_, wave = tid >> 6, lane = tid & 63, fr = lane & 15, fq_ = lane >> 4;
  const char* bigc = (const char*)(p.ws + WS_BIG);
  char* ohgc = (char*)p.out;
  char* QD = lds + OFF_QD; char* QA = lds + OFF_QA; char* KB = lds + OFF_KB; char* KS = lds + OFF_KS; char* VT = lds + OFF_VT; char* PP = lds + OFF_P; char* ST = lds + OFF_ST;
  char* RQ = QD; char* RZ = QA; char* RV = KB;
  float* TOT = (float*)(lds + OFF_TOT); float* DD = (float*)(lds + OFF_D);
  const int k = tid & 63, rq = tid >> 6;
  const int vv = tid & 127, jg = tid >> 7;
  const int lr = tid >> 3, lc8 = (tid & 7) * 8;
  const int vr = tid >> 4, vc8 = (tid & 15) * 8;
  for (int u = blockIdx.x; u < 256; u += gridDim.x) {
    const int kh = u & 1, dir = (u >> 1) & 1, h = (u >> 2) & 3, b = u >> 4;
    float lbk = 0.f;
    if (e != 0) { const float* lbsrc = dir ? p.lb_bwd : p.lb_fwd; const float a0 = lbsrc[h * 128 + kh * 64 + k], a1 = lbsrc[512 + h * 128 + kh * 64 + k]; lbk = 1.0f / (1.0f + __expf(a0 - a1)); }
    const int rsb = dir ? -8192 : 8192;
    const int base0 = (b * SEQ + (dir ? (SEQ - 1) : 0)) * 8192;
    const int qcol = (1536 + h * 128 + kh * 64 + lc8) * 2, zcol = ((dir ? 2560 : 2048) + h * 128 + kh * 64 + lc8) * 2, vcol = (3072 + h * 128 + vc8) * 2;
    const int osb = dir ? -1024 : 1024;
    const int obase = (dir * 2 + kh) * (T * 1024) + (b * SEQ + (dir ? (SEQ - 1) : 0)) * 1024 + h * 256;
    f32x4 Sacc[4];
#pragma unroll
    for (int i = 0; i < 4; ++i) Sacc[i] = (f32x4){0.f, 0.f, 0.f, 0.f};
    for (int i = tid; i < 128 * PK / 16; i += 512) *(u32x4*)(ST + i * 16) = (u32x4){0, 0, 0, 0};
    u32x4 gq, gz, gv0, gv1;
    { const int o0 = base0 + rsb * lr;
      gq = *(const GAS u32x4*)(bigc + (size_t)(unsigned)(o0 + qcol)); gz = *(const GAS u32x4*)(bigc + (size_t)(unsigned)(o0 + zcol));
      gv0 = *(const GAS u32x4*)(bigc + (size_t)(unsigned)(base0 + rsb * vr + vcol)); gv1 = *(const GAS u32x4*)(bigc + (size_t)(unsigned)(base0 + rsb * (vr + 32) + vcol)); }
    for (int c = 0; c < SEQ / 64; ++c) {
      const int pb = c & 1;
      *(u32x4*)(RQ + lr * PK + lc8 * 2) = gq; *(u32x4*)(RZ + lr * PK + lc8 * 2) = gz;
      *(u32x4*)(RV + vr * PV + vc8 * 2) = gv0; *(u32x4*)(RV + (vr + 32) * PV + vc8 * 2) = gv1;
      __syncthreads();
      float qf[8], kk[8], cl[8]; float run = 0.f;
#pragma unroll
      for (int i = 0; i < 8; ++i) { const int t = 8 * rq + i; const float z = bf2f(*(const unsigned short*)(RZ + t * PK + k * 2)); qf[i] = bf2f(*(const unsigned short*)(RQ + t * PK + k * 2));
        const float sg = __builtin_amdgcn_rcpf(1.0f + __builtin_amdgcn_exp2f(-L2E * z)); const float f = lbk + (1.0f - lbk) * sg;
        run += __builtin_amdgcn_logf(f); cl[i] = run; kk[i] = 1.0f - f; }
      TOT[rq * 64 + k] = run;
      unsigned short rvv[16];
#pragma unroll
      for (int i = 0; i < 16; ++i) rvv[i] = *(const unsigned short*)(RV + (16 * jg + i) * PV + vv * 2);
      u32x4 vpa, vpb;
      vpa.x = rvv[0] | ((unsigned)rvv[1] << 16); vpa.y = rvv[2] | ((unsigned)rvv[3] << 16); vpa.z = rvv[4] | ((unsigned)rvv[5] << 16); vpa.w = rvv[6] | ((unsigned)rvv[7] << 16);
      vpb.x = rvv[8] | ((unsigned)rvv[9] << 16); vpb.y = rvv[10] | ((unsigned)rvv[11] << 16); vpb.z = rvv[12] | ((unsigned)rvv[13] << 16); vpb.w = rvv[14] | ((unsigned)rvv[15] << 16);
      __syncthreads();
      { float tt[8];
#pragma unroll
        for (int r8 = 0; r8 < 8; ++r8) tt[r8] = TOT[r8 * 64 + k];
        const float mid = (tt[0] + tt[1]) + (tt[2] + tt[3]), last = mid + ((tt[4] + tt[5]) + (tt[6] + tt[7]));
        float off = 0.f;
#pragma unroll
        for (int r8 = 0; r8 < 7; ++r8) off += (r8 < rq) ? tt[r8] : 0.f;
        const float el = __builtin_amdgcn_exp2f(last), em = __builtin_amdgcn_exp2f(fminf(-mid, 120.f)), emi = __builtin_amdgcn_exp2f(mid);
        if (rq == 0) DD[k] = el;
        unsigned ksw[4];
#pragma unroll
        for (int i = 0; i < 8; ++i) { const float cc = off + cl[i];
          const float e1 = __builtin_amdgcn_exp2f(cc), inv1 = __builtin_amdgcn_exp2f(fminf(-cc, 120.f));
          const float ea = fminf(e1 * em, 3.6e16f), eb = fminf(inv1 * emi, 3.6e16f), es = fminf(inv1 * el, 1.0f);
          const int t = 8 * rq + i;
          const unsigned w0 = cvtpk(qf[i] * e1, qf[i] * ea), w1 = cvtpk(kk[i] * eb, kk[i] * es);
          *(unsigned short*)(QD + t * PK + k * 2) = (unsigned short)(w0 & 0xffffu);
          *(unsigned short*)(QA + t * PK + k * 2) = (unsigned short)(w0 >> 16);
          *(unsigned short*)(KB + t * PK + k * 2) = (unsigned short)(w1 & 0xffffu);
          if (i & 1) ksw[i >> 1] |= (w1 & 0xffff0000u); else ksw[i >> 1] = (w1 >> 16); }
        *(u32x4*)(KS + k * PJ + rq * 16) = (u32x4){ksw[0], ksw[1], ksw[2], ksw[3]};
        *(u32x4*)(VT + vv * PJ + jg * 32) = vpa; *(u32x4*)(VT + vv * PJ + jg * 32 + 16) = vpb; }
      __syncthreads();
      if (c + 1 < SEQ / 64) { const int bc = base0 + rsb * 64 * (c + 1); const int o0 = bc + rsb * lr;
        gq = *(const GAS u32x4*)(bigc + (size_t)(unsigned)(o0 + qcol)); gz = *(const GAS u32x4*)(bigc + (size_t)(unsigned)(o0 + zcol));
        gv0 = *(const GAS u32x4*)(bigc + (size_t)(unsigned)(bc + rsb * vr + vcol)); gv1 = *(const GAS u32x4*)(bigc + (size_t)(unsigned)(bc + rsb * (vr + 32) + vcol)); }
#define HWAIT() do { asm volatile("s_waitcnt lgkmcnt(0)" ::: "memory"); __builtin_amdgcn_sched_barrier(0); } while (0)
      f32x4 oacc[4];
      const int wq = wave >> 1, vt0 = 4 * (wave & 1);
      { const int ttA = 2 * (wave & 1); const char* STp = ST + pb * (128 * PK);
        bf16x8 fa[2], fb0[2], fb1[2], fqd[2], fs[4][2];
#pragma unroll
        for (int ks = 0; ks < 2; ++ks) { fa[ks] = ldfrag(KB, 16 * wq + fr, PK, ks * 32 + fq_ * 8); fb0[ks] = ldfrag(QA, 16 * ttA + fr, PK, ks * 32 + fq_ * 8); fb1[ks] = ldfrag(QA, 16 * (ttA + 1) + fr, PK, ks * 32 + fq_ * 8);
          fqd[ks] = ldfrag(QD, 16 * wq + fr, PK, ks * 32 + fq_ * 8);
#pragma unroll
          for (int n = 0; n < 4; ++n) fs[n][ks] = ldfrag(STp, 16 * (vt0 + n) + fr, PK, ks * 32 + fq_ * 8); }
        HWAIT();
        f32x4 acc0 = (f32x4){0.f, 0.f, 0.f, 0.f}, acc1 = acc0;
#pragma unroll
        for (int n = 0; n < 4; ++n) oacc[n] = acc0;
#pragma unroll
        for (int ks = 0; ks < 2; ++ks) {
          if (wq <= ttA) acc0 = __builtin_amdgcn_mfma_f32_16x16x32_bf16(fa[ks], fb0[ks], acc0, 0, 0, 0);
          if (wq <= ttA + 1) acc1 = __builtin_amdgcn_mfma_f32_16x16x32_bf16(fa[ks], fb1[ks], acc1, 0, 0, 0);
#pragma unroll
          for (int n = 0; n < 4; ++n) oacc[n] = __builtin_amdgcn_mfma_f32_16x16x32_bf16(fqd[ks], fs[n][ks], oacc[n], 0, 0, 0); }
        { const int j0 = 16 * wq + 4 * fq_;
          { const int tcol = 16 * ttA + fr; u32x2 w; w.x = cvtpk_c(j0 + 0 <= tcol ? acc0[0] : 0.f, j0 + 1 <= tcol ? acc0[1] : 0.f); w.y = cvtpk_c(j0 + 2 <= tcol ? acc0[2] : 0.f, j0 + 3 <= tcol ? acc0[3] : 0.f);
            *(u32x2*)(PP + tcol * PJ + j0 * 2) = w; }
          { const int tcol = 16 * (ttA + 1) + fr; u32x2 w; w.x = cvtpk_c(j0 + 0 <= tcol ? acc1[0] : 0.f, j0 + 1 <= tcol ? acc1[1] : 0.f); w.y = cvtpk_c(j0 + 2 <= tcol ? acc1[2] : 0.f, j0 + 3 <= tcol ? acc1[3] : 0.f);
            *(u32x2*)(PP + tcol * PJ + j0 * 2) = w; } } }
      { const f32x4 d4 = *(const f32x4*)(DD + 16 * wq + 4 * fq_); char* STn = ST + (pb ^ 1) * (128 * PK);
        const bf16x8 a0 = ldfrag(KS, 16 * wq + fr, PJ, fq_ * 8), a1 = ldfrag(KS, 16 * wq + fr, PJ, 32 + fq_ * 8);
        bf16x8 v0[4], v1[4];
#pragma unroll
        for (int n = 0; n < 4; ++n) { v0[n] = ldfrag(VT, 16 * (vt0 + n) + fr, PJ, fq_ * 8); v1[n] = ldfrag(VT, 16 * (vt0 + n) + fr, PJ, 32 + fq_ * 8); }
        HWAIT();
#pragma unroll
        for (int n = 0; n < 4; ++n) { Sacc[n] = Sacc[n] * d4;
          Sacc[n] = __builtin_amdgcn_mfma_f32_16x16x32_bf16(a0, v0[n], Sacc[n], 0, 0, 0);
          Sacc[n] = __builtin_amdgcn_mfma_f32_16x16x32_bf16(a1, v1[n], Sacc[n], 0, 0, 0); }
#pragma unroll
        for (int n = 0; n < 4; ++n) { u32x2 w; w.x = cvtpk_c(Sacc[n][0], Sacc[n][1]); w.y = cvtpk_c(Sacc[n][2], Sacc[n][3]);
          *(u32x2*)(STn + (16 * (vt0 + n) + fr) * PK + (16 * wq + 4 * fq_) * 2) = w; } }
      __syncthreads();
      { bf16x8 pf[2], vf[4][2];
#pragma unroll
        for (int ks = 0; ks < 2; ++ks) { pf[ks] = ldfrag(PP, 16 * wq + fr, PJ, ks * 32 + fq_ * 8);
#pragma unroll
          for (int n = 0; n < 4; ++n) vf[n][ks] = ldfrag(VT, 16 * (vt0 + n) + fr, PJ, ks * 32 + fq_ * 8); }
        HWAIT();
#pragma unroll
        for (int ks = 0; ks < 2; ++ks)
#pragma unroll
          for (int n = 0; n < 4; ++n) oacc[n] = __builtin_amdgcn_mfma_f32_16x16x32_bf16(pf[ks], vf[n][ks], oacc[n], 0, 0, 0);
#pragma unroll
        for (int n = 0; n < 4; ++n) { const int oo = obase + osb * (64 * c + 16 * wq + 4 * fq_) + (16 * (vt0 + n) + fr) * 2;
#pragma unroll
          for (int i = 0; i < 4; ++i) *(GAS unsigned short*)(ohgc + (size_t)(unsigned)(oo + osb * i)) = (unsigned short)(cvtpk_c(oacc[n][i], 0.f) & 0xffffu); } }
#undef HWAIT
    }
    __syncthreads();
  }
}
}

namespace sgu {
constexpr int VT_PITCH = 272;
constexpr int OFF_VT = 0, OFF_RS = 128 * VT_PITCH, OFF_END = OFF_RS + 512;
__device__ __forceinline__ void sgu_phase(const Params& p, int o, char* lds) {
  int tid_ = threadIdx.x; asm volatile("" : "+v"(tid_));
  const int tid = tid_, wave = tid >> 6, lane = tid & 63, fr = lane & 15, quad = lane >> 4;
  const int wr = wave >> 1, wc = wave & 1;
  const bf16* big = (const bf16*)(p.ws + WS_BIG); bf16* mix = (bf16*)(p.ws + WS_MIX);
  const bf16* Wb = (const bf16*)(p.ws + WS_W) + W_SGW + (size_t)o * 8 * 128 * 128;
  const unsigned long long* vss = (const unsigned long long*)(p.ws + WS_SS) + (size_t)(9 + o) * T;
  float* rs = (float*)(lds + OFF_RS);
  const int NU = 512 * 8, G = gridDim.x;
  const bool gfix = (G & 7) == 0;
  u32x4 wraw[4][2]; f32x4 gainv[4]; float biasv[2]; int gcur = -1;
  const int sq0 = tid >> 4, sc8 = (tid & 15) * 8;
  u32x4 vst[4];
  int u = blockIdx.x;
  if (u < NU) { const int g = u & 7; const size_t T0 = (size_t)(u >> 3) * 128;
#pragma unroll
    for (int i = 0; i < 4; ++i) vst[i] = *(const GAS u32x4*)(big + (T0 + sq0 + 32 * i) * 2048 + 1024 + g * 128 + sc8); }
  for (; u < NU; u += G) {
    const int g = u & 7, n = u >> 3; const size_t T0 = (size_t)n * 128;
    if (g != gcur) { gcur = g;
#pragma unroll
      for (int kq = 0; kq < 4; ++kq)
#pragma unroll
        for (int nt = 0; nt < 2; ++nt) wraw[kq][nt] = *(const GAS u32x4*)(Wb + ((size_t)g * 128 + wr * 32 + nt * 16 + fr) * 128 + kq * 32 + quad * 8);
#pragma unroll
      for (int mt = 0; mt < 4; ++mt) gainv[mt] = *(const f32x4*)(p.sg_norm + o * 1024 + g * 128 + wc * 64 + mt * 16 + 4 * quad);
#pragma unroll
      for (int nt = 0; nt < 2; ++nt) biasv[nt] = p.sg_b[(o * 8 + g) * 128 + wr * 32 + nt * 16 + fr]; }
    u32x2 uw[2][4];
#pragma unroll
    for (int nt = 0; nt < 2; ++nt)
#pragma unroll
      for (int mt = 0; mt < 4; ++mt) uw[nt][mt] = *(const GAS u32x2*)(big + (T0 + wr * 32 + nt * 16 + fr) * 2048 + g * 128 + wc * 64 + mt * 16 + 4 * quad);
    __syncthreads();
#pragma unroll
    for (int i = 0; i < 4; ++i) { const int q = sq0 + 32 * i; const u32x4 w = vst[i];
      unsigned short* d = (unsigned short*)(lds + OFF_VT + (sc8) * VT_PITCH + q * 2);
      d[0 * (VT_PITCH / 2)] = (unsigned short)(w.x & 0xffffu); d[1 * (VT_PITCH / 2)] = (unsigned short)(w.x >> 16);
      d[2 * (VT_PITCH / 2)] = (unsigned short)(w.y & 0xffffu); d[3 * (VT_PITCH / 2)] = (unsigned short)(w.y >> 16);
      d[4 * (VT_PITCH / 2)] = (unsigned short)(w.z & 0xffffu); d[5 * (VT_PITCH / 2)] = (unsigned short)(w.z >> 16);
      d[6 * (VT_PITCH / 2)] = (unsigned short)(w.w & 0xffffu); d[7 * (VT_PITCH / 2)] = (unsigned short)(w.w >> 16); }
    if (tid < 128) rs[tid] = __builtin_amdgcn_rsqf(pg8::ss2f(vss[T0 + tid]) * (1.0f / 1024.0f) + EPS);
    __syncthreads();
    if (u + G < NU) { const int g2 = (u + G) & 7; const size_t T2 = (size_t)((u + G) >> 3) * 128;
#pragma unroll
      for (int i = 0; i < 4; ++i) vst[i] = *(const GAS u32x4*)(big + (T2 + sq0 + 32 * i) * 2048 + 1024 + g2 * 128 + sc8); }
    f32x4 acc[4][2];
#pragma unroll
    for (int mt = 0; mt < 4; ++mt)
#pragma unroll
      for (int nt = 0; nt < 2; ++nt) acc[mt][nt] = (f32x4){0.f, 0.f, 0.f, 0.f};
#pragma unroll
    for (int kq = 0; kq < 4; ++kq) {
      const f32x4 r0 = *(const f32x4*)(rs + kq * 32 + quad * 8), r1 = *(const f32x4*)(rs + kq * 32 + quad * 8 + 4);
      bf16x8 wf[2];
#pragma unroll
      for (int nt = 0; nt < 2; ++nt) { const u32x4 w = wraw[kq][nt];
        u32x4 s; s.x = cvtpk(bflo(w.x) * r0[0], bfhi(w.x) * r0[1]); s.y = cvtpk(bflo(w.y) * r0[2], bfhi(w.y) * r0[3]); s.z = cvtpk(bflo(w.z) * r1[0], bfhi(w.z) * r1[1]); s.w = cvtpk(bflo(w.w) * r1[2], bfhi(w.w) * r1[3]);
        wf[nt] = __builtin_bit_cast(bf16x8, s); }
#pragma unroll
      for (int mt = 0; mt < 4; ++mt) { const bf16x8 vf = *(const bf16x8*)(lds + OFF_VT + (wc * 64 + mt * 16 + fr) * VT_PITCH + (kq * 32 + quad * 8) * 2);
#pragma unroll
        for (int nt = 0; nt < 2; ++nt) acc[mt][nt] = __builtin_amdgcn_mfma_f32_16x16x32_bf16(vf, wf[nt], acc[mt][nt], 0, 0, 0); }
    }
#pragma unroll
    for (int nt = 0; nt < 2; ++nt) { const int pp = wr * 32 + nt * 16 + fr;
#pragma unroll
      for (int mt = 0; mt < 4; ++mt) { const int c = g * 128 + wc * 64 + mt * 16 + 4 * quad; const u32x2 uu = uw[nt][mt];
        const f32x4 v = (f32x4){bflo(uu.x), bfhi(uu.x), bflo(uu.y), bfhi(uu.y)} * (gainv[mt] * acc[mt][nt] + biasv[nt]);
        u32x2 ow; ow.x = cvtpk(v[0], v[1]); ow.y = cvtpk(v[2], v[3]);
        *(GAS u32x2*)(mix + (T0 + pp) * 1024 + c) = ow; } }
  }
  (void)gfix;
}
}

#define XB_TMO      128
#define XB_XCNT(j)  (256  + 64 * (j))
#define XB_XSUB(j)  (1280 + 64 * (j))
#define XB_XGEN(j)  (2304 + 64 * (j))
#define XB_TOP      3328
#define XB_TOPGEN   3392
#define XCD_BAR_WORDS 3456
#define XB_SPIN_CAP (1u << 18)

__device__ __forceinline__ unsigned xb_ld(unsigned* p)              { return __hip_atomic_load(p, __ATOMIC_RELAXED, __HIP_MEMORY_SCOPE_AGENT); }
__device__ __forceinline__ unsigned xb_add(unsigned* p, unsigned v) { return __hip_atomic_fetch_add(p, v, __ATOMIC_RELAXED, __HIP_MEMORY_SCOPE_AGENT); }
__device__ __forceinline__ unsigned xb_xcc_id() { return (unsigned)__builtin_amdgcn_s_getreg((3 << 11) | 20) & 0xFu; }
#define XB_SPIN(cond, bar) do { unsigned _sp = 0; while (cond) { __builtin_amdgcn_s_sleep(1); \
    if ((++_sp & 255u) == 0u) { if (xb_ld(&(bar)[XB_TMO])) break; if (_sp > XB_SPIN_CAP) { atomicAdd(&(bar)[XB_TMO], 1u); break; } } } } while (0)

struct XcdBarrier {
    unsigned* bar; unsigned x;
    volatile LAS unsigned* st;
};

__device__ __forceinline__ XcdBarrier xcd_barrier_post(unsigned* bar, volatile LAS unsigned* st) {
    XcdBarrier b; b.bar = bar; b.x = xb_xcc_id(); b.st = st;
    if (threadIdx.x == 0) (void)xb_add(&bar[XB_XCNT(b.x)], 1u);
    return b;
}
__device__ __forceinline__ void xcd_barrier_complete(unsigned* bar, unsigned x, unsigned& nloc, unsigned& nx) {
    const unsigned G = gridDim.x * gridDim.y * gridDim.z;
    unsigned sum, cnt, mine, sp = 0u;
    for (;;) {
        sum = 0u; cnt = 0u; mine = 0u;
#pragma unroll
        for (unsigned j = 0; j < 16; ++j) { const unsigned c = xb_ld(&bar[XB_XCNT(j)]); sum += c; cnt += (c > 0u) ? 1u : 0u; mine = (j == x) ? c : mine; }
        if (sum == G) break;
        __builtin_amdgcn_s_sleep(1);
        if ((++sp & 255u) == 0u) { if (xb_ld(&bar[XB_TMO])) break; if (sp > XB_SPIN_CAP) { atomicAdd(&bar[XB_TMO], 1u); break; } }
    }
    nloc = mine > 0u ? mine : 1u; nx = cnt > 0u ? cnt : 1u;
}

__device__ __forceinline__ void xcd_barrier(const XcdBarrier& b) {
    asm volatile("s_waitcnt vmcnt(0)" ::: "memory");
    __syncthreads();
    if (threadIdx.x == 0) {
        unsigned* bar = b.bar;
        __builtin_amdgcn_s_waitcnt(0);
        unsigned nloc = b.st[0], nx = b.st[1];
        if (nloc == 0u) { xcd_barrier_complete(bar, b.x, nloc, nx); b.st[0] = nloc; b.st[1] = nx; }
        const unsigned old = xb_add(&bar[XB_XSUB(b.x)], 1u);
        const unsigned gen = old / nloc;
        if (old + 1u == (gen + 1u) * nloc) {
            __builtin_amdgcn_fence(__ATOMIC_RELEASE, "agent");
            asm volatile("s_waitcnt vmcnt(0)" ::: "memory");
            const unsigned og = xb_add(&bar[XB_TOP], 1u);
            const unsigned tg = og / nx;
            if (og + 1u == (tg + 1u) * nx) xb_add(&bar[XB_TOPGEN], 1u);
            else XB_SPIN(xb_ld(&bar[XB_TOPGEN]) == tg, bar);
            __builtin_amdgcn_fence(__ATOMIC_ACQUIRE, "agent");
            xb_add(&bar[XB_XGEN(b.x)], 1u);
            asm volatile("s_waitcnt vmcnt(0)" ::: "memory");
        } else {
            XB_SPIN(xb_ld(&bar[XB_XGEN(b.x)]) == gen, bar);
            __builtin_amdgcn_fence(__ATOMIC_ACQUIRE, "agent");
            asm volatile("s_waitcnt vmcnt(0)" ::: "memory");
        }
    }
    __syncthreads();
}

constexpr int NPHASE = 24;
__global__ void __launch_bounds__(512, 2) mega_fwd(Params pin) {
    extern __shared__ __attribute__((aligned(16))) unsigned char lds_raw[];
    PG8_LAS unsigned char* lds = (PG8_LAS unsigned char*)lds_raw;
    const int G = gridDim.x, c = blockIdx.x;
    volatile LAS unsigned* bst = (volatile LAS unsigned*)(lds + (LDS_BYTES - 64));
    if (threadIdx.x < 2) bst[threadIdx.x] = 0u;
    __syncthreads();
    const XcdBarrier xbar = xcd_barrier_post((unsigned*)(pin.ws + WS_BAR), bst);
    for (int ph = pin.ph_lo; ph < pin.ph_hi; ++ph) {
        Params p = pin;
        { unsigned long long w = (unsigned long long)pin.ws, o = (unsigned long long)pin.out; asm volatile("" : "+s"(w), "+s"(o)); p.ws = (unsigned char*)w; p.out = (float*)o; }
        unsigned char* ws = p.ws;
        bf16* WB = (bf16*)(ws + WS_W);
        bf16* hb = (bf16*)(ws + WS_HB); bf16* mix = (bf16*)(ws + WS_MIX); bf16* big = (bf16*)(ws + WS_BIG);
        unsigned long long* SS = (unsigned long long*)(ws + WS_SS);
        if (ph == 0) prologue_phase(p, lds);
        else if (ph == 23) final_phase(p);
        else {
            const int li = (ph - 1) / 11, r = (ph - 1) % 11;
            const int l = (r < 6) ? 2 * li : 2 * li + 1;
            if (r == 0) { pg8::Gemm g{hb, WB + W_INE + (size_t)li * 4096 * 1024, T, 4096, 1024}; pg8::StaticOrder S; S.init(T, 4096, G, c);
                pg8::EpiEvenIn E{big, SS + (size_t)(2 * l) * T, (unsigned*)(ws + WS_KMX) + li * 128}; pg8::gemm_phase<pg8::EpiEvenIn, pg8::StaticOrder, true, true>(lds, g, S, E); }
            else if (r == 1) { hg3::hgrn_phase(p, li, (char*)lds_raw); att::attn_phase(p, li, (char*)lds_raw); }
            else if (r == 2) { hg::hgpost_phase(p, li); }
            else if (r == 3 || r == 8) { const bf16* Wt = (r == 3) ? WB + W_OUTE + (size_t)li * 1024 * 1024 : WB + W_OUTO + (size_t)li * 1024 * 1024;
                pg8::Gemm g{mix, Wt, T, 1024, 1024}; pg8::StaticOrder S; S.init(T, 1024, G, c);
                pg8::EpiRes E{hb, SS + (size_t)(2 * l + 1) * T}; pg8::gemm_phase<pg8::EpiRes, pg8::StaticOrder, true, true>(lds, g, S, E); }
            else if (r == 4 || r == 9) { pg8::Gemm g{hb, WB + W_FIN + (size_t)l * 5632 * 1024, T, 5632, 1024}; pg8::StaticOrder S; S.init(T, 5632, G, c);
                pg8::EpiFfnIn E{big, SS + (size_t)(2 * l + 1) * T}; pg8::gemm_phase<pg8::EpiFfnIn, pg8::StaticOrder, true, true>(lds, g, S, E); }
            else if (r == 5 || r == 10) { pg8::Gemm g{big, WB + W_FOUT + (size_t)l * 1024 * 2816, T, 1024, 2816}; pg8::StaticOrder S; S.init(T, 1024, G, c);
                pg8::EpiRes E{hb, SS + (size_t)(2 * l + 2) * T}; pg8::gemm_phase<pg8::EpiRes, pg8::StaticOrder, true, true>(lds, g, S, E); }
            else if (r == 6) { pg8::Gemm g{hb, WB + W_INO + (size_t)li * 2048 * 1024, T, 2048, 1024}; pg8::StaticOrder S; S.init(T, 2048, G, c);
                pg8::EpiOddIn E{big, SS + (size_t)(2 * l) * T, SS + (size_t)(9 + li) * T}; pg8::gemm_phase<pg8::EpiOddIn, pg8::StaticOrder, true, true>(lds, g, S, E); }
            else if (r == 7) { sgu::sgu_phase(p, li, (char*)lds_raw); }
        }
        if (ph + 1 < pin.ph_hi) { if (ph == 0) cg::this_grid().sync(); else xcd_barrier(xbar); }
    }
}

#ifndef MK_MULTI
#define MK_MULTI 0
#endif
extern "C" void kernel_launch(void* const* d_in, const int* in_sizes, int n_in, void* d_out, int out_size, void* d_ws, size_t ws_size, hipStream_t stream) {
    static int grid = 0;
    if (grid == 0) {
        if (n_in != 22 || in_sizes[0] != T * D_MODEL || out_size != T * D_MODEL || ws_size < WS_END) { fprintf(stderr, "kernel_launch: unexpected shapes / workspace (n_in %d, in0 %d, out %d, ws %zu need %zu)\n", n_in, n_in > 0 ? in_sizes[0] : -1, out_size, ws_size, (size_t)WS_END); grid = -1; return; }
        int dev = 0, cus = 0, per_cu = 0;
        if (hipGetDevice(&dev) != hipSuccess || hipDeviceGetAttribute(&cus, hipDeviceAttributeMultiprocessorCount, dev) != hipSuccess) { grid = -1; return; }
        if (hipFuncSetAttribute((const void*)mega_fwd, hipFuncAttributeMaxDynamicSharedMemorySize, LDS_BYTES) != hipSuccess) { fprintf(stderr, "kernel_launch: hipFuncSetAttribute failed\n"); grid = -1; return; }
        if (hipOccupancyMaxActiveBlocksPerMultiprocessor(&per_cu, (const void*)mega_fwd, 512, LDS_BYTES) != hipSuccess || per_cu < 1) { fprintf(stderr, "kernel_launch: occupancy query says %d\n", per_cu); per_cu = 1; }
        (void)hipGetLastError();
        grid = cus * 1;
    }
    if (grid < 0) return;
    Params p{};
    const float* const* in = (const float* const*)d_in;
    p.x = in[0]; p.rel_bias = in[1]; p.norm_mix = in[2]; p.norm_ffn = in[3]; p.norm_final = in[4]; p.w_in_even = in[5]; p.w_out_even = in[6];
    p.lq1 = in[7]; p.lk1 = in[8]; p.lq2 = in[9]; p.lk2 = in[10]; p.da_subln = in[11]; p.lb_fwd = in[12]; p.lb_bwd = in[13]; p.hg_norm = in[14];
    p.w_in_odd = in[15]; p.sg_norm = in[16]; p.sg_w = in[17]; p.sg_b = in[18]; p.w_out_odd = in[19]; p.w_ffn_in = in[20]; p.w_ffn_out = in[21];
    p.out = (float*)d_out; p.ws = (unsigned char*)d_ws;
#if MK_MULTI
    for (int ph = 0; ph < NPHASE; ++ph) { p.ph_lo = ph; p.ph_hi = ph + 1; hipLaunchKernelGGL(mega_fwd, dim3(grid), dim3(512), LDS_BYTES, stream, p); }
#else
    p.ph_lo = 0; p.ph_hi = NPHASE;
    if (hipMemsetAsync((char*)d_ws + WS_BAR, 0, XCD_BAR_WORDS * 4, stream) != hipSuccess) { fprintf(stderr, "kernel_launch: memset of the barrier words failed\n"); return; }
    void* args[] = {&p};
    hipError_t e = hipLaunchCooperativeKernel((const void*)mega_fwd, dim3(grid), dim3(512), args, LDS_BYTES, stream);
    if (e != hipSuccess) fprintf(stderr, "cooperative launch failed: %s (grid %d)\n", hipGetErrorString(e), grid);
#endif
}
```
